# Optimizing an MI355X kernel written in HIP

```python
import jax
import jax.numpy as jnp
from jax import lax
import numpy as np

D_MODEL = 1024
BATCH = 4
SEQ = 4096
DEPTH = 1

GLA_HEADS = 4
GLA_DK = D_MODEL // (2 * GLA_HEADS)
GLA_DV = D_MODEL // GLA_HEADS
GLA_LOWRANK = 16
GLA_TAU = 16.0
GLA_CHUNK = 16

ATTN_GROUPS = ((128, 1), (512, 4), (2048, 16))
ATTN_HEADS_PER_GROUP = 4
ATTN_HEAD_DIM = 64
ATTN_HEADS = ATTN_HEADS_PER_GROUP * len(ATTN_GROUPS)
ROPE_THETA = 10000.0

D_FF = 2816
CONV_WIDTH = 3
EPS = 1e-6

GLA_QK_WIDTH = GLA_HEADS * GLA_DK
GLA_V_WIDTH = GLA_HEADS * GLA_DV
ATTN_WIDTH = ATTN_HEADS * ATTN_HEAD_DIM
ATTN_OUT_WIDTH = ATTN_HEADS_PER_GROUP * ATTN_HEAD_DIM
IN_WIDTHS = (GLA_QK_WIDTH, GLA_QK_WIDTH, GLA_V_WIDTH, GLA_V_WIDTH, GLA_LOWRANK,
             ATTN_WIDTH, ATTN_WIDTH, ATTN_WIDTH, D_MODEL, D_MODEL)
D_IN = sum(IN_WIDTHS)

kernel_name = "hybrid_gla_dilated_attn_convffn_block"


def rmsnorm(x, w):
    xf = x.astype(jnp.float32)
    y = xf * lax.rsqrt(jnp.mean(xf * xf, axis=-1, keepdims=True) + EPS)
    return (y * w.astype(jnp.float32)).astype(x.dtype)


def rotary(t, positions):
    half = t.shape[-1] // 2
    inv_freq = ROPE_THETA ** (-jnp.arange(half, dtype=jnp.float32) / half)
    ang = positions.astype(jnp.float32)[..., None] * inv_freq
    cos = jnp.cos(ang)[:, :, None, :]
    sin = jnp.sin(ang)[:, :, None, :]
    tf = t.astype(jnp.float32)
    t1, t2 = tf[..., :half], tf[..., half:]
    return jnp.concatenate([t1 * cos - t2 * sin, t2 * cos + t1 * sin], axis=-1).astype(t.dtype)


def gla_chunked(q, k, v, log_a):
    B, S, H, dk = q.shape
    dv = v.shape[-1]
    C = GLA_CHUNK
    N = S // C

    def chunks(t):
        return t.astype(jnp.float32).reshape(B, N, C, H, -1).transpose(0, 3, 1, 2, 4)

    qc = chunks(q) * (dk ** -0.5)
    kc, vc, lac = chunks(k), chunks(v), chunks(log_a)
    b = jnp.cumsum(lac, axis=3)
    b_last = b[:, :, :, -1:, :]
    qg = qc * jnp.exp(b)
    kg = kc * jnp.exp(-b)
    kd = kc * jnp.exp(b_last - b)

    causal = jnp.tril(jnp.ones((C, C), dtype=bool))
    attn = jnp.where(causal, jnp.einsum('bhnid,bhnjd->bhnij', qg, kg), 0.0)
    o_intra = jnp.einsum('bhnij,bhnjv->bhniv', attn, vc)

    def step(state, xs):
        qg_n, kd_n, v_n, dec_n = xs
        o_n = jnp.einsum('bhcd,bhdv->bhcv', qg_n, state)
        state = dec_n[..., None] * state + jnp.einsum('bhcd,bhcv->bhdv', kd_n, v_n)
        return state, o_n

    xs = (qg.transpose(2, 0, 1, 3, 4), kd.transpose(2, 0, 1, 3, 4), vc.transpose(2, 0, 1, 3, 4),
          jnp.exp(b_last[:, :, :, 0, :]).transpose(2, 0, 1, 3))
    state0 = jnp.zeros((B, H, dk, dv), jnp.float32)
    _, o_inter = lax.scan(step, state0, xs)
    o = o_intra + o_inter.transpose(1, 2, 0, 3, 4)
    return o.transpose(0, 2, 3, 1, 4).reshape(B, S, H, dv)


def dilated_group_attention(q, k, v, window, dilation):
    B, S, H, Dh = q.shape
    r = dilation
    L = S // r
    blk = window // dilation
    nblk = -(-L // blk)
    Lp = nblk * blk

    def to_sub(t):
        t = t.reshape(B, L, r, H, Dh).transpose(0, 2, 3, 1, 4)
        t = jnp.pad(t, ((0, 0), (0, 0), (0, 0), (0, Lp - L), (0, 0)))
        return t.reshape(B, r, H, nblk, blk, Dh)

    def with_prev(t):
        prev = jnp.pad(t, ((0, 0), (0, 0), (0, 0), (1, 0), (0, 0), (0, 0)))[:, :, :, :-1]
        return jnp.concatenate([prev, t], axis=-2)

    qb = to_sub(q)
    kc = with_prev(to_sub(k))
    vc = with_prev(to_sub(v))
    s = jnp.einsum('brhnid,brhnjd->brhnij', qb, kc).astype(jnp.float32) * (Dh ** -0.5)
    i_idx = jnp.arange(blk)[:, None]
    j_idx = jnp.arange(2 * blk)[None, :]
    dist = i_idx + blk - j_idx
    band = (dist >= 0) & (dist <= blk)
    n_idx = jnp.arange(nblk)[:, None, None]
    valid = band[None] & ((n_idx > 0) | (j_idx >= blk)[None])
    s = jnp.where(valid, s, -jnp.inf)
    m = jnp.max(s, axis=-1, keepdims=True)
    p = jnp.exp(s - m)
    denom = jnp.sum(p, axis=-1, keepdims=True)
    o = jnp.einsum('brhnij,brhnjd->brhnid', p, vc.astype(jnp.float32)) / denom
    lse = (m + jnp.log(denom))[..., 0]
    o = o.reshape(B, r, H, Lp, Dh)[:, :, :, :L].transpose(0, 3, 1, 2, 4).reshape(B, S, H, Dh)
    lse = lse.reshape(B, r, H, Lp)[..., :L].transpose(0, 3, 1, 2).reshape(B, S, H)
    return o, lse


def dilated_attention(aq, ak, av, positions):
    B, S, _ = aq.shape
    q = rotary(aq.reshape(B, S, ATTN_HEADS, ATTN_HEAD_DIM), positions)
    k = rotary(ak.reshape(B, S, ATTN_HEADS, ATTN_HEAD_DIM), positions)
    v = av.reshape(B, S, ATTN_HEADS, ATTN_HEAD_DIM)
    outs, lses = [], []
    for g, (window, dilation) in enumerate(ATTN_GROUPS):
        sl = slice(g * ATTN_HEADS_PER_GROUP, (g + 1) * ATTN_HEADS_PER_GROUP)
        o_g, lse_g = dilated_group_attention(q[:, :, sl], k[:, :, sl], v[:, :, sl], window, dilation)
        outs.append(o_g)
        lses.append(lse_g)
    wts = jax.nn.softmax(jnp.stack(lses, axis=0), axis=0)
    o = jnp.sum(wts[..., None] * jnp.stack(outs, axis=0), axis=0)
    return o.reshape(B, S, ATTN_OUT_WIDTH).astype(aq.dtype)


def causal_conv_ffn_hidden(h, w_up, conv_w, conv_b):
    S = h.shape[1]
    u = h @ w_up
    up = jnp.pad(u, ((0, 0), (CONV_WIDTH - 1, 0), (0, 0)))
    u = conv_b + sum(conv_w[i] * up[:, i:i + S] for i in range(CONV_WIDTH))
    value, gate = jnp.split(u, 2, axis=-1)
    return jax.nn.gelu(gate, approximate=False) * value


def setup_inputs(seed: int = 0) -> dict:
    key = jax.random.key(seed)
    ks = jax.random.split(key, 20)
    f32 = jnp.float32

    def nrm(k, shape, scale):
        return jax.random.normal(k, shape, f32) * scale

    def gain(k, shape):
        return 1.0 + 0.02 * jax.random.normal(k, shape, f32)

    L = DEPTH
    x = nrm(ks[0], (BATCH, SEQ, D_MODEL), 1.0)
    c = nrm(ks[1], (BATCH, D_MODEL), 1.0)
    positions = (jax.random.randint(ks[2], (BATCH, 1), 0, 1024, dtype=jnp.int32)
                 + jnp.arange(SEQ, dtype=jnp.int32)[None, :])
    return {
        'x': x,
        'c': c,
        'positions': positions,
        'ada_w': nrm(ks[3], (L, D_MODEL, 6 * D_MODEL), D_MODEL ** -0.5),
        'ada_b': nrm(ks[4], (L, 6 * D_MODEL), 0.02),
        'norm1_w': gain(ks[5], (L, D_MODEL)),
        'w_in': nrm(ks[6], (L, D_MODEL, D_IN), D_MODEL ** -0.5),
        'gla_gate_w2': nrm(ks[7], (L, GLA_LOWRANK, GLA_QK_WIDTH), GLA_LOWRANK ** -0.5),
        'gla_gate_b': nrm(ks[8], (L, GLA_QK_WIDTH), 0.1),
        'gla_norm_w': gain(ks[9], (L, GLA_DV)),
        'w_gla_branch': nrm(ks[10], (L, GLA_V_WIDTH, D_MODEL), GLA_V_WIDTH ** -0.5),
        'w_attn_branch': nrm(ks[11], (L, ATTN_OUT_WIDTH, D_MODEL), ATTN_OUT_WIDTH ** -0.5),
        'w_out': nrm(ks[12], (L, D_MODEL, D_MODEL), D_MODEL ** -0.5),
        'norm2_w': gain(ks[13], (L, D_MODEL)),
        'w_up': nrm(ks[14], (L, D_MODEL, 2 * D_FF), D_MODEL ** -0.5),
        'conv_w': nrm(ks[15], (L, CONV_WIDTH, 2 * D_FF), CONV_WIDTH ** -0.5),
        'conv_b': nrm(ks[16], (L, 2 * D_FF), 0.01),
        'w_down': nrm(ks[17], (L, D_FF, D_MODEL), D_FF ** -0.5),
        'final_norm_w': gain(ks[18], (D_MODEL,)),
    }


def reference(x, c, positions, ada_w, ada_b, norm1_w, w_in, gla_gate_w2, gla_gate_b, gla_norm_w,
              w_gla_branch, w_attn_branch, w_out, norm2_w, w_up, conv_w, conv_b, w_down, final_norm_w):
    B, S, _ = x.shape
    split_at = np.cumsum(IN_WIDTHS)[:-1].tolist()
    for layer in range(DEPTH):
        mod = jax.nn.silu(c) @ ada_w[layer] + ada_b[layer]
        shift1, scale1, gate1, shift2, scale2, gate2 = jnp.split(mod[:, None, :], 6, axis=-1)

        h = rmsnorm(x, norm1_w[layer]) * (1 + scale1) + shift1
        gq, gk, gv, gr, g_lr, aq, ak, av, merge_a, merge_b = jnp.split(h @ w_in[layer], split_at, axis=-1)

        log_a = jax.nn.log_sigmoid((g_lr @ gla_gate_w2[layer] + gla_gate_b[layer]).astype(jnp.float32)) / GLA_TAU
        o_gla = gla_chunked(gq.reshape(B, S, GLA_HEADS, GLA_DK), gk.reshape(B, S, GLA_HEADS, GLA_DK),
                            gv.reshape(B, S, GLA_HEADS, GLA_DV), log_a.reshape(B, S, GLA_HEADS, GLA_DK))
        o_gla = rmsnorm(o_gla.astype(x.dtype), gla_norm_w[layer]).reshape(B, S, GLA_V_WIDTH) * jax.nn.silu(gr)
        y_gla = o_gla @ w_gla_branch[layer]

        y_attn = dilated_attention(aq, ak, av, positions) @ w_attn_branch[layer]

        mixed = jax.nn.sigmoid(merge_a) * y_gla + jax.nn.sigmoid(merge_b) * y_attn
        x = x + gate1 * (mixed @ w_out[layer])

        h2 = rmsnorm(x, norm2_w[layer]) * (1 + scale2) + shift2
        hidden = causal_conv_ffn_hidden(h2, w_up[layer], conv_w[layer], conv_b[layer])
        x = x + gate2 * (hidden @ w_down[layer])
    return rmsnorm(x, final_norm_w)
```

```cpp
#include <hip/hip_runtime.h>
#include <hip/hip_cooperative_groups.h>
#include <cstdio>
#include <cstdint>
namespace cg = cooperative_groups;


#define LAS __attribute__((address_space(3)))
typedef unsigned short bf16_t;
typedef short bf16x8 __attribute__((ext_vector_type(8)));
typedef float f32x4 __attribute__((ext_vector_type(4)));
typedef float f32x2 __attribute__((ext_vector_type(2)));
typedef unsigned u32x4 __attribute__((ext_vector_type(4)));
typedef unsigned u32x2 __attribute__((ext_vector_type(2)));

constexpr int NB = 4, SEQ = 4096, DM = 1024, NT = NB * SEQ;
constexpr int DIN = 7440, NMAIN = 5376, NGATE = 2048;
constexpr int C_GQ = 0, C_GK = 512, C_GV = 1024, C_GR = 2048, C_AQ = 3072, C_AK = 3840, C_AV = 4608;
constexpr int DFF = 2816, NUP = 5632;
constexpr float EPS = 1e-6f;

constexpr size_t KiB = 1024, MiB = 1024 * 1024;
constexpr size_t WS_MOD = 256 * KiB;
constexpr size_t WS_WLR = 512 * KiB;
constexpr size_t WS_SSQ = 768 * KiB;
constexpr size_t WS_GLR = 1 * MiB;
constexpr size_t WS_LSE = 2 * MiB;
constexpr size_t WS_MODP = 3 * MiB;
constexpr size_t WS_ROPE = 6 * MiB;
constexpr size_t WS_WMAIN = 10 * MiB;
constexpr size_t WS_WMAB = WS_WMAIN + (size_t)NMAIN * DM * 2;
constexpr size_t WS_WG = WS_WMAB + (size_t)NGATE * DM * 2;
constexpr size_t WS_WA = WS_WG + (size_t)DM * DM * 2;
constexpr size_t WS_WOUT = WS_WA + (size_t)DM * 256 * 2;
constexpr size_t WS_WUP = WS_WOUT + (size_t)DM * DM * 2;
constexpr size_t WS_WDOWN = WS_WUP + (size_t)NUP * DM * 2;
constexpr size_t WS_WEND = WS_WDOWN + (size_t)DM * DFF * 2;
constexpr size_t WS_HBUF = 47 * MiB;
constexpr size_t WS_BIG = 79 * MiB;
constexpr size_t WS_END = 255 * MiB;
static_assert(WS_WEND <= WS_HBUF, "weights overflow");

constexpr int LDS_BYTES = 147456;

__device__ const double INVF_REV[32] = {
1.59154943091895346e-01, 1.19349370211248862e-01, 8.94994016088910133e-02, 6.71150830052272551e-02, 5.03292121044870353e-02, 3.77415847174197711e-02, 2.83021958306233987e-02, 2.12236527647776604e-02,
1.59154943091895339e-02, 1.19349370211248862e-02, 8.94994016088910237e-03, 6.71150830052272534e-03, 5.03292121044870370e-03, 3.77415847174197719e-03, 2.83021958306233987e-03, 2.12236527647776622e-03,
1.59154943091895356e-03, 1.19349370211248849e-03, 8.94994016088910237e-04, 6.71150830052272599e-04, 5.03292121044870326e-04, 3.77415847174197741e-04, 2.83021958306233954e-04, 2.12236527647776605e-04,
1.59154943091895351e-04, 1.19349370211248862e-04, 8.94994016088910182e-05, 6.71150830052272545e-05, 5.03292121044870354e-05, 3.77415847174197768e-05, 2.83021958306233961e-05, 2.12236527647776592e-05};

__device__ __forceinline__ float bf2f(bf16_t v) { return __uint_as_float((unsigned)v << 16); }

typedef __bf16 bf16x2_hw __attribute__((ext_vector_type(2)));
__device__ __forceinline__ unsigned f2bf(float f) { return (unsigned)__builtin_bit_cast(unsigned short, (__bf16)f); }
__device__ __forceinline__ unsigned pk2(float lo, float hi) { const f32x2 v = {lo, hi}; return __builtin_bit_cast(unsigned, __builtin_convertvector(v, bf16x2_hw)); }
__device__ __forceinline__ float lo16(unsigned w) { return __uint_as_float(w << 16); }
__device__ __forceinline__ float hi16(unsigned w) { return __uint_as_float(w & 0xffff0000u); }
__device__ __forceinline__ void unpack8(u32x4 w, float* f) { f[0] = lo16(w.x); f[1] = hi16(w.x); f[2] = lo16(w.y); f[3] = hi16(w.y); f[4] = lo16(w.z); f[5] = hi16(w.z); f[6] = lo16(w.w); f[7] = hi16(w.w); }
__device__ __forceinline__ u32x4 pack8(const float* f) { u32x4 w; w.x = pk2(f[0], f[1]); w.y = pk2(f[2], f[3]); w.z = pk2(f[4], f[5]); w.w = pk2(f[6], f[7]); return w; }
__device__ __forceinline__ float wave_sum(float v) {
#pragma unroll
    for (int o = 1; o < 64; o <<= 1) v += __shfl_xor(v, o);
    return v;
}
__device__ __forceinline__ float sigmoidf_(float x) { return __builtin_amdgcn_rcpf(1.0f + __expf(-x)); }

namespace pg8 {
constexpr int BM = 256, BK = 64, HALF = 128, HTB = HALF * BK * 2, STAGE_BYTES = 8 * HTB, NXCD = 8, WGM = 8;
__host__ __device__ __forceinline__ int lds_byte(int r, int c) { const int st = (r >> 4) * 2 + (c >> 5), rr = r & 15, cc = c & 31, ob = rr * 64 + cc * 2; return st * 1024 + (ob ^ (((ob >> 9) & 1) << 5)); }
__host__ __device__ __forceinline__ void stage_rc(int b, int& R, int& C) { const int st = b / 1024, sb = b % 1024, swz = sb ^ (((sb >> 9) & 1) << 5); R = (st >> 1) * 16 + swz / 64; C = (st & 1) * 32 + (swz % 64) / 2; }
__host__ __device__ __forceinline__ int perm32(int rho) { const int n = rho >> 4, i = rho & 15; return 8 * (i >> 2) + 4 * n + (i & 3); }

struct Unit { int pm, pn; };
struct Gemm { const bf16_t* A; const bf16_t* Bt; int M, N, K, lda, ldb; };

struct StaticOrder {
    int nM, nN, nwg, G, c;
    __host__ __device__ void init(int M, int N, int G_, int c_) { nM = M / BM; nN = N / BM; nwg = nM * nN; G = G_; c = c_; }
    __host__ __device__ void init_tiles(int nM_, int nN_, int G_, int c_) { nM = nM_; nN = nN_; nwg = nM * nN; G = G_; c = c_; }
    __host__ __device__ bool next(int i, Unit& u) const {
        const long L = (long)i * G + c; if (L >= nwg) return false;
        int wgid = (int)L; { const int q = nwg / NXCD, r = nwg % NXCD, xcd = wgid % NXCD, off = wgid / NXCD; wgid = (xcd < r ? xcd * (q + 1) : r * (q + 1) + (xcd - r) * q) + off; }
        const int nig = WGM * nN, gid = wgid / nig, fm = gid * WGM, gsz = (nM - fm) < WGM ? (nM - fm) : WGM;
        u.pm = fm + ((wgid % nig) % gsz); u.pn = (wgid % nig) / gsz; return true;
    }
};

template <class F> struct EpiRow8 {
    static constexpr bool PERM = true, AFTER_DRAIN = false, MIDHOOK = false;
    F f;
    __device__ __forceinline__ void operator()(const f32x4 (&acc)[2][2][4][2], const Unit& u, int wr, int wc, int fr, int fq) const {
        const int row0 = u.pm * BM + wr * 64 + fr, col0 = u.pn * BM + wc * 32 + 8 * fq;
#pragma unroll
        for (int ai = 0; ai < 2; ++ai)
#pragma unroll
            for (int m = 0; m < 4; ++m) {
#pragma unroll
                for (int bj = 0; bj < 2; ++bj) f(row0 + ai * HALF + m * 16, col0 + bj * HALF, acc[ai][bj][m][0], acc[ai][bj][m][1]);
                if (m == 3) asm volatile("" ::: "memory");
            }
    }
};

template <class Epi, bool ALIGN_EPI = true, bool CONVMAP = false, int AKSPLIT = 0>
__device__ __forceinline__ void gemm_phase(LAS unsigned char* lds, const Gemm g, const StaticOrder& S, const Epi& E) {
    int tid_ = threadIdx.x; asm volatile("" : "+v"(tid_));
    const int tid = tid_, wid = __builtin_amdgcn_readfirstlane(tid >> 6), lane = tid & 63, wr = wid >> 2, wc = wid & 3, fr = lane & 15, fq = lane >> 4;
    const int K = g.K, nt = K / BK;
    unsigned voffA[2], voffB[2];
#pragma unroll
    for (int i = 0; i < 2; ++i) { int R, C; stage_rc(tid * 16 + i * 8192, R, C); const int Rb = Epi::PERM ? ((R & ~31) + perm32(R & 31)) : R;
        const int Ra = CONVMAP ? (126 * (R >> 6) + 8 * (R & 15) + ((R >> 4) & 3)) : R;
        voffA[i] = (unsigned)(Ra * g.lda + C) * 2u; voffB[i] = (unsigned)(Rb * g.ldb + C) * 2u; }
    const unsigned kstep = (unsigned)(BK * 2);
    const unsigned hstepA = (unsigned)(CONVMAP ? 4 : HALF) * g.lda * 2, hstepB = (unsigned)HALF * g.ldb * 2;
    const unsigned tstepA = CONVMAP ? 252u * g.lda * 2 : 2 * hstepA, tstepB = 2 * hstepB;
    const char* const baseA = (const char*)g.A; const char* const baseB = (const char*)g.Bt;
    const unsigned ldsw = (unsigned)wid * 1024u;
    const int aoff = lds_byte(wr * 64 + fr, fq * 8), boff = lds_byte(wc * 32 + fr, fq * 8);
#define PG8_SA(b, h) (((b) * 2 + (h)) * HTB)
#define PG8_SB(b, h) ((4 + (b) * 2 + (h)) * HTB)
#define PG8_STAGE(bufoff, goff, voff) do { _Pragma("unroll") for (int _i = 0; _i < 2; ++_i) { unsigned _vo = (voff)[_i] + (goff); asm volatile("" : "+v"(_vo)); \
        __builtin_amdgcn_global_load_lds((const unsigned*)(base_##voff + _vo), (LAS unsigned*)(lds + (bufoff) + ldsw + _i * 8192), 16, 0, 0); } } while (0)
#define base_voffA baseA
#define base_voffB baseB
#define PG8_LDA(dst, b, h) do { _Pragma("unroll") for (int m = 0; m < 4; ++m) _Pragma("unroll") for (int k = 0; k < 2; ++k) dst[m][k] = *(const LAS bf16x8*)(lds + PG8_SA(b, h) + aoff + m * 2048 + k * 1024); } while (0)
#define PG8_LDB(dst, b, h) do { _Pragma("unroll") for (int n = 0; n < 2; ++n) _Pragma("unroll") for (int k = 0; k < 2; ++k) dst[n][k] = *(const LAS bf16x8*)(lds + PG8_SB(b, h) + boff + n * 2048 + k * 1024); } while (0)
#define PG8_MMA(ai, bj, At, Bt) do { __builtin_amdgcn_s_setprio(1); _Pragma("unroll") for (int m = 0; m < 4; ++m) _Pragma("unroll") for (int n = 0; n < 2; ++n) _Pragma("unroll") for (int k = 0; k < 2; ++k) \
        acc[ai][bj][m][n] = __builtin_amdgcn_mfma_f32_16x16x32_bf16(Bt[n][k], At[m][k], acc[ai][bj][m][n], 0, 0, 0); __builtin_amdgcn_s_setprio(0); } while (0)
#define PG8_KOFFA(x) ((unsigned)(x) * kstep + (AKSPLIT ? ((x) < 4 ? 2048u : 0xFFFFFE00u) : 0u))
#define PG8_WAIT_V(n) asm volatile("s_waitcnt vmcnt(" #n ")" ::: "memory")
#define PG8_WAIT_L(n) asm volatile("s_waitcnt lgkmcnt(" #n ")" ::: "memory")
#define PG8_BAR __builtin_amdgcn_s_barrier()
#define PG8_SCHED __builtin_amdgcn_sched_barrier(0)
    Unit cur, nxt; int ui = 0;
    if (!S.next(0, cur)) return;
    f32x4 acc[2][2][4][2];
#pragma unroll
    for (int a = 0; a < 2; ++a)
#pragma unroll
        for (int b = 0; b < 2; ++b)
#pragma unroll
            for (int m = 0; m < 4; ++m)
#pragma unroll
                for (int n = 0; n < 2; ++n) acc[a][b][m][n] = (f32x4){0.f, 0.f, 0.f, 0.f};
    bf16x8 At[4][2], B0[2][2], B1[2][2];
    unsigned cA = (unsigned)cur.pm * tstepA, cB = (unsigned)cur.pn * tstepB;
    PG8_STAGE(PG8_SB(0, 0), cB, voffB); PG8_STAGE(PG8_SB(0, 1), cB + hstepB, voffB); PG8_STAGE(PG8_SA(0, 0), cA + PG8_KOFFA(0), voffA); PG8_STAGE(PG8_SA(0, 1), cA + hstepA + PG8_KOFFA(0), voffA);
    if (wr == 1) PG8_BAR;
    PG8_WAIT_V(2); PG8_BAR;
    PG8_STAGE(PG8_SB(1, 0), cB + kstep, voffB); PG8_STAGE(PG8_SA(1, 0), cA + PG8_KOFFA(1), voffA); PG8_STAGE(PG8_SB(1, 1), cB + hstepB + kstep, voffB);
    PG8_WAIT_V(6); PG8_BAR;
    for (;;) {
        const bool has_next = S.next(ui + 1, nxt);
        const unsigned nA = has_next ? (unsigned)nxt.pm * tstepA : cA, nB = has_next ? (unsigned)nxt.pn * tstepB : cB;
#define PG8_ITER(t) do { \
            const bool last = (t == nt - 2); \
            const unsigned a1 = cA + PG8_KOFFA(t + 1); \
            const unsigned a2 = last ? nA + PG8_KOFFA(0) : cA + PG8_KOFFA(t + 2), b2 = last ? nB : cB + (unsigned)(t + 2) * kstep; \
            const unsigned a3 = a2 + kstep, b3 = b2 + kstep; \
            PG8_LDB(B0, 0, 0); PG8_LDB(B1, 0, 1); PG8_SCHED; PG8_LDA(At, 0, 0); PG8_STAGE(PG8_SA(1, 1), a1 + hstepA, voffA); \
            PG8_WAIT_V(8); PG8_WAIT_L(0); PG8_BAR; PG8_MMA(0, 0, At, B0); PG8_MMA(0, 1, At, B1); PG8_BAR; PG8_SCHED; \
            PG8_LDA(At, 0, 1); PG8_STAGE(PG8_SB(0, 0), b2, voffB); PG8_STAGE(PG8_SB(0, 1), b2 + hstepB, voffB); PG8_STAGE(PG8_SA(0, 0), a2, voffA); \
            PG8_WAIT_V(8); PG8_WAIT_L(0); PG8_BAR; PG8_MMA(1, 0, At, B0); PG8_MMA(1, 1, At, B1); PG8_BAR; PG8_SCHED; \
            PG8_LDB(B0, 1, 0); PG8_LDB(B1, 1, 1); PG8_SCHED; PG8_LDA(At, 1, 0); PG8_STAGE(PG8_SA(0, 1), a2 + hstepA, voffA); \
            PG8_WAIT_V(8); PG8_WAIT_L(0); PG8_BAR; PG8_MMA(0, 0, At, B0); PG8_MMA(0, 1, At, B1); PG8_BAR; PG8_SCHED; \
            PG8_LDA(At, 1, 1); PG8_STAGE(PG8_SB(1, 0), b3, voffB); PG8_STAGE(PG8_SB(1, 1), b3 + hstepB, voffB); PG8_STAGE(PG8_SA(1, 0), a3, voffA); \
            PG8_WAIT_V(8); PG8_WAIT_L(0); PG8_BAR; PG8_MMA(1, 0, At, B0); PG8_MMA(1, 1, At, B1); PG8_BAR; PG8_SCHED; \
        } while (0)
        if constexpr (Epi::MIDHOOK) {
            for (int t = 0; t < 4; t += 2) PG8_ITER(t);
            E.mid(acc, cur, wr, wc, fr, fq);
            for (int t = 4; t < nt; t += 2) PG8_ITER(t);
        } else {
            for (int t = 0; t < nt; t += 2) PG8_ITER(t);
        }
#undef PG8_ITER
        if constexpr (ALIGN_EPI) { if (wr == 0) PG8_BAR; }
        if constexpr (!Epi::AFTER_DRAIN) { E(acc, cur, wr, wc, fr, fq); }
        if (!has_next) break;
#pragma unroll
        for (int a = 0; a < 2; ++a)
#pragma unroll
            for (int b = 0; b < 2; ++b)
#pragma unroll
                for (int m = 0; m < 4; ++m)
#pragma unroll
                    for (int n = 0; n < 2; ++n) acc[a][b][m][n] = (f32x4){0.f, 0.f, 0.f, 0.f};
        cur = nxt; cA = nA; cB = nB; ++ui;
        if constexpr (ALIGN_EPI) { if (wr == 1) PG8_BAR; }
    }
    PG8_WAIT_V(0);
    if constexpr (!ALIGN_EPI) { if (wr == 0) PG8_BAR; }
    PG8_BAR;
    if constexpr (Epi::AFTER_DRAIN) { E.fused(acc, cur, wr, wc, fr, fq, lds, wid, lane); }
#undef PG8_SA
#undef PG8_SB
#undef PG8_STAGE
#undef base_voffA
#undef base_voffB
#undef PG8_LDA
#undef PG8_LDB
#undef PG8_MMA
#undef PG8_WAIT_V
#undef PG8_KOFFA
#undef PG8_WAIT_L
#undef PG8_BAR
#undef PG8_SCHED
}
}


#define XB_TMO      128
#define XB_XCNT(j)  (256  + 64 * (j))
#define XB_XSUB(j)  (1280 + 64 * (j))
#define XB_XGEN(j)  (2304 + 64 * (j))
#define XB_TOP      3328
#define XB_TOPGEN   3392
#define XCD_BAR_WORDS 3456
#define XB_SPIN_CAP (1u << 18)
__device__ __forceinline__ unsigned xb_ld(unsigned* p)              { return __hip_atomic_load(p, __ATOMIC_RELAXED, __HIP_MEMORY_SCOPE_AGENT); }
__device__ __forceinline__ unsigned xb_add(unsigned* p, unsigned v) { return __hip_atomic_fetch_add(p, v, __ATOMIC_RELAXED, __HIP_MEMORY_SCOPE_AGENT); }
__device__ __forceinline__ unsigned xb_xcc_id() { return (unsigned)__builtin_amdgcn_s_getreg((3 << 11) | 20) & 0xFu; }
#define XB_SPIN(cond, bar) do { unsigned _sp = 0; while (cond) { __builtin_amdgcn_s_sleep(1); \
    if ((++_sp & 255u) == 0u) { if (xb_ld(&(bar)[XB_TMO])) break; if (_sp > XB_SPIN_CAP) { atomicAdd(&(bar)[XB_TMO], 1u); break; } } } } while (0)
struct XcdBarrier { unsigned* bar; unsigned x; volatile LAS unsigned* st; };
__device__ __forceinline__ XcdBarrier xcd_barrier_post(unsigned* bar, volatile LAS unsigned* st) {
    XcdBarrier b; b.bar = bar; b.x = xb_xcc_id(); b.st = st;
    if (threadIdx.x == 0) (void)xb_add(&bar[XB_XCNT(b.x)], 1u);
    return b;
}
__device__ __forceinline__ void xcd_barrier_complete(unsigned* bar, unsigned x, unsigned& nloc, unsigned& nx) {
    const unsigned G = gridDim.x * gridDim.y * gridDim.z;
    unsigned sum, cnt, mine, sp = 0u;
    for (;;) {
        sum = 0u; cnt = 0u; mine = 0u;
#pragma unroll
        for (unsigned j = 0; j < 16; ++j) { const unsigned c = xb_ld(&bar[XB_XCNT(j)]); sum += c; cnt += (c > 0u) ? 1u : 0u; mine = (j == x) ? c : mine; }
        if (sum == G) break;
        __builtin_amdgcn_s_sleep(1);
        if ((++sp & 255u) == 0u) { if (xb_ld(&bar[XB_TMO])) break; if (sp > XB_SPIN_CAP) { atomicAdd(&bar[XB_TMO], 1u); break; } }
    }
    nloc = mine > 0u ? mine : 1u; nx = cnt > 0u ? cnt : 1u;
}
__device__ __forceinline__ void xcd_barrier(const XcdBarrier& b) {
    asm volatile("s_waitcnt vmcnt(0)" ::: "memory");
    __syncthreads();
    if (threadIdx.x == 0) {
        unsigned* bar = b.bar;
        __builtin_amdgcn_s_waitcnt(0);
        unsigned nloc = b.st[0], nx = b.st[1];
        if (nloc == 0u) { xcd_barrier_complete(bar, b.x, nloc, nx); b.st[0] = nloc; b.st[1] = nx; }
        const unsigned old = xb_add(&bar[XB_XSUB(b.x)], 1u);
        const unsigned gen = old / nloc;
        if (old + 1u == (gen + 1u) * nloc) {
            __builtin_amdgcn_fence(__ATOMIC_RELEASE, "agent");
            asm volatile("s_waitcnt vmcnt(0)" ::: "memory");
            const unsigned og = xb_add(&bar[XB_TOP], 1u);
            const unsigned tg = og / nx;
            if (og + 1u == (tg + 1u) * nx) xb_add(&bar[XB_TOPGEN], 1u);
            else XB_SPIN(xb_ld(&bar[XB_TOPGEN]) == tg, bar);
            __builtin_amdgcn_fence(__ATOMIC_ACQUIRE, "agent");
            xb_add(&bar[XB_XGEN(b.x)], 1u);
            asm volatile("s_waitcnt vmcnt(0)" ::: "memory");
        } else {
            XB_SPIN(xb_ld(&bar[XB_XGEN(b.x)]) == gen, bar);
            __builtin_amdgcn_fence(__ATOMIC_ACQUIRE, "agent");
            asm volatile("s_waitcnt vmcnt(0)" ::: "memory");
        }
    }
    __syncthreads();
}

struct Args {
    const float* x; const float* c; const int* positions; const float* ada_w; const float* ada_b; const float* norm1_w; const float* w_in;
    const float* gate_w2; const float* gate_b; const float* gla_norm_w; const float* w_gla; const float* w_attn; const float* w_out; const float* norm2_w;
    const float* w_up; const float* conv_w; const float* conv_b; const float* w_down; const float* final_w;
    float* out; unsigned char* ws;
};

typedef const __attribute__((address_space(4))) Args* KArgs;
__device__ __forceinline__ KArgs kargs() { KArgs p = (KArgs)__builtin_amdgcn_kernarg_segment_ptr(); asm volatile("" : "+s"(p)); return p; }

struct Ctx { int tid, lane, wave, gtid, nthr, gw, ngw; LAS unsigned char* lds; };

__device__ __forceinline__ Ctx make_ctx(unsigned char* lds_raw) {
    Ctx X; int t = threadIdx.x; asm volatile("" : "+v"(t)); X.tid = t; X.lane = X.tid & 63; X.wave = __builtin_amdgcn_readfirstlane(X.tid >> 6);
    X.gtid = blockIdx.x * 512 + X.tid; X.nthr = gridDim.x * 512; X.gw = blockIdx.x * 8 + X.wave; X.ngw = gridDim.x * 8; X.lds = (LAS unsigned char*)lds_raw; return X; }

template <int ID, class F> __device__ __forceinline__ void run_gemm(const Ctx& X, const pg8::Gemm g, const F& f) {
    pg8::StaticOrder S; S.init(g.M, g.N, (int)gridDim.x, (int)blockIdx.x);
    pg8::EpiRow8<F> E{f};
    pg8::gemm_phase<pg8::EpiRow8<F>, true>(X.lds, g, S, E);
}

struct FStoreProj { bf16_t* O; const f32x2* rope;
    __device__ __forceinline__ void operator()(int row, int col, f32x4 v0, f32x4 v1) const {
        if (col >= C_AQ && col < C_AV) { const int g8 = ((col - C_AQ) & 63) >> 3; const f32x4* rp = (const f32x4*)(rope + (size_t)row * 32 + 4 * g8); const f32x4 r0 = rp[0], r1 = rp[1];
            const f32x4 cs = {r0[0], r0[2], r1[0], r1[2]}, sn = {r0[1], r0[3], r1[1], r1[3]}; const float sc = col < C_AK ? 0.125f : 1.0f;
            const f32x4 a0 = (v0 * cs - v1 * sn) * sc, a1 = (v1 * cs + v0 * sn) * sc; v0 = a0; v1 = a1; }
        u32x4 w; w.x = pk2(v0[0], v0[1]); w.y = pk2(v0[2], v0[3]); w.z = pk2(v1[0], v1[1]); w.w = pk2(v1[2], v1[3]);
        *(u32x4*)(O + (size_t)row * NMAIN + col) = w; } };
struct FSigmoidSplit { bf16_t* GA; bf16_t* GB;
    __device__ __forceinline__ void operator()(int row, int col, f32x4 v0, f32x4 v1) const {
        u32x4 w; w.x = pk2(sigmoidf_(v0[0]), sigmoidf_(v0[1])); w.y = pk2(sigmoidf_(v0[2]), sigmoidf_(v0[3])); w.z = pk2(sigmoidf_(v1[0]), sigmoidf_(v1[1])); w.w = pk2(sigmoidf_(v1[2]), sigmoidf_(v1[3]));
        if (col < 1024) *(u32x4*)(GA + (size_t)row * DM + col) = w; else *(u32x4*)(GB + (size_t)row * NMAIN + (col - 1024)) = w; } };
__device__ __forceinline__ f32x2 gelu_pk(f32x2 v) {
    const f32x2 av = __builtin_elementwise_abs(v), d = av * 0.2316418882f + 1.0f;
    f32x2 t; t.x = __builtin_amdgcn_rcpf(d.x); t.y = __builtin_amdgcn_rcpf(d.y);
    f32x2 q = t * 0.5307027145f + (-0.7265760135f); q = q * t + 0.7107068705f; q = q * t + (-0.142248368f); q = q * t + 0.127414796f; q = q * t;
    const f32x2 s = (v * v) * (-0.72134752044f);
    f32x2 e; e.x = __builtin_amdgcn_exp2f(s.x); e.y = __builtin_amdgcn_exp2f(s.y);
    const f32x2 m = v * (q * e), r = v - m;
    f32x2 o; o.x = v.x < 0.f ? m.x : r.x; o.y = v.y < 0.f ? m.y : r.y; return o;
}
__device__ __forceinline__ f32x4 dpp_shr1(f32x4 x) {
    f32x4 r;
#pragma unroll
    for (int j = 0; j < 4; ++j) r[j] = __int_as_float(__builtin_amdgcn_update_dpp(0, __float_as_int(x[j]), 0x111, 0xf, 0xf, false));
    return r;
}
struct EpiConvGeglu {
    static constexpr bool PERM = true, AFTER_DRAIN = false, MIDHOOK = false;
    bf16_t* hidden; const float* conv_w; const float* conv_b;
    template <bool EDGE> __device__ __forceinline__ void body(const f32x4 (&acc)[2][2][4][2], const pg8::Unit& u, int wr, int wc, int fr, int fq) const {
        const int tw0 = 252 * u.pm - 2 + 126 * wr;
        const int chb = 128 * u.pn + 32 * wc + 8 * fq;
#pragma unroll
        for (int n = 0; n < 2; ++n) {
            const int ch = chb + 4 * n;
            const f32x4 wv0 = *(const f32x4*)(conv_w + ch), wv1 = *(const f32x4*)(conv_w + NUP + ch), wv2 = *(const f32x4*)(conv_w + 2 * NUP + ch), bv = *(const f32x4*)(conv_b + ch);
            const f32x4 wg0 = *(const f32x4*)(conv_w + DFF + ch), wg1 = *(const f32x4*)(conv_w + NUP + DFF + ch), wg2 = *(const f32x4*)(conv_w + 2 * NUP + DFF + ch), bg = *(const f32x4*)(conv_b + DFF + ch);
            const f32x4 v7 = dpp_shr1(acc[1][0][3][n]), v6 = dpp_shr1(acc[1][0][2][n]), g7 = dpp_shr1(acc[1][1][3][n]), g6 = dpp_shr1(acc[1][1][2][n]);
#pragma unroll
            for (int k = 0; k < 8; ++k) {
                const int ai = k >> 2, m = k & 3, lr = 8 * fr + k, tau = tw0 + lr, sp = tau & 4095;
                const f32x4 cv = acc[ai][0][m][n], cg = acc[ai][1][m][n];
                const f32x4 p1v = k >= 1 ? acc[(k >= 1 ? k - 1 : 0) >> 2][0][(k >= 1 ? k - 1 : 0) & 3][n] : v7;
                const f32x4 p1g = k >= 1 ? acc[(k >= 1 ? k - 1 : 0) >> 2][1][(k >= 1 ? k - 1 : 0) & 3][n] : g7;
                const f32x4 p2v = k >= 2 ? acc[(k >= 2 ? k - 2 : 0) >> 2][0][(k >= 2 ? k - 2 : 0) & 3][n] : (k == 1 ? v7 : v6);
                const f32x4 p2g = k >= 2 ? acc[(k >= 2 ? k - 2 : 0) >> 2][1][(k >= 2 ? k - 2 : 0) & 3][n] : (k == 1 ? g7 : g6);
                f32x4 val, gat;
                if (EDGE) { const float m1 = sp >= 1 ? 1.f : 0.f, m2 = sp >= 2 ? 1.f : 0.f;
                    val = bv + wv2 * cv + (wv1 * m1) * p1v + (wv0 * m2) * p2v; gat = bg + wg2 * cg + (wg1 * m1) * p1g + (wg0 * m2) * p2g; }
                else { val = bv + wv2 * cv + wv1 * p1v + wv0 * p2v; gat = bg + wg2 * cg + wg1 * p1g + wg0 * p2g; }
                const f32x2 g01 = gelu_pk((f32x2){gat[0], gat[1]}), g23 = gelu_pk((f32x2){gat[2], gat[3]});
                u32x2 w; w.x = pk2(g01.x * val[0], g01.y * val[1]); w.y = pk2(g23.x * val[2], g23.y * val[3]);
                if (lr >= 2 && tau < NT) *(u32x2*)(hidden + (size_t)tau * DFF + ch) = w;
            }
            asm volatile("" ::: "memory");
        }
    }
    __device__ __forceinline__ void operator()(const f32x4 (&acc)[2][2][4][2], const pg8::Unit& u, int wr, int wc, int fr, int fq) const {
        const int tw0 = 252 * u.pm - 2 + 126 * wr;
        const bool edge = (tw0 <= 1) || ((tw0 & 4095) < 2) || (((tw0 + 127) >> 12) != (tw0 >> 12));
        if (edge) body<true>(acc, u, wr, wc, fr, fq); else body<false>(acc, u, wr, wc, fr, fq);
    }
};

struct EpiMixed2 {
    static constexpr bool PERM = true, AFTER_DRAIN = false, MIDHOOK = true;
    const bf16_t* gA; const bf16_t* gB; bf16_t* O;
    __device__ __forceinline__ void mid(f32x4 (&acc)[2][2][4][2], const pg8::Unit& u, int wr, int wc, int fr, int fq) const {
        const int row0 = u.pm * 256 + wr * 64 + fr, col0 = u.pn * 256 + wc * 32 + 8 * fq;
#pragma unroll
        for (int ai = 0; ai < 2; ++ai)
#pragma unroll
            for (int m = 0; m < 4; ++m) { const int row = row0 + ai * 128 + m * 16;
#pragma unroll
                for (int bj = 0; bj < 2; ++bj) { const int col = col0 + bj * 128;
                    const u32x4 aw = *(const u32x4*)((const char*)gA + (unsigned)(row * DM + col) * 2u), bw = *(const u32x4*)((const char*)gB + (unsigned)(row * NMAIN + col) * 2u);
                    f32x4 r0, r1;
                    r0[0] = lo16(bw.x) * __builtin_amdgcn_rcpf(fmaxf(lo16(aw.x), 1e-20f)); r0[1] = hi16(bw.x) * __builtin_amdgcn_rcpf(fmaxf(hi16(aw.x), 1e-20f));
                    r0[2] = lo16(bw.y) * __builtin_amdgcn_rcpf(fmaxf(lo16(aw.y), 1e-20f)); r0[3] = hi16(bw.y) * __builtin_amdgcn_rcpf(fmaxf(hi16(aw.y), 1e-20f));
                    r1[0] = lo16(bw.z) * __builtin_amdgcn_rcpf(fmaxf(lo16(aw.z), 1e-20f)); r1[1] = hi16(bw.z) * __builtin_amdgcn_rcpf(fmaxf(hi16(aw.z), 1e-20f));
                    r1[2] = lo16(bw.w) * __builtin_amdgcn_rcpf(fmaxf(lo16(aw.w), 1e-20f)); r1[3] = hi16(bw.w) * __builtin_amdgcn_rcpf(fmaxf(hi16(aw.w), 1e-20f));
                    acc[ai][bj][m][0] *= r0; acc[ai][bj][m][1] *= r1;
                    asm volatile("" ::: "memory"); } }
    }
    __device__ __forceinline__ void operator()(const f32x4 (&acc)[2][2][4][2], const pg8::Unit& u, int wr, int wc, int fr, int fq) const {
        const int row0 = u.pm * 256 + wr * 64 + fr, col0 = u.pn * 256 + wc * 32 + 8 * fq;
#pragma unroll
        for (int ai = 0; ai < 2; ++ai) {
#pragma unroll
            for (int m = 0; m < 4; ++m) { const int row = row0 + ai * 128 + m * 16;
#pragma unroll
                for (int bj = 0; bj < 2; ++bj) { const int col = col0 + bj * 128; float a8[8]; unpack8(*(const u32x4*)(gA + (size_t)row * DM + col), a8);
                    const f32x4 v0 = acc[ai][bj][m][0], v1 = acc[ai][bj][m][1];
                    float o[8] = {v0[0] * a8[0], v0[1] * a8[1], v0[2] * a8[2], v0[3] * a8[3], v1[0] * a8[4], v1[1] * a8[5], v1[2] * a8[6], v1[3] * a8[7]};
                    *(u32x4*)(O + (size_t)row * DM + col) = pack8(o); } }
            asm volatile("" ::: "memory");
        }
    }
};

struct RmsPanel {
    float* xbuf;
    unsigned* cnt;
    __device__ __forceinline__ void run(const pg8::Unit& u, LAS unsigned char* lds, int wid, int lane) const {
        LAS float* P = (LAS float*)lds; LAS float* S = (LAS float*)(lds + 4096);
        asm volatile("s_waitcnt lgkmcnt(0)" ::: "memory"); __builtin_amdgcn_s_barrier(); asm volatile("" ::: "memory");
        const int row = wid * 32 + (lane & 31);
        if (lane < 32) { const float tot = (P[row * 4 + 0] + P[row * 4 + 1]) + (P[row * 4 + 2] + P[row * 4 + 3]);
            __hip_atomic_store(xbuf + (size_t)(u.pm * 256 + row) * 4 + u.pn, tot, __ATOMIC_RELAXED, __HIP_MEMORY_SCOPE_AGENT); }
        asm volatile("s_waitcnt vmcnt(0)" ::: "memory");
        if (lane == 0) __hip_atomic_fetch_add(cnt + 64 * u.pm, 1u, __ATOMIC_RELAXED, __HIP_MEMORY_SCOPE_AGENT);
        if (wid == 0) { unsigned sp = 0;
            for (;;) { if ((unsigned)__builtin_amdgcn_readfirstlane(__hip_atomic_load(cnt + 64 * u.pm, __ATOMIC_RELAXED, __HIP_MEMORY_SCOPE_AGENT)) >= 32u) break;
                if (++sp > (1u << 22)) break; __builtin_amdgcn_s_sleep(2); }
            __builtin_amdgcn_fence(__ATOMIC_ACQUIRE, "agent"); }
        asm volatile("s_waitcnt vmcnt(0) lgkmcnt(0)" ::: "memory"); __builtin_amdgcn_s_barrier(); asm volatile("" ::: "memory");
        if (lane < 32) { const float* slot = xbuf + (size_t)(u.pm * 256 + row) * 4; float q = 0.f;
#pragma unroll
            for (int t = 0; t < 4; ++t) q += __hip_atomic_load(slot + t, __ATOMIC_RELAXED, __HIP_MEMORY_SCOPE_AGENT);
            S[row] = 1.0f / sqrtf(q * (1.0f / 1024.0f) + EPS); }
        asm volatile("s_waitcnt lgkmcnt(0)" ::: "memory"); __builtin_amdgcn_s_barrier(); asm volatile("" ::: "memory");
    }
};
struct EpiResNorm {
    static constexpr bool PERM = true, AFTER_DRAIN = true, MIDHOOK = false;
    const float* base; bf16_t* x1b; bf16_t* hn; const float* mod; const float* nw; RmsPanel st;
    __device__ __forceinline__ void fused(f32x4 (&acc)[2][2][4][2], const pg8::Unit& u, int wr, int wc, int fr, int fq, LAS unsigned char* lds, int wid, int lane) const {
        const int col0 = u.pn * 256 + wc * 32 + 8 * fq, b = (u.pm * 256) >> 12; const float* mb = mod + (size_t)b * 6144;
        { LAS float* P = (LAS float*)lds;
          f32x4 gg[2][2];
#pragma unroll
          for (int bj = 0; bj < 2; ++bj) { gg[bj][0] = *(const f32x4*)(mb + 2048 + col0 + bj * 128); gg[bj][1] = *(const f32x4*)(mb + 2048 + col0 + bj * 128 + 4); }
          f32x4 nb[2][2];
          { const float* bp = base + (size_t)(u.pm * 256 + wr * 64 + fr) * DM + col0;
#pragma unroll
            for (int bj = 0; bj < 2; ++bj) { nb[bj][0] = __builtin_nontemporal_load((const f32x4*)(bp + bj * 128)); nb[bj][1] = __builtin_nontemporal_load((const f32x4*)(bp + bj * 128 + 4)); } }
#pragma unroll
          for (int k = 0; k < 8; ++k) { const int ai = k >> 2, m = k & 3, r = ai * 128 + wr * 64 + m * 16 + fr; float s = 0.f;
              f32x4 cb[2][2];
#pragma unroll
              for (int bj = 0; bj < 2; ++bj) { cb[bj][0] = nb[bj][0]; cb[bj][1] = nb[bj][1]; }
              if (k < 7) { const int k2 = k + 1; const float* bp = base + (size_t)(u.pm * 256 + (k2 >> 2) * 128 + wr * 64 + (k2 & 3) * 16 + fr) * DM + col0;
#pragma unroll
                  for (int bj = 0; bj < 2; ++bj) { nb[bj][0] = __builtin_nontemporal_load((const f32x4*)(bp + bj * 128)); nb[bj][1] = __builtin_nontemporal_load((const f32x4*)(bp + bj * 128 + 4)); } }
#pragma unroll
              for (int bj = 0; bj < 2; ++bj) { const f32x4 x0 = cb[bj][0] + gg[bj][0] * acc[ai][bj][m][0], x1 = cb[bj][1] + gg[bj][1] * acc[ai][bj][m][1];
                  acc[ai][bj][m][0] = x0; acc[ai][bj][m][1] = x1;
                  s += ((x0[0] * x0[0] + x0[1] * x0[1]) + (x0[2] * x0[2] + x0[3] * x0[3])) + ((x1[0] * x1[0] + x1[1] * x1[1]) + (x1[2] * x1[2] + x1[3] * x1[3])); }
              s += __shfl_xor(s, 16); s += __shfl_xor(s, 32);
              if (fq == 0) P[r * 4 + wc] = s;
              asm volatile("" ::: "memory"); } }
        st.run(u, lds, wid, lane);
        const LAS float* S = (const LAS float*)(lds + 4096);
#pragma unroll
        for (int bj = 0; bj < 2; ++bj) { const int col = col0 + bj * 128;
            f32x4 g2[2], s2[2];
#pragma unroll
            for (int n = 0; n < 2; ++n) { g2[n] = *(const f32x4*)(nw + col + 4 * n) * (*(const f32x4*)(mb + 4096 + col + 4 * n) + 1.0f); s2[n] = *(const f32x4*)(mb + 3072 + col + 4 * n); }
#pragma unroll
            for (int ai = 0; ai < 2; ++ai)
#pragma unroll
                for (int m = 0; m < 4; ++m) { const int r = ai * 128 + wr * 64 + m * 16 + fr; const float rstd = S[r]; const size_t off = (size_t)(u.pm * 256 + r) * DM + col;
                    { u32x4 xw; xw.x = pk2(acc[ai][bj][m][0][0], acc[ai][bj][m][0][1]); xw.y = pk2(acc[ai][bj][m][0][2], acc[ai][bj][m][0][3]); xw.z = pk2(acc[ai][bj][m][1][0], acc[ai][bj][m][1][1]); xw.w = pk2(acc[ai][bj][m][1][2], acc[ai][bj][m][1][3]);
                      *(u32x4*)(x1b + off) = xw; }
                    const f32x4 y0 = acc[ai][bj][m][0] * rstd * g2[0] + s2[0], y1 = acc[ai][bj][m][1] * rstd * g2[1] + s2[1];
                    u32x4 w; w.x = pk2(y0[0], y0[1]); w.y = pk2(y0[2], y0[3]); w.z = pk2(y1[0], y1[1]); w.w = pk2(y1[2], y1[3]);
                    *(u32x4*)(hn + off) = w; } }
    }
};
struct EpiResFinal {
    static constexpr bool PERM = true, AFTER_DRAIN = true, MIDHOOK = false;
    const bf16_t* x1b; float* out; const float* mod; const float* fw; RmsPanel st;
    __device__ __forceinline__ void fused(f32x4 (&acc)[2][2][4][2], const pg8::Unit& u, int wr, int wc, int fr, int fq, LAS unsigned char* lds, int wid, int lane) const {
        const int col0 = u.pn * 256 + wc * 32 + 8 * fq, b = (u.pm * 256) >> 12; const float* mb = mod + (size_t)b * 6144;
        { LAS float* P = (LAS float*)lds;
          f32x4 gg[2][2];
#pragma unroll
          for (int bj = 0; bj < 2; ++bj) { gg[bj][0] = *(const f32x4*)(mb + 5120 + col0 + bj * 128); gg[bj][1] = *(const f32x4*)(mb + 5120 + col0 + bj * 128 + 4); }
          u32x4 nb[2];
          { const bf16_t* bp = x1b + (size_t)(u.pm * 256 + wr * 64 + fr) * DM + col0;
#pragma unroll
            for (int bj = 0; bj < 2; ++bj) nb[bj] = *(const u32x4*)(bp + bj * 128); }
#pragma unroll
          for (int k = 0; k < 8; ++k) { const int ai = k >> 2, m = k & 3, r = ai * 128 + wr * 64 + m * 16 + fr; float s = 0.f;
              f32x4 cb[2][2];
#pragma unroll
              for (int bj = 0; bj < 2; ++bj) { cb[bj][0] = (f32x4){lo16(nb[bj].x), hi16(nb[bj].x), lo16(nb[bj].y), hi16(nb[bj].y)}; cb[bj][1] = (f32x4){lo16(nb[bj].z), hi16(nb[bj].z), lo16(nb[bj].w), hi16(nb[bj].w)}; }
              if (k < 7) { const int k2 = k + 1; const bf16_t* bp = x1b + (size_t)(u.pm * 256 + (k2 >> 2) * 128 + wr * 64 + (k2 & 3) * 16 + fr) * DM + col0;
#pragma unroll
                  for (int bj = 0; bj < 2; ++bj) nb[bj] = *(const u32x4*)(bp + bj * 128); }
#pragma unroll
              for (int bj = 0; bj < 2; ++bj) { const f32x4 x0 = cb[bj][0] + gg[bj][0] * acc[ai][bj][m][0], x1 = cb[bj][1] + gg[bj][1] * acc[ai][bj][m][1];
                  acc[ai][bj][m][0] = x0; acc[ai][bj][m][1] = x1;
                  s += ((x0[0] * x0[0] + x0[1] * x0[1]) + (x0[2] * x0[2] + x0[3] * x0[3])) + ((x1[0] * x1[0] + x1[1] * x1[1]) + (x1[2] * x1[2] + x1[3] * x1[3])); }
              s += __shfl_xor(s, 16); s += __shfl_xor(s, 32);
              if (fq == 0) P[r * 4 + wc] = s;
              asm volatile("" ::: "memory"); } }
        st.run(u, lds, wid, lane);
        const LAS float* S = (const LAS float*)(lds + 4096);
#pragma unroll
        for (int bj = 0; bj < 2; ++bj) { const int col = col0 + bj * 128; const f32x4 w0 = *(const f32x4*)(fw + col), w1 = *(const f32x4*)(fw + col + 4);
#pragma unroll
            for (int ai = 0; ai < 2; ++ai)
#pragma unroll
                for (int m = 0; m < 4; ++m) { const int r = ai * 128 + wr * 64 + m * 16 + fr; const float rstd = S[r]; const size_t off = (size_t)(u.pm * 256 + r) * DM + col;
                    __builtin_nontemporal_store(acc[ai][bj][m][0] * rstd * w0, (f32x4*)(out + off)); __builtin_nontemporal_store(acc[ai][bj][m][1] * rstd * w1, (f32x4*)(out + off + 4)); } }
    }
};

__device__ __forceinline__ void transpose_item(const float* W, int ldw, int col0, int K, bf16_t* WT, int drow0, int k0, int n0, LAS float* scr, int lane, int perm = 0, int d0 = 0) {
#pragma unroll 8
    for (int i = 0; i < 32; ++i) { const int kk = 2 * i + (lane >> 5); scr[kk * 33 + (lane & 31)] = __builtin_nontemporal_load(&W[(size_t)(k0 + kk) * ldw + col0 + n0 + (lane & 31)]); }
    asm volatile("s_waitcnt lgkmcnt(0)" ::: "memory");
    const int c = lane & 7;
#pragma unroll
    for (int j = 0; j < 4; ++j) { const int n = (lane >> 3) + 8 * j; const LAS float* s = scr + (8 * c) * 33 + n;
        u32x4 o; o.x = pk2(s[0 * 33], s[1 * 33]); o.y = pk2(s[2 * 33], s[3 * 33]); o.z = pk2(s[4 * 33], s[5 * 33]); o.w = pk2(s[6 * 33], s[7 * 33]);
        const int drow = perm ? (drow0 + 8 * (n >> 2) + (n & 3) + (d0 ? 4 : 0)) : (drow0 + n);
        *(u32x4*)(WT + (size_t)drow * K + k0 + 8 * c) = o; }
    asm volatile("s_waitcnt lgkmcnt(0)" ::: "memory");
}

__device__ __forceinline__ void phase0_transposes(const Ctx& X, KArgs a, int it0, int it1, int gw, int ngw) {
    unsigned char* ws = a->ws;
    LAS float* scr = (LAS float*)(X.lds + X.wave * 16384);
    constexpr int I1 = 16 * 96, I2 = 16 * 72, I3 = 16 * 64, I4 = 16 * 32, I5 = 4 * 32, I6 = 16 * 32, I7 = 16 * 176, I8 = 44 * 32;
    constexpr int NITEMS = I1 + I2 + I3 + I4 + I5 + I6 + I7 + I8;
    for (int it = it0 + gw; it < (it1 < 0 ? NITEMS : it1); it += ngw) {
        int r = it;
        if (r < I1) { const int nb = r % 96, kb = r / 96; transpose_item(a->w_in, DIN, 0, DM, (bf16_t*)(ws + WS_WMAIN), nb * 32, kb * 64, nb * 32, scr, X.lane); continue; } r -= I1;
        if (r < I2) { const int nb = r % 72, kb = r / 72; const bool rot = nb < 48;
            transpose_item(a->w_in, DIN, 3088, DM, (bf16_t*)(ws + WS_WMAIN), rot ? 3072 + (nb >> 1) * 64 : 3072 + nb * 32, kb * 64, nb * 32, scr, X.lane, rot ? 1 : 0, (nb & 1) * 32); continue; } r -= I2;
        if (r < I3) { const int nb = r % 64, kb = r / 64; transpose_item(a->w_in, DIN, 5392, DM, (bf16_t*)(ws + WS_WMAB), nb * 32, kb * 64, nb * 32, scr, X.lane); continue; } r -= I3;
        if (r < I4) { const int nb = r % 32, kb = r / 32; transpose_item(a->w_gla, DM, 0, 1280, (bf16_t*)(ws + WS_WG) + 256, nb * 32, kb * 64, nb * 32, scr, X.lane); continue; } r -= I4;
        if (r < I5) { const int nb = r % 32, kb = r / 32; transpose_item(a->w_attn, DM, 0, 1280, (bf16_t*)(ws + WS_WG), nb * 32, kb * 64, nb * 32, scr, X.lane); continue; } r -= I5;
        if (r < I6) { const int nb = r % 32, kb = r / 32; transpose_item(a->w_out, DM, 0, DM, (bf16_t*)(ws + WS_WOUT), nb * 32, kb * 64, nb * 32, scr, X.lane); continue; } r -= I6;
        if (r < I7) { const int nb = r % 176, kb = r / 176; const int n0 = nb * 32; const int ch = n0 % DFF; const int drow = (ch / 128) * 256 + (n0 >= DFF ? 128 : 0) + (ch % 128);
            transpose_item(a->w_up, NUP, 0, DM, (bf16_t*)(ws + WS_WUP), drow, kb * 64, n0, scr, X.lane); continue; } r -= I7;
        { const int nb = r % 32, kb = r / 32; transpose_item(a->w_down, DM, 0, DFF, (bf16_t*)(ws + WS_WDOWN), nb * 32, kb * 64, nb * 32, scr, X.lane); }
    }
}

__device__ __forceinline__ void phase0(const Ctx& X, KArgs a) {
    unsigned char* ws = a->ws;
    { bf16_t* wlr = (bf16_t*)(ws + WS_WLR);
      for (int idx = X.gtid; idx < 16 * DM; idx += X.nthr) { const int j = idx >> 10, k = idx & 1023; wlr[idx] = (bf16_t)f2bf(a->w_in[(size_t)k * DIN + 3072 + j]); } }
    { float* modp = (float*)(ws + WS_MODP);
      for (int u = X.gw; u < 96 * 32; u += X.ngw) { const int cgp = u % 96, kc = u / 96, j = cgp * 64 + X.lane;
          float w[32];
#pragma unroll
          for (int kk = 0; kk < 32; ++kk) w[kk] = __builtin_nontemporal_load(&a->ada_w[(size_t)(kc * 32 + kk) * 6144 + j]);
          const float cA = a->c[(X.lane >> 5) * DM + kc * 32 + (X.lane & 31)], cB = a->c[((X.lane >> 5) + 2) * DM + kc * 32 + (X.lane & 31)];
          const int sA = __float_as_int(cA / (1.0f + __expf(-cA))), sB = __float_as_int(cB / (1.0f + __expf(-cB)));
          float acc[4] = {0.f, 0.f, 0.f, 0.f};
#pragma unroll
          for (int kk = 0; kk < 32; ++kk) {
              acc[0] += __int_as_float(__builtin_amdgcn_readlane(sA, kk)) * w[kk]; acc[1] += __int_as_float(__builtin_amdgcn_readlane(sA, 32 + kk)) * w[kk];
              acc[2] += __int_as_float(__builtin_amdgcn_readlane(sB, kk)) * w[kk]; acc[3] += __int_as_float(__builtin_amdgcn_readlane(sB, 32 + kk)) * w[kk]; }
#pragma unroll
          for (int b = 0; b < 4; ++b) modp[(size_t)(kc * 4 + b) * 6144 + j] = acc[b]; } }
    { f32x2* rope = (f32x2*)(ws + WS_ROPE);
      for (int idx = X.gtid; idx < NT * 32; idx += X.nthr) { const int t = idx >> 5, i = idx & 31;
          const double rev = (double)a->positions[t] * INVF_REV[i]; const float fr = (float)(rev - floor(rev));
          rope[idx] = (f32x2){__builtin_amdgcn_cosf(fr), __builtin_amdgcn_sinf(fr)}; } }
}

template <int MODE> __device__ __forceinline__ void norm_pass(const Ctx& X, KArgs a, const float* xin, bf16_t* hout, float* fout) {
    unsigned char* ws = a->ws;
    const float* modp = (const float*)(ws + WS_MODP); float* mod = (float*)(ws + WS_MOD);
    if (MODE == 0) { for (int idx = X.gtid; idx < 4 * 6144; idx += X.nthr) { const int b = idx / 6144, j = idx % 6144; float s = a->ada_b[j];
            float pv[32];
#pragma unroll
            for (int kc = 0; kc < 32; ++kc) pv[kc] = modp[(size_t)(kc * 4 + b) * 6144 + j];
#pragma unroll
            for (int kc = 0; kc < 32; ++kc) s += pv[kc];
            mod[idx] = s; } }
    LAS float* gs = (LAS float*)X.lds;
    LAS bf16_t* hs = (LAS bf16_t*)(X.lds + 8192);
    for (int rt = blockIdx.x; rt < NT / 64; rt += gridDim.x) {
        const int row0 = rt * 64, b = row0 >> 12;
        __syncthreads();
        for (int idx = X.tid; idx < DM; idx += 512) {
            float g, s;
            if (MODE == 0) { float sc = a->ada_b[1024 + idx], sh = a->ada_b[idx];
                float pa[32], pb[32];
#pragma unroll
                for (int kc = 0; kc < 32; ++kc) { pa[kc] = modp[(size_t)(kc * 4 + b) * 6144 + 1024 + idx]; pb[kc] = modp[(size_t)(kc * 4 + b) * 6144 + idx]; }
#pragma unroll
                for (int kc = 0; kc < 32; ++kc) { sc += pa[kc]; sh += pb[kc]; }
                g = a->norm1_w[idx] * (1.0f + sc); s = sh; }
            else if (MODE == 1) { g = a->norm2_w[idx] * (1.0f + mod[b * 6144 + 4096 + idx]); s = mod[b * 6144 + 3072 + idx]; }
            else { g = a->final_w[idx]; s = 0.f; }
            gs[idx] = g; gs[1024 + idx] = s;
        }
        __syncthreads();
#pragma unroll 1
        for (int rb = 0; rb < 8; rb += 4) {
            f32x4 v[4][4];
#pragma unroll
            for (int r = 0; r < 4; ++r) { const f32x4* xr = (const f32x4*)(xin + (size_t)(row0 + X.wave * 8 + rb + r) * DM) + X.lane;
#pragma unroll
                for (int j = 0; j < 4; ++j) v[r][j] = __builtin_nontemporal_load(xr + 64 * j); }
#pragma unroll
            for (int r = 0; r < 4; ++r) {
                const int lr = X.wave * 8 + rb + r, row = row0 + lr;
                float ss = 0.f;
#pragma unroll
                for (int j = 0; j < 4; ++j) ss += (v[r][j][0] * v[r][j][0] + v[r][j][1] * v[r][j][1]) + (v[r][j][2] * v[r][j][2] + v[r][j][3] * v[r][j][3]);
                const float rstd = 1.0f / sqrtf(wave_sum(ss) * (1.0f / DM) + EPS);
#pragma unroll
                for (int j = 0; j < 4; ++j) { const int k = 4 * X.lane + 256 * j;
                    const f32x4 g = *(const LAS f32x4*)(gs + k), sft = *(const LAS f32x4*)(gs + 1024 + k);
                    const f32x4 y = v[r][j] * rstd * g + sft;
                    if (MODE == 2) { *((f32x4*)(fout + (size_t)row * DM) + X.lane + 64 * j) = y; }
                    else { u32x2 w; w.x = pk2(y[0], y[1]); w.y = pk2(y[2], y[3]);
                        *(u32x2*)(hout + (size_t)row * DM + k) = w;
                        if (MODE == 0) *(LAS u32x2*)(hs + lr * 1032 + k) = w; } }
            }
        }
        if (MODE == 0) {
            __syncthreads();
            const bf16_t* wlr = (const bf16_t*)(ws + WS_WLR);
            const int mt = X.wave & 3, kh = X.wave >> 2, fr = X.lane & 15, fq = X.lane >> 4;
            f32x4 acc = {0.f, 0.f, 0.f, 0.f};
#pragma unroll 4
            for (int ks = 0; ks < 16; ++ks) { const int k0 = kh * 512 + ks * 32 + 8 * fq;
                const bf16x8 av = *(const LAS bf16x8*)(hs + (16 * mt + fr) * 1032 + k0);
                const bf16x8 bv = *(const bf16x8*)(wlr + fr * 1024 + k0);
                acc = __builtin_amdgcn_mfma_f32_16x16x32_bf16(av, bv, acc, 0, 0, 0); }
            LAS f32x4* red = (LAS f32x4*)X.lds;
            if (kh == 1) red[mt * 64 + X.lane] = acc;
            __syncthreads();
            if (kh == 0) { const f32x4 o = acc + red[mt * 64 + X.lane]; float* glr = (float*)(ws + WS_GLR);
#pragma unroll
                for (int e = 0; e < 4; ++e) glr[(size_t)(row0 + 16 * mt + 4 * fq + e) * 16 + fr] = o[e]; }
        }
    }
}

constexpr int QP = 72, VP = 264;
__device__ __forceinline__ void attn_mfma(const Ctx& X, KArgs a, int dry = 0) {
    bf16_t* proj = (bf16_t*)(a->ws + WS_BIG); const f32x2* rope = (const f32x2*)(a->ws + WS_ROPE); float* lse = (float*)(a->ws + WS_LSE);
    LAS bf16_t* Qs = (LAS bf16_t*)X.lds; LAS bf16_t* Ks = (LAS bf16_t*)(X.lds + 128 * QP * 2); LAS bf16_t* Vt = (LAS bf16_t*)(X.lds + 384 * QP * 2);
    const int fr = X.lane & 15, fq = X.lane >> 4, w = X.wave, i0 = 16 * w;
    for (int unit = blockIdx.x; unit < 1536; unit += gridDim.x) {
        const int b = unit / 384, rem = unit % 384, h = rem >> 5, pn = rem & 31, g = h >> 2, hg = h & 3;
        const int r = (g == 0) ? 1 : (g == 1 ? 4 : 16), nblk = 32 / r, p = pn / nblk, n = pn % nblk;
        const int tb = b * SEQ + p;
        __syncthreads();
        { const int i = X.tid >> 2, c = X.tid & 3; const int t = tb + (128 * n + i) * r; const bf16_t* src = proj + (size_t)t * NMAIN + C_AQ + h * 64 + 16 * c;
          *(LAS u32x4*)(Qs + i * QP + 16 * c) = *(const u32x4*)src; *(LAS u32x4*)(Qs + i * QP + 16 * c + 8) = *(const u32x4*)(src + 8); }
#pragma unroll
        for (int q = 0; q < 2; ++q) { const int idx = X.tid + 512 * q, j = idx >> 2, c = idx & 3; int m = 128 * (n - 1) + j; m = m < 0 ? 0 : m; const int t = tb + m * r;
            const bf16_t* src = proj + (size_t)t * NMAIN + C_AK + h * 64 + 16 * c;
            *(LAS u32x4*)(Ks + j * QP + 16 * c) = *(const u32x4*)src; *(LAS u32x4*)(Ks + j * QP + 16 * c + 8) = *(const u32x4*)(src + 8); }
#pragma unroll
        for (int q = 0; q < 4; ++q) { const int idx = X.tid + 512 * q, j = idx & 255, c = idx >> 8; int m = 128 * (n - 1) + j; m = m < 0 ? 0 : m; const int t = tb + m * r;
            const u32x4 wv = *(const u32x4*)(proj + (size_t)t * NMAIN + C_AV + h * 64 + 8 * c);
            LAS bf16_t* vp = Vt + (8 * c) * VP + j;
            vp[0 * VP] = (bf16_t)(wv.x & 0xffff); vp[1 * VP] = (bf16_t)(wv.x >> 16); vp[2 * VP] = (bf16_t)(wv.y & 0xffff); vp[3 * VP] = (bf16_t)(wv.y >> 16);
            vp[4 * VP] = (bf16_t)(wv.z & 0xffff); vp[5 * VP] = (bf16_t)(wv.z >> 16); vp[6 * VP] = (bf16_t)(wv.w & 0xffff); vp[7 * VP] = (bf16_t)(wv.w >> 16); }
        __syncthreads();
        bf16x8 bq[2];
#pragma unroll
        for (int ks = 0; ks < 2; ++ks) bq[ks] = *(const LAS bf16x8*)(Qs + (i0 + fr) * QP + 32 * ks + 8 * fq);
        f32x4 sc[9];
#pragma unroll
        for (int q = 0; q < 9; ++q) { sc[q] = (f32x4){0.f, 0.f, 0.f, 0.f};
#pragma unroll
            for (int ks = 0; ks < 2; ++ks) { const bf16x8 ak = *(const LAS bf16x8*)(Ks + (16 * (w + q) + fr) * QP + 32 * ks + 8 * fq); sc[q] = __builtin_amdgcn_mfma_f32_16x16x32_bf16(ak, bq[ks], sc[q], 0, 0, 0); } }
        const int iq = i0 + fr;
        float mx = -INFINITY;
#pragma unroll
        for (int q = 0; q < 9; ++q)
#pragma unroll
            for (int e = 0; e < 4; ++e) { const int j = 16 * (w + q) + 4 * fq + e, dist = iq + 128 - j; const bool valid = (dist >= 0) && (dist <= 128) && (n > 0 || j >= 128);
                sc[q][e] = valid ? sc[q][e] : -INFINITY; mx = fmaxf(mx, sc[q][e]); }
        mx = fmaxf(mx, __shfl_xor(mx, 16)); mx = fmaxf(mx, __shfl_xor(mx, 32));
        float l = 0.f;
#pragma unroll
        for (int q = 0; q < 9; ++q)
#pragma unroll
            for (int e = 0; e < 4; ++e) { sc[q][e] = __expf(sc[q][e] - mx); l += sc[q][e]; }
        l += __shfl_xor(l, 16); l += __shfl_xor(l, 32);
        f32x4 o[4];
#pragma unroll
        for (int dt = 0; dt < 4; ++dt) o[dt] = (f32x4){0.f, 0.f, 0.f, 0.f};
#pragma unroll
        for (int c = 0; c < 5; ++c) { const int jtA = w + 2 * c; int jtB = w + 2 * c + 1; jtB = jtB > 15 ? 15 : jtB;
            const f32x4 pa = sc[2 * c]; const f32x4 pb = (2 * c + 1 <= 8) ? sc[(2 * c + 1 <= 8) ? 2 * c + 1 : 8] : (f32x4){0.f, 0.f, 0.f, 0.f};
            u32x4 pw; pw.x = pk2(pa[0], pa[1]); pw.y = pk2(pa[2], pa[3]); pw.z = pk2(pb[0], pb[1]); pw.w = pk2(pb[2], pb[3]);
            const bf16x8 bfrag = __builtin_bit_cast(bf16x8, pw);
#pragma unroll
            for (int dt = 0; dt < 4; ++dt) { const LAS bf16_t* vr = Vt + (16 * dt + fr) * VP + 4 * fq;
                const u32x2 lo = *(const LAS u32x2*)(vr + 16 * jtA), hi = *(const LAS u32x2*)(vr + 16 * jtB); const u32x4 av = {lo.x, lo.y, hi.x, hi.y};
                o[dt] = __builtin_amdgcn_mfma_f32_16x16x32_bf16(__builtin_bit_cast(bf16x8, av), bfrag, o[dt], 0, 0, 0); } }
        const float il = 1.0f / l; const int tq = tb + (128 * n + iq) * r;
        bf16_t* op = (dry ? proj + (size_t)NT * NMAIN + (size_t)(tq & 63) * NMAIN : proj + (size_t)tq * NMAIN) + C_AQ + h * 64 + 4 * fq;
#pragma unroll
        for (int dt = 0; dt < 4; ++dt) { u32x2 wv; wv.x = pk2(o[dt][0] * il, o[dt][1] * il); wv.y = pk2(o[dt][2] * il, o[dt][3] * il); *(u32x2*)(op + 16 * dt) = wv; }
        if (fq == 0) lse[((size_t)g * NT + tq) * 4 + hg] = mx + __logf(l);
    }
}

__device__ __forceinline__ void attn_combine(const Ctx& X, KArgs a) {
    bf16_t* proj = (bf16_t*)(a->ws + WS_BIG); const float* lse = (const float*)(a->ws + WS_LSE);
    for (int base = X.gtid; base < NT * 32; base += 4 * X.nthr) {
        u32x4 o0[4], o1[4], o2[4]; float l0[4], l1[4], l2[4];
#pragma unroll
        for (int q = 0; q < 4; ++q) { const int idx = base + q * X.nthr; if (idx < NT * 32) { const int t = idx >> 5, c8 = (idx & 31) * 8, hg = c8 >> 6;
            l0[q] = lse[((size_t)0 * NT + t) * 4 + hg]; l1[q] = lse[((size_t)1 * NT + t) * 4 + hg]; l2[q] = lse[((size_t)2 * NT + t) * 4 + hg];
            const bf16_t* p = proj + (size_t)t * NMAIN + C_AQ + c8; o0[q] = *(const u32x4*)p; o1[q] = *(const u32x4*)(p + 256); o2[q] = *(const u32x4*)(p + 512); } }
#pragma unroll
        for (int q = 0; q < 4; ++q) { const int idx = base + q * X.nthr; if (idx < NT * 32) { const int t = idx >> 5, c8 = (idx & 31) * 8;
            const float mx = fmaxf(l0[q], fmaxf(l1[q], l2[q])); float w0 = __expf(l0[q] - mx), w1 = __expf(l1[q] - mx), w2 = __expf(l2[q] - mx); const float inv = 1.0f / (w0 + w1 + w2); w0 *= inv; w1 *= inv; w2 *= inv;
            float f0[8], f1[8], f2[8], o[8]; unpack8(o0[q], f0); unpack8(o1[q], f1); unpack8(o2[q], f2);
#pragma unroll
            for (int e = 0; e < 8; ++e) o[e] = w0 * f0[e] + w1 * f1[e] + w2 * f2[e];
            *(u32x4*)(proj + (size_t)t * NMAIN + C_AQ + c8) = pack8(o); } }
    }
}

constexpr int GP = 136;
__device__ __forceinline__ void gla_bcum(KArgs a, int tid, int t0, int h, LAS float* segtot, LAS float* glrs, float (&bc)[32], float& tot) {
    const int d = tid & 127, seg = __builtin_amdgcn_readfirstlane(tid >> 7), col = h * 128 + d;
    const float* glr = (const float*)(a->ws + WS_GLR);
    float w2r[16];
#pragma unroll
    for (int j = 0; j < 16; ++j) w2r[j] = a->gate_w2[j * 512 + col];
    const float bias = a->gate_b[col];
    *(LAS f32x4*)(glrs + tid * 4) = *(const f32x4*)(glr + (size_t)t0 * 16 + tid * 4);
    __syncthreads();
    float run = 0.f;
#pragma unroll
    for (int r = 0; r < 32; ++r) { const LAS f32x4* gp = (const LAS f32x4*)(glrs + (seg * 32 + r) * 16);
        float z = bias;
#pragma unroll
        for (int q = 0; q < 4; ++q) { const f32x4 g = gp[q]; z += g[0] * w2r[4 * q] + g[1] * w2r[4 * q + 1] + g[2] * w2r[4 * q + 2] + g[3] * w2r[4 * q + 3]; }
        const float la = (fminf(z, 0.f) - __logf(1.0f + __expf(-fabsf(z)))) * (1.0f / 16.0f);
        run += la; bc[r] = run; }
    segtot[seg * 128 + d] = run;
    __syncthreads();
    float off = 0.f; tot = 0.f;
#pragma unroll
    for (int s2 = 0; s2 < 4; ++s2) { const float v = segtot[s2 * 128 + d]; tot += v; if (s2 < seg) off += v; }
#pragma unroll
    for (int r = 0; r < 32; ++r) bc[r] += off;
}
__device__ __forceinline__ void gla_stage_vT(const bf16_t* proj, int tid, int t0, int h, LAS bf16_t* vT) {
#pragma unroll
    for (int q = 0; q < 8; ++q) { const int i = tid >> 2, c = (tid & 3) + 4 * q;
        const u32x4 wv = *(const u32x4*)(proj + (size_t)(t0 + i) * NMAIN + C_GV + h * 256 + 8 * c);
        LAS bf16_t* vp = vT + (8 * c) * GP + i;
        vp[0 * GP] = (bf16_t)(wv.x & 0xffff); vp[1 * GP] = (bf16_t)(wv.x >> 16); vp[2 * GP] = (bf16_t)(wv.y & 0xffff); vp[3 * GP] = (bf16_t)(wv.y >> 16);
        vp[4 * GP] = (bf16_t)(wv.z & 0xffff); vp[5 * GP] = (bf16_t)(wv.z >> 16); vp[6 * GP] = (bf16_t)(wv.w & 0xffff); vp[7 * GP] = (bf16_t)(wv.w >> 16); }
}
__device__ __forceinline__ void gla_a1(const Ctx& X, KArgs a, float* kvt, float* decb) {
    const bf16_t* proj = (const bf16_t*)(a->ws + WS_BIG);
    LAS bf16_t* kdT = (LAS bf16_t*)X.lds; LAS bf16_t* vT = (LAS bf16_t*)(X.lds + 128 * GP * 2); LAS float* segtot = (LAS float*)(X.lds + 384 * GP * 2);
    const int fr = X.lane & 15, fq = X.lane >> 4, w = X.wave;
    for (int unit = blockIdx.x; unit < 512; unit += gridDim.x) {
        const int bh = unit >> 5, n = unit & 31, b = bh >> 2, h = bh & 3, t0 = b * SEQ + n * 128;
        __syncthreads();
        float bc[32], tot; gla_bcum(a, X.tid, t0, h, segtot, (LAS float*)vT, bc, tot);
        { const int d = X.tid & 127, seg = X.tid >> 7;
#pragma unroll
          for (int r8 = 0; r8 < 4; ++r8) { float kd[8];
#pragma unroll
              for (int e = 0; e < 8; ++e) { const int r = r8 * 8 + e; kd[e] = bf2f(proj[(size_t)(t0 + seg * 32 + r) * NMAIN + C_GK + h * 128 + d]) * __expf(tot - bc[r]); }
              *(LAS u32x4*)(kdT + d * GP + seg * 32 + r8 * 8) = pack8(kd); }
          if (seg == 0) decb[unit * 128 + d] = __expf(tot); }
        gla_stage_vT(proj, X.tid, t0, h, vT);
        __syncthreads();
        f32x4 acc[8][2];
#pragma unroll
        for (int mt = 0; mt < 8; ++mt) { acc[mt][0] = (f32x4){0.f, 0.f, 0.f, 0.f}; acc[mt][1] = (f32x4){0.f, 0.f, 0.f, 0.f}; }
#pragma unroll
        for (int ks = 0; ks < 4; ++ks) {
            bf16x8 bfr[2];
#pragma unroll
            for (int nt = 0; nt < 2; ++nt) bfr[nt] = *(const LAS bf16x8*)(vT + (32 * w + 16 * nt + fr) * GP + 32 * ks + 8 * fq);
#pragma unroll
            for (int mt = 0; mt < 8; ++mt) { const bf16x8 af = *(const LAS bf16x8*)(kdT + (16 * mt + fr) * GP + 32 * ks + 8 * fq);
#pragma unroll
                for (int nt = 0; nt < 2; ++nt) acc[mt][nt] = __builtin_amdgcn_mfma_f32_16x16x32_bf16(af, bfr[nt], acc[mt][nt], 0, 0, 0); }
        }
        bf16_t* ko = (bf16_t*)kvt + (size_t)unit * 32768;
#pragma unroll
        for (int mt = 0; mt < 8; ++mt)
#pragma unroll
            for (int nt = 0; nt < 2; ++nt) { u32x2 wv; wv.x = pk2(acc[mt][nt][0], acc[mt][nt][1]); wv.y = pk2(acc[mt][nt][2], acc[mt][nt][3]);
                *(u32x2*)(ko + (32 * w + 16 * nt + fr) * 128 + 16 * mt + 4 * fq) = wv; }
    }
}
__device__ __forceinline__ void gla_a2(const Ctx& X, KArgs a, float* kvt, const float* decb, int dry = 0) {
    u32x2* kb = (u32x2*)kvt;
    for (int gid = X.gtid; gid < 131072; gid += X.nthr) {
        const int bh = gid >> 13, e4 = gid & 8191, d4 = (e4 & 31) * 4;
        f32x4 S = {0.f, 0.f, 0.f, 0.f};
#pragma unroll 1
        for (int n0 = 0; n0 < 32; n0 += 16) {
            u32x2 kv[16]; f32x4 dc[16];
#pragma unroll
            for (int j = 0; j < 16; ++j) { const int unit = bh * 32 + n0 + j; kv[j] = kb[(size_t)unit * 8192 + e4]; dc[j] = *(const f32x4*)(decb + unit * 128 + d4); }
#pragma unroll
            for (int j = 0; j < 16; ++j) { const int unit = bh * 32 + n0 + j; u32x2 wv; wv.x = pk2(S[0], S[1]); wv.y = pk2(S[2], S[3]);
                if (dry) *((u32x2*)(a->ws + WS_BIG + (size_t)NT * NMAIN * 2) + gid) = wv; else kb[(size_t)unit * 8192 + e4] = wv;
                const f32x4 kf = {lo16(kv[j].x), hi16(kv[j].x), lo16(kv[j].y), hi16(kv[j].y)}; S = dc[j] * S + kf; }
        }
    }
}
__device__ __forceinline__ void gla_a3(const Ctx& X, KArgs a, const float* kvt, int dry = 0) {
    bf16_t* proj = (bf16_t*)(a->ws + WS_BIG);
    LAS bf16_t* qgs = (LAS bf16_t*)X.lds; LAS bf16_t* kgs = (LAS bf16_t*)(X.lds + 128 * GP * 2); LAS bf16_t* vT = (LAS bf16_t*)(X.lds + 256 * GP * 2); LAS float* segtot = (LAS float*)(X.lds + 512 * GP * 2);
    const int fr = X.lane & 15, fq = X.lane >> 4, w = X.wave, i0 = 16 * w;
    for (int unit = blockIdx.x; unit < 512; unit += gridDim.x) {
        const int bh = unit >> 5, n = unit & 31, b = bh >> 2, h = bh & 3, t0 = b * SEQ + n * 128;
        __syncthreads();
        { float bc[32], tot; gla_bcum(a, X.tid, t0, h, segtot, (LAS float*)vT, bc, tot);
          const int d = X.tid & 127, seg = X.tid >> 7;
#pragma unroll
          for (int r = 0; r < 32; ++r) { const int i = seg * 32 + r; const bf16_t* row = proj + (size_t)(t0 + i) * NMAIN + h * 128 + d;
              const float qv = bf2f(row[C_GQ]), kv = bf2f(row[C_GK]);
              qgs[i * GP + d] = (bf16_t)f2bf(qv * 0.08838834764831845f * __expf(bc[r])); kgs[i * GP + d] = (bf16_t)f2bf(kv * __expf(-bc[r])); } }
        gla_stage_vT(proj, X.tid, t0, h, vT);
        __syncthreads();
        bf16x8 afr[4];
#pragma unroll
        for (int ks = 0; ks < 4; ++ks) afr[ks] = *(const LAS bf16x8*)(qgs + (i0 + fr) * GP + 32 * ks + 8 * fq);
        f32x4 acc[16];
#pragma unroll
        for (int nt = 0; nt < 16; ++nt) acc[nt] = (f32x4){0.f, 0.f, 0.f, 0.f};
        for (int jt = 0; jt <= (w | 1); ++jt) {
            f32x4 att = {0.f, 0.f, 0.f, 0.f};
            if (jt <= w) {
#pragma unroll
                for (int ks = 0; ks < 4; ++ks) { const bf16x8 bf = *(const LAS bf16x8*)(kgs + (16 * jt + fr) * GP + 32 * ks + 8 * fq); att = __builtin_amdgcn_mfma_f32_16x16x32_bf16(afr[ks], bf, att, 0, 0, 0); }
            }
#pragma unroll
            for (int e = 0; e < 4; ++e) { const int i = i0 + 4 * fq + e, j = 16 * jt + fr; qgs[i * GP + j] = (bf16_t)f2bf(j <= i ? att[e] : 0.f); }
        }
        asm volatile("s_waitcnt lgkmcnt(0)" ::: "memory");
        for (int ks = 0; ks <= (w >> 1); ++ks) { const bf16x8 af = *(const LAS bf16x8*)(qgs + (i0 + fr) * GP + 32 * ks + 8 * fq);
#pragma unroll
            for (int nt = 0; nt < 16; ++nt) { const bf16x8 bf = *(const LAS bf16x8*)(vT + (16 * nt + fr) * GP + 32 * ks + 8 * fq); acc[nt] = __builtin_amdgcn_mfma_f32_16x16x32_bf16(af, bf, acc[nt], 0, 0, 0); } }
        if (n > 0) {
            __syncthreads();
            const bf16_t* sb = (const bf16_t*)kvt + (size_t)unit * 32768;
#pragma unroll
            for (int q = 0; q < 8; ++q) { const int sidx = X.tid + 512 * q; const u32x4 wv = *(const u32x4*)(sb + (size_t)sidx * 8);
                *(LAS u32x4*)(vT + (sidx >> 4) * GP + (sidx & 15) * 8) = wv; }
            __syncthreads();
#pragma unroll
            for (int ks = 0; ks < 4; ++ks)
#pragma unroll
                for (int nt = 0; nt < 16; ++nt) { const bf16x8 bf = *(const LAS bf16x8*)(vT + (16 * nt + fr) * GP + 32 * ks + 8 * fq); acc[nt] = __builtin_amdgcn_mfma_f32_16x16x32_bf16(afr[ks], bf, acc[nt], 0, 0, 0); }
        }
        float rs[4];
#pragma unroll
        for (int e = 0; e < 4; ++e) { float s2 = 0.f;
#pragma unroll
            for (int nt = 0; nt < 16; ++nt) s2 += acc[nt][e] * acc[nt][e];
            s2 += __shfl_xor(s2, 1); s2 += __shfl_xor(s2, 2); s2 += __shfl_xor(s2, 4); s2 += __shfl_xor(s2, 8);
            rs[e] = 1.0f / sqrtf(s2 * (1.0f / 256.0f) + EPS); }
        __syncthreads();
        { LAS bf16_t* ost = (LAS bf16_t*)(X.lds + w * 8704);
#pragma unroll
          for (int nt = 0; nt < 16; ++nt) { const float nw = a->gla_norm_w[16 * nt + fr];
#pragma unroll
              for (int e = 0; e < 4; ++e) ost[(4 * fq + e) * 272 + 16 * nt + fr] = (bf16_t)f2bf(acc[nt][e] * rs[e] * nw); }
          asm volatile("s_waitcnt lgkmcnt(0)" ::: "memory");
          const int r = X.lane >> 2, cgp = X.lane & 3;
          bf16_t* orow = proj + (size_t)(t0 + i0 + r) * NMAIN + C_GR + h * 256;
          bf16_t* drow = dry ? proj + (size_t)NT * NMAIN + (size_t)((t0 + i0 + r) & 63) * NMAIN + C_GR + h * 256 : orow;
          u32x4 gv[8];
#pragma unroll
          for (int q = 0; q < 8; ++q) gv[q] = *(const u32x4*)(orow + 8 * (cgp + 4 * q));
#pragma unroll
          for (int q = 0; q < 8; ++q) { const int c = cgp + 4 * q; float v[8], gr[8]; unpack8(*(const LAS u32x4*)(ost + r * 272 + 8 * c), v); unpack8(gv[q], gr);
#pragma unroll
              for (int e = 0; e < 8; ++e) v[e] *= gr[e] * sigmoidf_(gr[e]);
              *(u32x4*)(drow + 8 * c) = pack8(v); } }
    }
}

__global__ void __launch_bounds__(512, 2) fwd_megakernel(Args a_kernarg) {
    extern __shared__ __attribute__((aligned(16))) unsigned char lds_raw[];
    cg::grid_group grid = cg::this_grid();
#define X make_ctx(lds_raw)
    { volatile LAS unsigned* st0 = (volatile LAS unsigned*)((LAS unsigned char*)lds_raw + LDS_BYTES - 64); if (threadIdx.x < 2) st0[threadIdx.x] = 0u; }
    __syncthreads();
    const XcdBarrier xbar = xcd_barrier_post((unsigned*)(kargs()->ws), (volatile LAS unsigned*)((LAS unsigned char*)lds_raw + LDS_BYTES - 64));
#define WSP(T, off) ((T*)(a->ws + (off)))

    phase0(X, kargs());
    if (gridDim.x == 0x7fffffffu) grid.sync();
    xcd_barrier(xbar);
    { KArgs a = kargs(); norm_pass<0>(X, a, a->x, WSP(bf16_t, WS_HBUF), nullptr); }
    __syncthreads();
    phase0_transposes(X, kargs(), 0, 16 * 96 + 16 * 72 + 16 * 64, X.gw, X.ngw);
    xcd_barrier(xbar);
    { KArgs a = kargs(); pg8::Gemm g{WSP(bf16_t, WS_HBUF), WSP(bf16_t, WS_WMAIN), NT, NMAIN, DM, DM, DM}; run_gemm<0>(X, g, FStoreProj{WSP(bf16_t, WS_BIG), WSP(f32x2, WS_ROPE)}); }
    { const int nfull = (gridDim.x > 64) ? 64 : 0;
      if ((int)blockIdx.x >= nfull) phase0_transposes(X, kargs(), 16 * 96 + 16 * 72 + 16 * 64, -1, ((int)blockIdx.x - nfull) * 8 + X.wave, ((int)gridDim.x - nfull) * 8); }
    xcd_barrier(xbar);
#pragma unroll 1
    for (int step = 0; step < 2; ++step) {
        if (((step ^ (int)blockIdx.x) & 1) == 0) { KArgs a = kargs(); gla_a1(X, a, a->out, WSP(float, WS_SSQ)); }
        else attn_mfma(X, kargs());
        __syncthreads();
    }
    xcd_barrier(xbar);
    { KArgs a = kargs(); gla_a2(X, a, a->out, WSP(float, WS_SSQ)); }
    xcd_barrier(xbar);
    if ((blockIdx.x & 1) == 0) { KArgs a = kargs(); pg8::Gemm g{WSP(bf16_t, WS_HBUF), WSP(bf16_t, WS_WMAB), NT, NGATE, DM, DM, DM};
        run_gemm<1>(X, g, FSigmoidSplit{(bf16_t*)a->out + (size_t)NT * DM, WSP(bf16_t, WS_BIG) + C_AK}); }
    __syncthreads();
    { KArgs a = kargs(); gla_a3(X, a, a->out); }
    attn_combine(X, kargs());
    __syncthreads();
    if ((blockIdx.x & 1) != 0) { KArgs a = kargs(); pg8::Gemm g{WSP(bf16_t, WS_HBUF), WSP(bf16_t, WS_WMAB), NT, NGATE, DM, DM, DM};
        run_gemm<1>(X, g, FSigmoidSplit{(bf16_t*)a->out + (size_t)NT * DM, WSP(bf16_t, WS_BIG) + C_AK}); }
    xcd_barrier(xbar);
    { KArgs a = kargs(); pg8::Gemm g{WSP(bf16_t, WS_BIG) + C_GR, WSP(bf16_t, WS_WG), NT, DM, 1280, NMAIN, 1280};
      pg8::StaticOrder S; S.init(NT, DM, (int)gridDim.x, (int)blockIdx.x);
      EpiMixed2 E{(const bf16_t*)a->out + (size_t)NT * DM, WSP(bf16_t, WS_BIG) + C_AK, WSP(bf16_t, WS_HBUF)};
      pg8::gemm_phase<EpiMixed2, true, false, 1>(X.lds, g, S, E); }
    xcd_barrier(xbar);
    { KArgs a = kargs(); pg8::Gemm g{WSP(bf16_t, WS_HBUF), WSP(bf16_t, WS_WOUT), NT, DM, DM, DM, DM};
      pg8::StaticOrder S; S.init(NT, DM, (int)gridDim.x, (int)blockIdx.x);
      EpiResNorm E{a->x, WSP(bf16_t, WS_BIG) + (size_t)48 * 1024 * 1024, WSP(bf16_t, WS_HBUF), WSP(float, WS_MOD), a->norm2_w, RmsPanel{WSP(float, WS_GLR), (unsigned*)(a->ws + 16384)}};
      pg8::gemm_phase<EpiResNorm, false>(X.lds, g, S, E); }
    xcd_barrier(xbar);
    { KArgs a = kargs(); pg8::Gemm g{WSP(bf16_t, WS_HBUF) - 2 * DM, WSP(bf16_t, WS_WUP), NT, NUP, DM, DM, DM};
      pg8::StaticOrder S; S.init_tiles(66, NUP / 256, (int)gridDim.x, (int)blockIdx.x);
      EpiConvGeglu E{WSP(bf16_t, WS_BIG), a->conv_w, a->conv_b};
      pg8::gemm_phase<EpiConvGeglu, true, true>(X.lds, g, S, E); }
    xcd_barrier(xbar);
    { KArgs a = kargs(); pg8::Gemm g{WSP(bf16_t, WS_BIG), WSP(bf16_t, WS_WDOWN), NT, DM, DFF, DFF, DFF};
      pg8::StaticOrder S; S.init(NT, DM, (int)gridDim.x, (int)blockIdx.x);
      EpiResFinal E{WSP(bf16_t, WS_BIG) + (size_t)48 * 1024 * 1024, a->out, WSP(float, WS_MOD), a->final_w, RmsPanel{WSP(float, WS_GLR) + 65536, (unsigned*)(a->ws + 32768)}};
      pg8::gemm_phase<EpiResFinal, false>(X.lds, g, S, E); }
#undef WSP
#undef X
}

extern "C" void kernel_launch(void* const* d_in, const int* in_sizes, int n_in, void* d_out, int out_size, void* d_ws, size_t ws_size, hipStream_t stream) {
    static int grid_blocks = 0;
    if (grid_blocks == 0) {
        if (n_in != 19 || out_size != NT * DM || ws_size < WS_END) { fprintf(stderr, "kernel_launch: unexpected sizes (n_in %d out %d ws %zu)\n", n_in, out_size, ws_size); grid_blocks = -1; return; }
        int dev = 0, cus = 0, per_cu = 0;
        hipGetDevice(&dev); hipDeviceGetAttribute(&cus, hipDeviceAttributeMultiprocessorCount, dev);
        hipFuncSetAttribute((const void*)fwd_megakernel, hipFuncAttributeMaxDynamicSharedMemorySize, LDS_BYTES);
        hipOccupancyMaxActiveBlocksPerMultiprocessor(&per_cu, (const void*)fwd_megakernel, 512, LDS_BYTES);
        if (per_cu < 1) { fprintf(stderr, "kernel_launch: occupancy query says %d blocks per CU\n", per_cu); per_cu = 1; }
        if (per_cu > 1) per_cu = 1;
        grid_blocks = cus * per_cu;
        (void)hipGetLastError();
    }
    if (grid_blocks < 0) return;
    Args a{};
    a.x = (const float*)d_in[0]; a.c = (const float*)d_in[1]; a.positions = (const int*)d_in[2]; a.ada_w = (const float*)d_in[3]; a.ada_b = (const float*)d_in[4];
    a.norm1_w = (const float*)d_in[5]; a.w_in = (const float*)d_in[6]; a.gate_w2 = (const float*)d_in[7]; a.gate_b = (const float*)d_in[8]; a.gla_norm_w = (const float*)d_in[9];
    a.w_gla = (const float*)d_in[10]; a.w_attn = (const float*)d_in[11]; a.w_out = (const float*)d_in[12]; a.norm2_w = (const float*)d_in[13]; a.w_up = (const float*)d_in[14];
    a.conv_w = (const float*)d_in[15]; a.conv_b = (const float*)d_in[16]; a.w_down = (const float*)d_in[17]; a.final_w = (const float*)d_in[18];
    a.out = (float*)d_out; a.ws = (unsigned char*)d_ws;
    (void)hipMemsetAsync(d_ws, 0, 65536, stream);
    void* args[] = {&a};
    hipError_t e = hipLaunchCooperativeKernel((const void*)fwd_megakernel, dim3(grid_blocks), dim3(512), args, LDS_BYTES, stream);
    if (e != hipSuccess) fprintf(stderr, "cooperative launch failed: %s (grid %d)\n", hipGetErrorString(e), grid_blocks);
}
```

```cpp
#include <hip/hip_runtime.h>
#include <hip/hip_cooperative_groups.h>
#include <cstdio>
#include <cstdint>
namespace cg = cooperative_groups;


#define LAS __attribute__((address_space(3)))
typedef unsigned short bf16_t;
typedef short bf16x8 __attribute__((ext_vector_type(8)));
typedef float f32x4 __attribute__((ext_vector_type(4)));
typedef float f32x2 __attribute__((ext_vector_type(2)));
typedef unsigned u32x4 __attribute__((ext_vector_type(4)));
typedef unsigned u32x2 __attribute__((ext_vector_type(2)));

constexpr int NB = 4, SEQ = 4096, DM = 1024, NT = NB * SEQ;
constexpr int DIN = 7440, NMAIN = 5376, NGATE = 2048;
constexpr int C_GQ = 0, C_GK = 512, C_GV = 1024, C_GR = 2048, C_AQ = 3072, C_AK = 3840, C_AV = 4608;
constexpr int DFF = 2816, NUP = 5632;
constexpr float EPS = 1e-6f;

constexpr size_t KiB = 1024, MiB = 1024 * 1024;
constexpr size_t WS_MOD = 256 * KiB;
constexpr size_t WS_WLR = 512 * KiB;
constexpr size_t WS_SSQ = 768 * KiB;
constexpr size_t WS_GLR = 1 * MiB;
constexpr size_t WS_LSE = 2 * MiB;
constexpr size_t WS_MODP = 3 * MiB;
constexpr size_t WS_ROPE = 6 * MiB;
constexpr size_t WS_WMAIN = 10 * MiB;
constexpr size_t WS_WMAB = WS_WMAIN + (size_t)NMAIN * DM * 2;
constexpr size_t WS_WG = WS_WMAB + (size_t)NGATE * DM * 2;
constexpr size_t WS_WA = WS_WG + (size_t)DM * DM * 2;
constexpr size_t WS_WOUT = WS_WA + (size_t)DM * 256 * 2;
constexpr size_t WS_WUP = WS_WOUT + (size_t)DM * DM * 2;
constexpr size_t WS_WDOWN = WS_WUP + (size_t)NUP * DM * 2;
constexpr size_t WS_WEND = WS_WDOWN + (size_t)DM * DFF * 2;
constexpr size_t WS_HBUF = 47 * MiB;
constexpr size_t WS_BIG = 79 * MiB;
constexpr size_t WS_END = 255 * MiB;
static_assert(WS_WEND <= WS_HBUF, "weights overflow");

constexpr int LDS_BYTES = 147456;

__device__ const double INVF_REV[32] = {
1.59154943091895346e-01, 1.19349370211248862e-01, 8.94994016088910133e-02, 6.71150830052272551e-02, 5.03292121044870353e-02, 3.77415847174197711e-02, 2.83021958306233987e-02, 2.12236527647776604e-02,
1.59154943091895339e-02, 1.19349370211248862e-02, 8.94994016088910237e-03, 6.71150830052272534e-03, 5.03292121044870370e-03, 3.77415847174197719e-03, 2.83021958306233987e-03, 2.12236527647776622e-03,
1.59154943091895356e-03, 1.19349370211248849e-03, 8.94994016088910237e-04, 6.71150830052272599e-04, 5.03292121044870326e-04, 3.77415847174197741e-04, 2.83021958306233954e-04, 2.12236527647776605e-04,
1.59154943091895351e-04, 1.19349370211248862e-04, 8.94994016088910182e-05, 6.71150830052272545e-05, 5.03292121044870354e-05, 3.77415847174197768e-05, 2.83021958306233961e-05, 2.12236527647776592e-05};

__device__ __forceinline__ float bf2f(bf16_t v) { return __uint_as_float((unsigned)v << 16); }

typedef __bf16 bf16x2_hw __attribute__((ext_vector_type(2)));
__device__ __forceinline__ unsigned f2bf(float f) { return (unsigned)__builtin_bit_cast(unsigned short, (__bf16)f); }
__device__ __forceinline__ unsigned pk2(float lo, float hi) { const f32x2 v = {lo, hi}; return __builtin_bit_cast(unsigned, __builtin_convertvector(v, bf16x2_hw)); }
__device__ __forceinline__ float lo16(unsigned w) { return __uint_as_float(w << 16); }
__device__ __forceinline__ float hi16(unsigned w) { return __uint_as_float(w & 0xffff0000u); }
__device__ __forceinline__ void unpack8(u32x4 w, float* f) { f[0] = lo16(w.x); f[1] = hi16(w.x); f[2] = lo16(w.y); f[3] = hi16(w.y); f[4] = lo16(w.z); f[5] = hi16(w.z); f[6] = lo16(w.w); f[7] = hi16(w.w); }
__device__ __forceinline__ u32x4 pack8(const float* f) { u32x4 w; w.x = pk2(f[0], f[1]); w.y = pk2(f[2], f[3]); w.z = pk2(f[4], f[5]); w.w = pk2(f[6], f[7]); return w; }
__device__ __forceinline__ float wave_sum(float v) {
#pragma unroll
    for (int o = 1; o < 64; o <<= 1) v += __shfl_xor(v, o);
    return v;
}
__device__ __forceinline__ float sigmoidf_(float x) { return __builtin_amdgcn_rcpf(1.0f + __expf(-x)); }

namespace pg8 {
constexpr int BM = 256, BK = 64, HALF = 128, HTB = HALF * BK * 2, STAGE_BYTES = 8 * HTB, NXCD = 8, WGM = 8;
__host__ __device__ __forceinline__ int lds_byte(int r, int c) { const int st = (r >> 4) * 2 + (c >> 5), rr = r & 15, cc = c & 31, ob = rr * 64 + cc * 2; return st * 1024 + (ob ^ (((ob >> 9) & 1) << 5)); }
__host__ __device__ __forceinline__ void stage_rc(int b, int& R, int& C) { const int st = b / 1024, sb = b % 1024, swz = sb ^ (((sb >> 9) & 1) << 5); R = (st >> 1) * 16 + swz / 64; C = (st & 1) * 32 + (swz % 64) / 2; }
__host__ __device__ __forceinline__ int perm32(int rho) { const int n = rho >> 4, i = rho & 15; return 8 * (i >> 2) + 4 * n + (i & 3); }

struct Unit { int pm, pn; };
struct Gemm { const bf16_t* A; const bf16_t* Bt; int M, N, K, lda, ldb; };

struct StaticOrder {
    int nM, nN, nwg, G, c;
    __host__ __device__ void init(int M, int N, int G_, int c_) { nM = M / BM; nN = N / BM; nwg = nM * nN; G = G_; c = c_; }
    __host__ __device__ void init_tiles(int nM_, int nN_, int G_, int c_) { nM = nM_; nN = nN_; nwg = nM * nN; G = G_; c = c_; }
    __host__ __device__ bool next(int i, Unit& u) const {
        const long L = (long)i * G + c; if (L >= nwg) return false;
        int wgid = (int)L; { const int q = nwg / NXCD, r = nwg % NXCD, xcd = wgid % NXCD, off = wgid / NXCD; wgid = (xcd < r ? xcd * (q + 1) : r * (q + 1) + (xcd - r) * q) + off; }
        const int nig = WGM * nN, gid = wgid / nig, fm = gid * WGM, gsz = (nM - fm) < WGM ? (nM - fm) : WGM;
        u.pm = fm + ((wgid % nig) % gsz); u.pn = (wgid % nig) / gsz; return true;
    }
};

template <class F> struct EpiRow8 {
    static constexpr bool PERM = true, AFTER_DRAIN = false, MIDHOOK = false;
    F f;
    __device__ __forceinline__ void operator()(const f32x4 (&acc)[2][2][4][2], const Unit& u, int wr, int wc, int fr, int fq) const {
        const int row0 = u.pm * BM + wr * 64 + fr, col0 = u.pn * BM + wc * 32 + 8 * fq;
#pragma unroll
        for (int ai = 0; ai < 2; ++ai)
#pragma unroll
            for (int m = 0; m < 4; ++m) {
#pragma unroll
                for (int bj = 0; bj < 2; ++bj) f(row0 + ai * HALF + m * 16, col0 + bj * HALF, acc[ai][bj][m][0], acc[ai][bj][m][1]);
                if (m == 3) asm volatile("" ::: "memory");
            }
    }
};

template <class Epi, bool ALIGN_EPI = true, bool CONVMAP = false, int AKSPLIT = 0>
__device__ __forceinline__ void gemm_phase(LAS unsigned char* lds, const Gemm g, const StaticOrder& S, const Epi& E) {
    int tid_ = threadIdx.x; asm volatile("" : "+v"(tid_));
    const int tid = tid_, wid = __builtin_amdgcn_readfirstlane(tid >> 6), lane = tid & 63, wr = wid >> 2, wc = wid & 3, fr = lane & 15, fq = lane >> 4;
    const int K = g.K, nt = K / BK;
    unsigned voffA[2], voffB[2];
#pragma unroll
    for (int i = 0; i < 2; ++i) { int R, C; stage_rc(tid * 16 + i * 8192, R, C); const int Rb = Epi::PERM ? ((R & ~31) + perm32(R & 31)) : R;
        const int Ra = CONVMAP ? (126 * (R >> 6) + 8 * (R & 15) + ((R >> 4) & 3)) : R;
        voffA[i] = (unsigned)(Ra * g.lda + C) * 2u; voffB[i] = (unsigned)(Rb * g.ldb + C) * 2u; }
    const unsigned kstep = (unsigned)(BK * 2);
    const unsigned hstepA = (unsigned)(CONVMAP ? 4 : HALF) * g.lda * 2, hstepB = (unsigned)HALF * g.ldb * 2;
    const unsigned tstepA = CONVMAP ? 252u * g.lda * 2 : 2 * hstepA, tstepB = 2 * hstepB;
    const char* const baseA = (const char*)g.A; const char* const baseB = (const char*)g.Bt;
    const unsigned ldsw = (unsigned)wid * 1024u;
    const int aoff = lds_byte(wr * 64 + fr, fq * 8), boff = lds_byte(wc * 32 + fr, fq * 8);
#define PG8_SA(b, h) (((b) * 2 + (h)) * HTB)
#define PG8_SB(b, h) ((4 + (b) * 2 + (h)) * HTB)
#define PG8_STAGE(bufoff, goff, voff) do { _Pragma("unroll") for (int _i = 0; _i < 2; ++_i) { unsigned _vo = (voff)[_i] + (goff); asm volatile("" : "+v"(_vo)); \
        __builtin_amdgcn_global_load_lds((const unsigned*)(base_##voff + _vo), (LAS unsigned*)(lds + (bufoff) + ldsw + _i * 8192), 16, 0, 0); } } while (0)
#define base_voffA baseA
#define base_voffB baseB
#define PG8_LDA(dst, b, h) do { _Pragma("unroll") for (int m = 0; m < 4; ++m) _Pragma("unroll") for (int k = 0; k < 2; ++k) dst[m][k] = *(const LAS bf16x8*)(lds + PG8_SA(b, h) + aoff + m * 2048 + k * 1024); } while (0)
#define PG8_LDB(dst, b, h) do { _Pragma("unroll") for (int n = 0; n < 2; ++n) _Pragma("unroll") for (int k = 0; k < 2; ++k) dst[n][k] = *(const LAS bf16x8*)(lds + PG8_SB(b, h) + boff + n * 2048 + k * 1024); } while (0)
#define PG8_MMA(ai, bj, At, Bt) do { __builtin_amdgcn_s_setprio(1); _Pragma("unroll") for (int m = 0; m < 4; ++m) _Pragma("unroll") for (int n = 0; n < 2; ++n) _Pragma("unroll") for (int k = 0; k < 2; ++k) \
        acc[ai][bj][m][n] = __builtin_amdgcn_mfma_f32_16x16x32_bf16(Bt[n][k], At[m][k], acc[ai][bj][m][n], 0, 0, 0); __builtin_amdgcn_s_setprio(0); } while (0)
#define PG8_KOFFA(x) ((unsigned)(x) * kstep + (AKSPLIT ? ((x) < 4 ? 2048u : 0xFFFFFE00u) : 0u))
#define PG8_WAIT_V(n) asm volatile("s_waitcnt vmcnt(" #n ")" ::: "memory")
#define PG8_WAIT_L(n) asm volatile("s_waitcnt lgkmcnt(" #n ")" ::: "memory")
#define PG8_BAR __builtin_amdgcn_s_barrier()
#define PG8_SCHED __builtin_amdgcn_sched_barrier(0)
    Unit cur, nxt; int ui = 0;
    if (!S.next(0, cur)) return;
    f32x4 acc[2][2][4][2];
#pragma unroll
    for (int a = 0; a < 2; ++a)
#pragma unroll
        for (int b = 0; b < 2; ++b)
#pragma unroll
            for (int m = 0; m < 4; ++m)
#pragma unroll
                for (int n = 0; n < 2; ++n) acc[a][b][m][n] = (f32x4){0.f, 0.f, 0.f, 0.f};
    bf16x8 At[4][2], B0[2][2], B1[2][2];
    unsigned cA = (unsigned)cur.pm * tstepA, cB = (unsigned)cur.pn * tstepB;
    PG8_STAGE(PG8_SB(0, 0), cB, voffB); PG8_STAGE(PG8_SB(0, 1), cB + hstepB, voffB); PG8_STAGE(PG8_SA(0, 0), cA + PG8_KOFFA(0), voffA); PG8_STAGE(PG8_SA(0, 1), cA + hstepA + PG8_KOFFA(0), voffA);
    if (wr == 1) PG8_BAR;
    PG8_WAIT_V(2); PG8_BAR;
    PG8_STAGE(PG8_SB(1, 0), cB + kstep, voffB); PG8_STAGE(PG8_SA(1, 0), cA + PG8_KOFFA(1), voffA); PG8_STAGE(PG8_SB(1, 1), cB + hstepB + kstep, voffB);
    PG8_WAIT_V(6); PG8_BAR;
    for (;;) {
        const bool has_next = S.next(ui + 1, nxt);
        const unsigned nA = has_next ? (unsigned)nxt.pm * tstepA : cA, nB = has_next ? (unsigned)nxt.pn * tstepB : cB;
#define PG8_ITER(t) do { \
            const bool last = (t == nt - 2); \
            const unsigned a1 = cA + PG8_KOFFA(t + 1); \
            const unsigned a2 = last ? nA + PG8_KOFFA(0) : cA + PG8_KOFFA(t + 2), b2 = last ? nB : cB + (unsigned)(t + 2) * kstep; \
            const unsigned a3 = a2 + kstep, b3 = b2 + kstep; \
            PG8_LDB(B0, 0, 0); PG8_LDB(B1, 0, 1); PG8_SCHED; PG8_LDA(At, 0, 0); PG8_STAGE(PG8_SA(1, 1), a1 + hstepA, voffA); \
            PG8_WAIT_V(8); PG8_WAIT_L(0); PG8_BAR; PG8_MMA(0, 0, At, B0); PG8_MMA(0, 1, At, B1); PG8_BAR; PG8_SCHED; \
            PG8_LDA(At, 0, 1); PG8_STAGE(PG8_SB(0, 0), b2, voffB); PG8_STAGE(PG8_SB(0, 1), b2 + hstepB, voffB); PG8_STAGE(PG8_SA(0, 0), a2, voffA); \
            PG8_WAIT_V(8); PG8_WAIT_L(0); PG8_BAR; PG8_MMA(1, 0, At, B0); PG8_MMA(1, 1, At, B1); PG8_BAR; PG8_SCHED; \
            PG8_LDB(B0, 1, 0); PG8_LDB(B1, 1, 1); PG8_SCHED; PG8_LDA(At, 1, 0); PG8_STAGE(PG8_SA(0, 1), a2 + hstepA, voffA); \
            PG8_WAIT_V(8); PG8_WAIT_L(0); PG8_BAR; PG8_MMA(0, 0, At, B0); PG8_MMA(0, 1, At, B1); PG8_BAR; PG8_SCHED; \
            PG8_LDA(At, 1, 1); PG8_STAGE(PG8_SB(1, 0), b3, voffB); PG8_STAGE(PG8_SB(1, 1), b3 + hstepB, voffB); PG8_STAGE(PG8_SA(1, 0), a3, voffA); \
            PG8_WAIT_V(8); PG8_WAIT_L(0); PG8_BAR; PG8_MMA(1, 0, At, B0); PG8_MMA(1, 1, At, B1); PG8_BAR; PG8_SCHED; \
        } while (0)
        if constexpr (Epi::MIDHOOK) {
            for (int t = 0; t < 4; t += 2) PG8_ITER(t);
            E.mid(acc, cur, wr, wc, fr, fq);
            for (int t = 4; t < nt; t += 2) PG8_ITER(t);
        } else {
            for (int t = 0; t < nt; t += 2) PG8_ITER(t);
        }
#undef PG8_ITER
        if constexpr (ALIGN_EPI) { if (wr == 0) PG8_BAR; }
        if constexpr (!Epi::AFTER_DRAIN) { E(acc, cur, wr, wc, fr, fq); }
        if (!has_next) break;
#pragma unroll
        for (int a = 0; a < 2; ++a)
#pragma unroll
            for (int b = 0; b < 2; ++b)
#pragma unroll
                for (int m = 0; m < 4; ++m)
#pragma unroll
                    for (int n = 0; n < 2; ++n) acc[a][b][m][n] = (f32x4){0.f, 0.f, 0.f, 0.f};
        cur = nxt; cA = nA; cB = nB; ++ui;
        if constexpr (ALIGN_EPI) { if (wr == 1) PG8_BAR; }
    }
    PG8_WAIT_V(0);
    if constexpr (!ALIGN_EPI) { if (wr == 0) PG8_BAR; }
    PG8_BAR;
    if constexpr (Epi::AFTER_DRAIN) { E.fused(acc, cur, wr, wc, fr, fq, lds, wid, lane); }
#undef PG8_SA
#undef PG8_SB
#undef PG8_STAGE
#undef base_voffA
#undef base_voffB
#undef PG8_LDA
#undef PG8_LDB
#undef PG8_MMA
#undef PG8_WAIT_V
#undef PG8_KOFFA
#undef PG8_WAIT_L
#undef PG8_BAR
#undef PG8_SCHED
}
}


#define XB_TMO      128
#define XB_XCNT(j)  (256  + 64 * (j))
#define XB_XSUB(j)  (1280 + 64 * (j))
#define XB_XGEN(j)  (2304 + 64 * (j))
#define XB_TOP      3328
#define XB_TOPGEN   3392
#define XCD_BAR_WORDS 3456
#define XB_SPIN_CAP (1u << 18)
__device__ __forceinline__ unsigned xb_ld(unsigned* p)              { return __hip_atomic_load(p, __ATOMIC_RELAXED, __HIP_MEMORY_SCOPE_AGENT); }
__device__ __forceinline__ unsigned xb_add(unsigned* p, unsigned v) { return __hip_atomic_fetch_add(p, v, __ATOMIC_RELAXED, __HIP_MEMORY_SCOPE_AGENT); }
__device__ __forceinline__ unsigned xb_xcc_id() { return (unsigned)__builtin_amdgcn_s_getreg((3 << 11) | 20) & 0xFu; }
#define XB_SPIN(cond, bar) do { unsigned _sp = 0; while (cond) { __builtin_amdgcn_s_sleep(1); \
    if ((++_sp & 255u) == 0u) { if (xb_ld(&(bar)[XB_TMO])) break; if (_sp > XB_SPIN_CAP) { atomicAdd(&(bar)[XB_TMO], 1u); break; } } } } while (0)
struct XcdBarrier { unsigned* bar; unsigned x; volatile LAS unsigned* st; };
__device__ __forceinline__ XcdBarrier xcd_barrier_post(unsigned* bar, volatile LAS unsigned* st) {
    XcdBarrier b; b.bar = bar; b.x = xb_xcc_id(); b.st = st;
    if (threadIdx.x == 0) (void)xb_add(&bar[XB_XCNT(b.x)], 1u);
    return b;
}
__device__ __forceinline__ void xcd_barrier_complete(unsigned* bar, unsigned x, unsigned& nloc, unsigned& nx) {
    const unsigned G = gridDim.x * gridDim.y * gridDim.z;
    unsigned sum, cnt, mine, sp = 0u;
    for (;;) {
        sum = 0u; cnt = 0u; mine = 0u;
#pragma unroll
        for (unsigned j = 0; j < 16; ++j) { const unsigned c = xb_ld(&bar[XB_XCNT(j)]); sum += c; cnt += (c > 0u) ? 1u : 0u; mine = (j == x) ? c : mine; }
        if (sum == G) break;
        __builtin_amdgcn_s_sleep(1);
        if ((++sp & 255u) == 0u) { if (xb_ld(&bar[XB_TMO])) break; if (sp > XB_SPIN_CAP) { atomicAdd(&bar[XB_TMO], 1u); break; } }
    }
    nloc = mine > 0u ? mine : 1u; nx = cnt > 0u ? cnt : 1u;
}
__device__ __forceinline__ void xcd_barrier(const XcdBarrier& b) {
    asm volatile("s_waitcnt vmcnt(0)" ::: "memory");
    __syncthreads();
    if (threadIdx.x == 0) {
        unsigned* bar = b.bar;
        __builtin_amdgcn_s_waitcnt(0);
        unsigned nloc = b.st[0], nx = b.st[1];
        if (nloc == 0u) { xcd_barrier_complete(bar, b.x, nloc, nx); b.st[0] = nloc; b.st[1] = nx; }
        const unsigned old = xb_add(&bar[XB_XSUB(b.x)], 1u);
        const unsigned gen = old / nloc;
        if (old + 1u == (gen + 1u) * nloc) {
            __builtin_amdgcn_fence(__ATOMIC_RELEASE, "agent");
            asm volatile("s_waitcnt vmcnt(0)" ::: "memory");
            const unsigned og = xb_add(&bar[XB_TOP], 1u);
            const unsigned tg = og / nx;
            if (og + 1u == (tg + 1u) * nx) xb_add(&bar[XB_TOPGEN], 1u);
            else XB_SPIN(xb_ld(&bar[XB_TOPGEN]) == tg, bar);
            __builtin_amdgcn_fence(__ATOMIC_ACQUIRE, "agent");
            xb_add(&bar[XB_XGEN(b.x)], 1u);
            asm volatile("s_waitcnt vmcnt(0)" ::: "memory");
        } else {
            XB_SPIN(xb_ld(&bar[XB_XGEN(b.x)]) == gen, bar);
            __builtin_amdgcn_fence(__ATOMIC_ACQUIRE, "agent");
            asm volatile("s_waitcnt vmcnt(0)" ::: "memory");
        }
    }
    __syncthreads();
}

struct Args {
    const float* x; const float* c; const int* positions; const float* ada_w; const float* ada_b; const float* norm1_w; const float* w_in;
    const float* gate_w2; const float* gate_b; const float* gla_norm_w; const float* w_gla; const float* w_attn; const float* w_out; const float* norm2_w;
    const float* w_up; const float* conv_w; const float* conv_b; const float* w_down; const float* final_w;
    float* out; unsigned char* ws;
};

typedef const __attribute__((address_space(4))) Args* KArgs;
__device__ __forceinline__ KArgs kargs() { KArgs p = (KArgs)__builtin_amdgcn_kernarg_segment_ptr(); asm volatile("" : "+s"(p)); return p; }

struct Ctx { int tid, lane, wave, gtid, nthr, gw, ngw; LAS unsigned char* lds; };

__device__ __forceinline__ Ctx make_ctx(unsigned char* lds_raw) {
    Ctx X; int t = threadIdx.x; asm volatile("" : "+v"(t)); X.tid = t; X.lane = X.tid & 63; X.wave = __builtin_amdgcn_readfirstlane(X.tid >> 6);
    X.gtid = blockIdx.x * 512 + X.tid; X.nthr = gridDim.x * 512; X.gw = blockIdx.x * 8 + X.wave; X.ngw = gridDim.x * 8; X.lds = (LAS unsigned char*)lds_raw; return X; }

template <int ID, class F> __device__ __forceinline__ void run_gemm(const Ctx& X, const pg8::Gemm g, const F& f) {
    pg8::StaticOrder S; S.init(g.M, g.N, (int)gridDim.x, (int)blockIdx.x);
    pg8::EpiRow8<F> E{f};
    pg8::gemm_phase<pg8::EpiRow8<F>, true>(X.lds, g, S, E);
}

struct FStoreProj { bf16_t* O; const f32x2* rope;
    __device__ __forceinline__ void operator()(int row, int col, f32x4 v0, f32x4 v1) const {
        if (col >= C_AQ && col < C_AV) { const int g8 = ((col - C_AQ) & 63) >> 3; const f32x4* rp = (const f32x4*)(rope + (size_t)row * 32 + 4 * g8); const f32x4 r0 = rp[0], r1 = rp[1];
            const f32x4 cs = {r0[0], r0[2], r1[0], r1[2]}, sn = {r0[1], r0[3], r1[1], r1[3]}; const float sc = col < C_AK ? 0.125f : 1.0f;
            const f32x4 a0 = (v0 * cs - v1 * sn) * sc, a1 = (v1 * cs + v0 * sn) * sc; v0 = a0; v1 = a1; }
        u32x4 w; w.x = pk2(v0[0], v0[1]); w.y = pk2(v0[2], v0[3]); w.z = pk2(v1[0], v1[1]); w.w = pk2(v1[2], v1[3]);
        *(u32x4*)(O + (size_t)row * NMAIN + col) = w; } };
struct FSigmoidSplit { bf16_t* GA; bf16_t* GB;
    __device__ __forceinline__ void operator()(int row, int col, f32x4 v0, f32x4 v1) const {
        u32x4 w; w.x = pk2(sigmoidf_(v0[0]), sigmoidf_(v0[1])); w.y = pk2(sigmoidf_(v0[2]), sigmoidf_(v0[3])); w.z = pk2(sigmoidf_(v1[0]), sigmoidf_(v1[1])); w.w = pk2(sigmoidf_(v1[2]), sigmoidf_(v1[3]));
        if (col < 1024) *(u32x4*)(GA + (size_t)row * DM + col) = w; else *(u32x4*)(GB + (size_t)row * NMAIN + (col - 1024)) = w; } };
__device__ __forceinline__ f32x2 gelu_pk(f32x2 v) {
    const f32x2 av = __builtin_elementwise_abs(v), d = av * 0.2316418882f + 1.0f;
    f32x2 t; t.x = __builtin_amdgcn_rcpf(d.x); t.y = __builtin_amdgcn_rcpf(d.y);
    f32x2 q = t * 0.5307027145f + (-0.7265760135f); q = q * t + 0.7107068705f; q = q * t + (-0.142248368f); q = q * t + 0.127414796f; q = q * t;
    const f32x2 s = (v * v) * (-0.72134752044f);
    f32x2 e; e.x = __builtin_amdgcn_exp2f(s.x); e.y = __builtin_amdgcn_exp2f(s.y);
    const f32x2 m = av * (q * e);
    f32x2 o; o.x = fmaxf(v.x, 0.f) - m.x; o.y = fmaxf(v.y, 0.f) - m.y; return o;
}
__device__ __forceinline__ f32x4 dpp_shr1(f32x4 x) {
    f32x4 r;
#pragma unroll
    for (int j = 0; j < 4; ++j) r[j] = __int_as_float(__builtin_amdgcn_update_dpp(0, __float_as_int(x[j]), 0x111, 0xf, 0xf, false));
    return r;
}
struct EpiConvGeglu {
    static constexpr bool PERM = true, AFTER_DRAIN = false, MIDHOOK = false;
    bf16_t* hidden; const float* conv_w; const float* conv_b;
    template <bool EDGE> __device__ __forceinline__ void body(const f32x4 (&acc)[2][2][4][2], const pg8::Unit& u, int wr, int wc, int fr, int fq) const {
        const int tw0 = 252 * u.pm - 2 + 126 * wr;
        const int chb = 128 * u.pn + 32 * wc + 8 * fq;
#pragma unroll
        for (int n = 0; n < 2; ++n) {
            const int ch = chb + 4 * n;
            const f32x4 wv0 = *(const f32x4*)(conv_w + ch), wv1 = *(const f32x4*)(conv_w + NUP + ch), wv2 = *(const f32x4*)(conv_w + 2 * NUP + ch), bv = *(const f32x4*)(conv_b + ch);
            const f32x4 wg0 = *(const f32x4*)(conv_w + DFF + ch), wg1 = *(const f32x4*)(conv_w + NUP + DFF + ch), wg2 = *(const f32x4*)(conv_w + 2 * NUP + DFF + ch), bg = *(const f32x4*)(conv_b + DFF + ch);
            const f32x4 v7 = dpp_shr1(acc[1][0][3][n]), v6 = dpp_shr1(acc[1][0][2][n]), g7 = dpp_shr1(acc[1][1][3][n]), g6 = dpp_shr1(acc[1][1][2][n]);
#pragma unroll
            for (int k = 0; k < 8; ++k) {
                const int ai = k >> 2, m = k & 3, lr = 8 * fr + k, tau = tw0 + lr, sp = tau & 4095;
                const f32x4 cv = acc[ai][0][m][n], cg = acc[ai][1][m][n];
                const f32x4 p1v = k >= 1 ? acc[(k >= 1 ? k - 1 : 0) >> 2][0][(k >= 1 ? k - 1 : 0) & 3][n] : v7;
                const f32x4 p1g = k >= 1 ? acc[(k >= 1 ? k - 1 : 0) >> 2][1][(k >= 1 ? k - 1 : 0) & 3][n] : g7;
                const f32x4 p2v = k >= 2 ? acc[(k >= 2 ? k - 2 : 0) >> 2][0][(k >= 2 ? k - 2 : 0) & 3][n] : (k == 1 ? v7 : v6);
                const f32x4 p2g = k >= 2 ? acc[(k >= 2 ? k - 2 : 0) >> 2][1][(k >= 2 ? k - 2 : 0) & 3][n] : (k == 1 ? g7 : g6);
                f32x4 val, gat;
                if (EDGE) { const float m1 = sp >= 1 ? 1.f : 0.f, m2 = sp >= 2 ? 1.f : 0.f;
                    val = bv + wv2 * cv + (wv1 * m1) * p1v + (wv0 * m2) * p2v; gat = bg + wg2 * cg + (wg1 * m1) * p1g + (wg0 * m2) * p2g; }
                else { val = bv + wv2 * cv + wv1 * p1v + wv0 * p2v; gat = bg + wg2 * cg + wg1 * p1g + wg0 * p2g; }
                const f32x2 g01 = gelu_pk((f32x2){gat[0], gat[1]}), g23 = gelu_pk((f32x2){gat[2], gat[3]});
                u32x2 w; w.x = pk2(g01.x * val[0], g01.y * val[1]); w.y = pk2(g23.x * val[2], g23.y * val[3]);
                if (lr >= 2 && tau < NT) *(u32x2*)((char*)hidden + (unsigned)(tau * DFF + ch) * 2u) = w;
            }
            asm volatile("" ::: "memory");
        }
    }
    __device__ __forceinline__ void operator()(const f32x4 (&acc)[2][2][4][2], const pg8::Unit& u, int wr, int wc, int fr, int fq) const {
        const int tw0 = 252 * u.pm - 2 + 126 * wr;
        const bool edge = (tw0 <= 1) || ((tw0 & 4095) < 2) || (((tw0 + 127) >> 12) != (tw0 >> 12));
        if (edge) body<true>(acc, u, wr, wc, fr, fq); else body<false>(acc, u, wr, wc, fr, fq);
    }
};

struct EpiMixed2 {
    static constexpr bool PERM = true, AFTER_DRAIN = false, MIDHOOK = true;
    const bf16_t* gA; const bf16_t* gB; bf16_t* O;
    __device__ __forceinline__ void mid(f32x4 (&acc)[2][2][4][2], const pg8::Unit& u, int wr, int wc, int fr, int fq) const {
        const int row0 = u.pm * 256 + wr * 64 + fr, col0 = u.pn * 256 + wc * 32 + 8 * fq;
#pragma unroll
        for (int ai = 0; ai < 2; ++ai)
#pragma unroll
            for (int m = 0; m < 4; ++m) { const int row = row0 + ai * 128 + m * 16;
#pragma unroll
                for (int bj = 0; bj < 2; ++bj) { const int col = col0 + bj * 128;
                    const u32x4 aw = *(const u32x4*)((const char*)gA + (unsigned)(row * DM + col) * 2u), bw = *(const u32x4*)((const char*)gB + (unsigned)(row * NMAIN + col) * 2u);
                    f32x4 r0, r1;
                    r0[0] = lo16(bw.x) * __builtin_amdgcn_rcpf(fmaxf(lo16(aw.x), 1e-20f)); r0[1] = hi16(bw.x) * __builtin_amdgcn_rcpf(fmaxf(hi16(aw.x), 1e-20f));
                    r0[2] = lo16(bw.y) * __builtin_amdgcn_rcpf(fmaxf(lo16(aw.y), 1e-20f)); r0[3] = hi16(bw.y) * __builtin_amdgcn_rcpf(fmaxf(hi16(aw.y), 1e-20f));
                    r1[0] = lo16(bw.z) * __builtin_amdgcn_rcpf(fmaxf(lo16(aw.z), 1e-20f)); r1[1] = hi16(bw.z) * __builtin_amdgcn_rcpf(fmaxf(hi16(aw.z), 1e-20f));
                    r1[2] = lo16(bw.w) * __builtin_amdgcn_rcpf(fmaxf(lo16(aw.w), 1e-20f)); r1[3] = hi16(bw.w) * __builtin_amdgcn_rcpf(fmaxf(hi16(aw.w), 1e-20f));
                    acc[ai][bj][m][0] *= r0; acc[ai][bj][m][1] *= r1;
                    asm volatile("" ::: "memory"); } }
    }
    __device__ __forceinline__ void operator()(const f32x4 (&acc)[2][2][4][2], const pg8::Unit& u, int wr, int wc, int fr, int fq) const {
        const int row0 = u.pm * 256 + wr * 64 + fr, col0 = u.pn * 256 + wc * 32 + 8 * fq;
#pragma unroll
        for (int ai = 0; ai < 2; ++ai) {
#pragma unroll
            for (int m = 0; m < 4; ++m) { const int row = row0 + ai * 128 + m * 16;
#pragma unroll
                for (int bj = 0; bj < 2; ++bj) { const int col = col0 + bj * 128; float a8[8]; unpack8(*(const u32x4*)(gA + (size_t)row * DM + col), a8);
                    const f32x4 v0 = acc[ai][bj][m][0], v1 = acc[ai][bj][m][1];
                    float o[8] = {v0[0] * a8[0], v0[1] * a8[1], v0[2] * a8[2], v0[3] * a8[3], v1[0] * a8[4], v1[1] * a8[5], v1[2] * a8[6], v1[3] * a8[7]};
                    *(u32x4*)(O + (size_t)row * DM + col) = pack8(o); } }
            asm volatile("" ::: "memory");
        }
    }
};

struct RmsPanel {
    float* xbuf;
    unsigned* cnt;
    __device__ __forceinline__ void run(const pg8::Unit& u, LAS unsigned char* lds, int wid, int lane) const {
        LAS float* P = (LAS float*)lds; LAS float* S = (LAS float*)(lds + 4096);
        asm volatile("s_waitcnt lgkmcnt(0)" ::: "memory"); __builtin_amdgcn_s_barrier(); asm volatile("" ::: "memory");
        const int row = wid * 32 + (lane & 31);
        if (lane < 32) { const float tot = (P[row * 4 + 0] + P[row * 4 + 1]) + (P[row * 4 + 2] + P[row * 4 + 3]);
            __hip_atomic_store(xbuf + (size_t)(u.pm * 256 + row) * 4 + u.pn, tot, __ATOMIC_RELAXED, __HIP_MEMORY_SCOPE_AGENT); }
        asm volatile("s_waitcnt vmcnt(0)" ::: "memory");
        if (lane == 0) __hip_atomic_fetch_add(cnt + 64 * u.pm, 1u, __ATOMIC_RELAXED, __HIP_MEMORY_SCOPE_AGENT);
        if (wid == 0) { unsigned sp = 0;
            for (;;) { if ((unsigned)__builtin_amdgcn_readfirstlane(__hip_atomic_load(cnt + 64 * u.pm, __ATOMIC_RELAXED, __HIP_MEMORY_SCOPE_AGENT)) >= 32u) break;
                if (++sp > (1u << 22)) break; __builtin_amdgcn_s_sleep(2); }
            __builtin_amdgcn_fence(__ATOMIC_ACQUIRE, "agent"); }
        asm volatile("s_waitcnt vmcnt(0) lgkmcnt(0)" ::: "memory"); __builtin_amdgcn_s_barrier(); asm volatile("" ::: "memory");
        if (lane < 32) { const float* slot = xbuf + (size_t)(u.pm * 256 + row) * 4; float q = 0.f;
#pragma unroll
            for (int t = 0; t < 4; ++t) q += __hip_atomic_load(slot + t, __ATOMIC_RELAXED, __HIP_MEMORY_SCOPE_AGENT);
            S[row] = 1.0f / sqrtf(q * (1.0f / 1024.0f) + EPS); }
        asm volatile("s_waitcnt lgkmcnt(0)" ::: "memory"); __builtin_amdgcn_s_barrier(); asm volatile("" ::: "memory");
    }
};
struct EpiResNorm {
    static constexpr bool PERM = true, AFTER_DRAIN = true, MIDHOOK = false;
    const float* base; bf16_t* x1b; bf16_t* hn; const float* mod; const float* nw; RmsPanel st;
    __device__ __forceinline__ void fused(f32x4 (&acc)[2][2][4][2], const pg8::Unit& u, int wr, int wc, int fr, int fq, LAS unsigned char* lds, int wid, int lane) const {
        const int col0 = u.pn * 256 + wc * 32 + 8 * fq, b = (u.pm * 256) >> 12; const float* mb = mod + (size_t)b * 6144;
        { LAS float* P = (LAS float*)lds;
          f32x4 gg[2][2];
#pragma unroll
          for (int bj = 0; bj < 2; ++bj) { gg[bj][0] = *(const f32x4*)(mb + 2048 + col0 + bj * 128); gg[bj][1] = *(const f32x4*)(mb + 2048 + col0 + bj * 128 + 4); }
          f32x4 nb[2][2];
          { const float* bp = base + (size_t)(u.pm * 256 + wr * 64 + fr) * DM + col0;
#pragma unroll
            for (int bj = 0; bj < 2; ++bj) { nb[bj][0] = __builtin_nontemporal_load((const f32x4*)(bp + bj * 128)); nb[bj][1] = __builtin_nontemporal_load((const f32x4*)(bp + bj * 128 + 4)); } }
#pragma unroll
          for (int k = 0; k < 8; ++k) { const int ai = k >> 2, m = k & 3, r = ai * 128 + wr * 64 + m * 16 + fr; float s = 0.f;
              f32x4 cb[2][2];
#pragma unroll
              for (int bj = 0; bj < 2; ++bj) { cb[bj][0] = nb[bj][0]; cb[bj][1] = nb[bj][1]; }
              if (k < 7) { const int k2 = k + 1; const float* bp = base + (size_t)(u.pm * 256 + (k2 >> 2) * 128 + wr * 64 + (k2 & 3) * 16 + fr) * DM + col0;
#pragma unroll
                  for (int bj = 0; bj < 2; ++bj) { nb[bj][0] = __builtin_nontemporal_load((const f32x4*)(bp + bj * 128)); nb[bj][1] = __builtin_nontemporal_load((const f32x4*)(bp + bj * 128 + 4)); } }
#pragma unroll
              for (int bj = 0; bj < 2; ++bj) { const f32x4 x0 = cb[bj][0] + gg[bj][0] * acc[ai][bj][m][0], x1 = cb[bj][1] + gg[bj][1] * acc[ai][bj][m][1];
                  acc[ai][bj][m][0] = x0; acc[ai][bj][m][1] = x1;
                  s += ((x0[0] * x0[0] + x0[1] * x0[1]) + (x0[2] * x0[2] + x0[3] * x0[3])) + ((x1[0] * x1[0] + x1[1] * x1[1]) + (x1[2] * x1[2] + x1[3] * x1[3])); }
              s += __shfl_xor(s, 16); s += __shfl_xor(s, 32);
              if (fq == 0) P[r * 4 + wc] = s;
              asm volatile("" ::: "memory"); } }
        st.run(u, lds, wid, lane);
        const LAS float* S = (const LAS float*)(lds + 4096);
#pragma unroll
        for (int bj = 0; bj < 2; ++bj) { const int col = col0 + bj * 128;
            f32x4 g2[2], s2[2];
#pragma unroll
            for (int n = 0; n < 2; ++n) { g2[n] = *(const f32x4*)(nw + col + 4 * n) * (*(const f32x4*)(mb + 4096 + col + 4 * n) + 1.0f); s2[n] = *(const f32x4*)(mb + 3072 + col + 4 * n); }
#pragma unroll
            for (int ai = 0; ai < 2; ++ai)
#pragma unroll
                for (int m = 0; m < 4; ++m) { const int r = ai * 128 + wr * 64 + m * 16 + fr; const float rstd = S[r]; const size_t off = (size_t)(u.pm * 256 + r) * DM + col;
                    { u32x4 xw; xw.x = pk2(acc[ai][bj][m][0][0], acc[ai][bj][m][0][1]); xw.y = pk2(acc[ai][bj][m][0][2], acc[ai][bj][m][0][3]); xw.z = pk2(acc[ai][bj][m][1][0], acc[ai][bj][m][1][1]); xw.w = pk2(acc[ai][bj][m][1][2], acc[ai][bj][m][1][3]);
                      *(u32x4*)(x1b + off) = xw; }
                    const f32x4 y0 = acc[ai][bj][m][0] * rstd * g2[0] + s2[0], y1 = acc[ai][bj][m][1] * rstd * g2[1] + s2[1];
                    u32x4 w; w.x = pk2(y0[0], y0[1]); w.y = pk2(y0[2], y0[3]); w.z = pk2(y1[0], y1[1]); w.w = pk2(y1[2], y1[3]);
                    *(u32x4*)(hn + off) = w; } }
    }
};
struct EpiResFinal {
    static constexpr bool PERM = true, AFTER_DRAIN = true, MIDHOOK = false;
    const bf16_t* x1b; float* out; const float* mod; const float* fw; RmsPanel st;
    __device__ __forceinline__ void fused(f32x4 (&acc)[2][2][4][2], const pg8::Unit& u, int wr, int wc, int fr, int fq, LAS unsigned char* lds, int wid, int lane) const {
        const int col0 = u.pn * 256 + wc * 32 + 8 * fq, b = (u.pm * 256) >> 12; const float* mb = mod + (size_t)b * 6144;
        { LAS float* P = (LAS float*)lds;
          f32x4 gg[2][2];
#pragma unroll
          for (int bj = 0; bj < 2; ++bj) { gg[bj][0] = *(const f32x4*)(mb + 5120 + col0 + bj * 128); gg[bj][1] = *(const f32x4*)(mb + 5120 + col0 + bj * 128 + 4); }
          u32x4 nb[2];
          { const bf16_t* bp = x1b + (size_t)(u.pm * 256 + wr * 64 + fr) * DM + col0;
#pragma unroll
            for (int bj = 0; bj < 2; ++bj) nb[bj] = __builtin_nontemporal_load((const u32x4*)(bp + bj * 128)); }
#pragma unroll
          for (int k = 0; k < 8; ++k) { const int ai = k >> 2, m = k & 3, r = ai * 128 + wr * 64 + m * 16 + fr; float s = 0.f;
              f32x4 cb[2][2];
#pragma unroll
              for (int bj = 0; bj < 2; ++bj) { cb[bj][0] = (f32x4){lo16(nb[bj].x), hi16(nb[bj].x), lo16(nb[bj].y), hi16(nb[bj].y)}; cb[bj][1] = (f32x4){lo16(nb[bj].z), hi16(nb[bj].z), lo16(nb[bj].w), hi16(nb[bj].w)}; }
              if (k < 7) { const int k2 = k + 1; const bf16_t* bp = x1b + (size_t)(u.pm * 256 + (k2 >> 2) * 128 + wr * 64 + (k2 & 3) * 16 + fr) * DM + col0;
#pragma unroll
                  for (int bj = 0; bj < 2; ++bj) nb[bj] = __builtin_nontemporal_load((const u32x4*)(bp + bj * 128)); }
#pragma unroll
              for (int bj = 0; bj < 2; ++bj) { const f32x4 x0 = cb[bj][0] + gg[bj][0] * acc[ai][bj][m][0], x1 = cb[bj][1] + gg[bj][1] * acc[ai][bj][m][1];
                  acc[ai][bj][m][0] = x0; acc[ai][bj][m][1] = x1;
                  s += ((x0[0] * x0[0] + x0[1] * x0[1]) + (x0[2] * x0[2] + x0[3] * x0[3])) + ((x1[0] * x1[0] + x1[1] * x1[1]) + (x1[2] * x1[2] + x1[3] * x1[3])); }
              s += __shfl_xor(s, 16); s += __shfl_xor(s, 32);
              if (fq == 0) P[r * 4 + wc] = s;
              asm volatile("" ::: "memory"); } }
        st.run(u, lds, wid, lane);
        const LAS float* S = (const LAS float*)(lds + 4096);
#pragma unroll
        for (int bj = 0; bj < 2; ++bj) { const int col = col0 + bj * 128; const f32x4 w0 = *(const f32x4*)(fw + col), w1 = *(const f32x4*)(fw + col + 4);
#pragma unroll
            for (int ai = 0; ai < 2; ++ai)
#pragma unroll
                for (int m = 0; m < 4; ++m) { const int r = ai * 128 + wr * 64 + m * 16 + fr; const float rstd = S[r]; const size_t off = (size_t)(u.pm * 256 + r) * DM + col;
                    __builtin_nontemporal_store(acc[ai][bj][m][0] * rstd * w0, (f32x4*)(out + off)); __builtin_nontemporal_store(acc[ai][bj][m][1] * rstd * w1, (f32x4*)(out + off + 4)); } }
    }
};

__device__ __forceinline__ void transpose_item(const float* W, int ldw, int col0, int K, bf16_t* WT, int drow0, int k0, int n0, LAS float* scr, int lane, int perm = 0, int d0 = 0) {
#pragma unroll 8
    for (int i = 0; i < 32; ++i) { const int kk = 2 * i + (lane >> 5); scr[kk * 33 + (lane & 31)] = __builtin_nontemporal_load(&W[(size_t)(k0 + kk) * ldw + col0 + n0 + (lane & 31)]); }
    asm volatile("s_waitcnt lgkmcnt(0)" ::: "memory");
    const int c = lane & 7;
#pragma unroll
    for (int j = 0; j < 4; ++j) { const int n = (lane >> 3) + 8 * j; const LAS float* s = scr + (8 * c) * 33 + n;
        u32x4 o; o.x = pk2(s[0 * 33], s[1 * 33]); o.y = pk2(s[2 * 33], s[3 * 33]); o.z = pk2(s[4 * 33], s[5 * 33]); o.w = pk2(s[6 * 33], s[7 * 33]);
        const int drow = perm ? (drow0 + 8 * (n >> 2) + (n & 3) + (d0 ? 4 : 0)) : (drow0 + n);
        *(u32x4*)(WT + (size_t)drow * K + k0 + 8 * c) = o; }
    asm volatile("s_waitcnt lgkmcnt(0)" ::: "memory");
}

__device__ __forceinline__ void phase0_transposes(const Ctx& X, KArgs a, int it0, int it1, int gw, int ngw) {
    unsigned char* ws = a->ws;
    LAS float* scr = (LAS float*)(X.lds + X.wave * 16384);
    constexpr int I1 = 16 * 96, I2 = 16 * 72, I3 = 16 * 64, I4 = 16 * 32, I5 = 4 * 32, I6 = 16 * 32, I7 = 16 * 176, I8 = 44 * 32;
    constexpr int NITEMS = I1 + I2 + I3 + I4 + I5 + I6 + I7 + I8;
    for (int it = it0 + gw; it < (it1 < 0 ? NITEMS : it1); it += ngw) {
        int r = it;
        if (r < I1) { const int nb = r % 96, kb = r / 96; transpose_item(a->w_in, DIN, 0, DM, (bf16_t*)(ws + WS_WMAIN), nb * 32, kb * 64, nb * 32, scr, X.lane); continue; } r -= I1;
        if (r < I2) { const int nb = r % 72, kb = r / 72; const bool rot = nb < 48;
            transpose_item(a->w_in, DIN, 3088, DM, (bf16_t*)(ws + WS_WMAIN), rot ? 3072 + (nb >> 1) * 64 : 3072 + nb * 32, kb * 64, nb * 32, scr, X.lane, rot ? 1 : 0, (nb & 1) * 32); continue; } r -= I2;
        if (r < I3) { const int nb = r % 64, kb = r / 64; transpose_item(a->w_in, DIN, 5392, DM, (bf16_t*)(ws + WS_WMAB), nb * 32, kb * 64, nb * 32, scr, X.lane); continue; } r -= I3;
        if (r < I4) { const int nb = r % 32, kb = r / 32; transpose_item(a->w_gla, DM, 0, 1280, (bf16_t*)(ws + WS_WG) + 256, nb * 32, kb * 64, nb * 32, scr, X.lane); continue; } r -= I4;
        if (r < I5) { const int nb = r % 32, kb = r / 32; transpose_item(a->w_attn, DM, 0, 1280, (bf16_t*)(ws + WS_WG), nb * 32, kb * 64, nb * 32, scr, X.lane); continue; } r -= I5;
        if (r < I6) { const int nb = r % 32, kb = r / 32; transpose_item(a->w_out, DM, 0, DM, (bf16_t*)(ws + WS_WOUT), nb * 32, kb * 64, nb * 32, scr, X.lane); continue; } r -= I6;
        if (r < I7) { const int nb = r % 176, kb = r / 176; const int n0 = nb * 32; const int ch = n0 % DFF; const int drow = (ch / 128) * 256 + (n0 >= DFF ? 128 : 0) + (ch % 128);
            transpose_item(a->w_up, NUP, 0, DM, (bf16_t*)(ws + WS_WUP), drow, kb * 64, n0, scr, X.lane); continue; } r -= I7;
        { const int nb = r % 32, kb = r / 32; transpose_item(a->w_down, DM, 0, DFF, (bf16_t*)(ws + WS_WDOWN), nb * 32, kb * 64, nb * 32, scr, X.lane); }
    }
}

__device__ __forceinline__ void phase0(const Ctx& X, KArgs a) {
    unsigned char* ws = a->ws;
    { bf16_t* wlr = (bf16_t*)(ws + WS_WLR);
      for (int idx = X.gtid; idx < 16 * DM; idx += X.nthr) { const int j = idx >> 10, k = idx & 1023; wlr[idx] = (bf16_t)f2bf(a->w_in[(size_t)k * DIN + 3072 + j]); } }
    { float* modp = (float*)(ws + WS_MODP);
      for (int u = X.gw; u < 96 * 32; u += X.ngw) { const int cgp = u % 96, kc = u / 96, j = cgp * 64 + X.lane;
          float w[32];
#pragma unroll
          for (int kk = 0; kk < 32; ++kk) w[kk] = __builtin_nontemporal_load(&a->ada_w[(size_t)(kc * 32 + kk) * 6144 + j]);
          const float cA = a->c[(X.lane >> 5) * DM + kc * 32 + (X.lane & 31)], cB = a->c[((X.lane >> 5) + 2) * DM + kc * 32 + (X.lane & 31)];
          const int sA = __float_as_int(cA / (1.0f + __expf(-cA))), sB = __float_as_int(cB / (1.0f + __expf(-cB)));
          float acc[4] = {0.f, 0.f, 0.f, 0.f};
#pragma unroll
          for (int kk = 0; kk < 32; ++kk) {
              acc[0] += __int_as_float(__builtin_amdgcn_readlane(sA, kk)) * w[kk]; acc[1] += __int_as_float(__builtin_amdgcn_readlane(sA, 32 + kk)) * w[kk];
              acc[2] += __int_as_float(__builtin_amdgcn_readlane(sB, kk)) * w[kk]; acc[3] += __int_as_float(__builtin_amdgcn_readlane(sB, 32 + kk)) * w[kk]; }
#pragma unroll
          for (int b = 0; b < 4; ++b) modp[(size_t)(kc * 4 + b) * 6144 + j] = acc[b]; } }
    { f32x2* rope = (f32x2*)(ws + WS_ROPE);
      for (int idx = X.gtid; idx < NT * 32; idx += X.nthr) { const int t = idx >> 5, i = idx & 31;
          const double rev = (double)a->positions[t] * INVF_REV[i]; const float fr = (float)(rev - floor(rev));
          rope[idx] = (f32x2){__builtin_amdgcn_cosf(fr), __builtin_amdgcn_sinf(fr)}; } }
}

template <int MODE> __device__ __forceinline__ void norm_pass(const Ctx& X, KArgs a, const float* xin, bf16_t* hout, float* fout) {
    unsigned char* ws = a->ws;
    const float* modp = (const float*)(ws + WS_MODP); float* mod = (float*)(ws + WS_MOD);
    if (MODE == 0) { for (int idx = X.gtid; idx < 4 * 6144; idx += X.nthr) { const int b = idx / 6144, j = idx % 6144; float s = a->ada_b[j];
            float pv[32];
#pragma unroll
            for (int kc = 0; kc < 32; ++kc) pv[kc] = modp[(size_t)(kc * 4 + b) * 6144 + j];
#pragma unroll
            for (int kc = 0; kc < 32; ++kc) s += pv[kc];
            mod[idx] = s; } }
    LAS float* gs = (LAS float*)X.lds;
    LAS bf16_t* hs = (LAS bf16_t*)(X.lds + 8192);
    for (int rt = blockIdx.x; rt < NT / 64; rt += gridDim.x) {
        const int row0 = rt * 64, b = row0 >> 12;
        __syncthreads();
        for (int idx = X.tid; idx < DM; idx += 512) {
            float g, s;
            if (MODE == 0) { float sc = a->ada_b[1024 + idx], sh = a->ada_b[idx];
                float pa[32], pb[32];
#pragma unroll
                for (int kc = 0; kc < 32; ++kc) { pa[kc] = modp[(size_t)(kc * 4 + b) * 6144 + 1024 + idx]; pb[kc] = modp[(size_t)(kc * 4 + b) * 6144 + idx]; }
#pragma unroll
                for (int kc = 0; kc < 32; ++kc) { sc += pa[kc]; sh += pb[kc]; }
                g = a->norm1_w[idx] * (1.0f + sc); s = sh; }
            else if (MODE == 1) { g = a->norm2_w[idx] * (1.0f + mod[b * 6144 + 4096 + idx]); s = mod[b * 6144 + 3072 + idx]; }
            else { g = a->final_w[idx]; s = 0.f; }
            gs[idx] = g; gs[1024 + idx] = s;
        }
        __syncthreads();
#pragma unroll 1
        for (int rb = 0; rb < 8; rb += 4) {
            f32x4 v[4][4];
#pragma unroll
            for (int r = 0; r < 4; ++r) { const f32x4* xr = (const f32x4*)(xin + (size_t)(row0 + X.wave * 8 + rb + r) * DM) + X.lane;
#pragma unroll
                for (int j = 0; j < 4; ++j) v[r][j] = __builtin_nontemporal_load(xr + 64 * j); }
#pragma unroll
            for (int r = 0; r < 4; ++r) {
                const int lr = X.wave * 8 + rb + r, row = row0 + lr;
                float ss = 0.f;
#pragma unroll
                for (int j = 0; j < 4; ++j) ss += (v[r][j][0] * v[r][j][0] + v[r][j][1] * v[r][j][1]) + (v[r][j][2] * v[r][j][2] + v[r][j][3] * v[r][j][3]);
                const float rstd = 1.0f / sqrtf(wave_sum(ss) * (1.0f / DM) + EPS);
#pragma unroll
                for (int j = 0; j < 4; ++j) { const int k = 4 * X.lane + 256 * j;
                    const f32x4 g = *(const LAS f32x4*)(gs + k), sft = *(const LAS f32x4*)(gs + 1024 + k);
                    const f32x4 y = v[r][j] * rstd * g + sft;
                    if (MODE == 2) { *((f32x4*)(fout + (size_t)row * DM) + X.lane + 64 * j) = y; }
                    else { u32x2 w; w.x = pk2(y[0], y[1]); w.y = pk2(y[2], y[3]);
                        *(u32x2*)(hout + (size_t)row * DM + k) = w;
                        if (MODE == 0) *(LAS u32x2*)(hs + lr * 1032 + k) = w; } }
            }
        }
        if (MODE == 0) {
            __syncthreads();
            const bf16_t* wlr = (const bf16_t*)(ws + WS_WLR);
            const int mt = X.wave & 3, kh = X.wave >> 2, fr = X.lane & 15, fq = X.lane >> 4;
            f32x4 acc = {0.f, 0.f, 0.f, 0.f};
#pragma unroll 4
            for (int ks = 0; ks < 16; ++ks) { const int k0 = kh * 512 + ks * 32 + 8 * fq;
                const bf16x8 av = *(const LAS bf16x8*)(hs + (16 * mt + fr) * 1032 + k0);
                const bf16x8 bv = *(const bf16x8*)(wlr + fr * 1024 + k0);
                acc = __builtin_amdgcn_mfma_f32_16x16x32_bf16(av, bv, acc, 0, 0, 0); }
            LAS f32x4* red = (LAS f32x4*)X.lds;
            if (kh == 1) red[mt * 64 + X.lane] = acc;
            __syncthreads();
            if (kh == 0) { const f32x4 o = acc + red[mt * 64 + X.lane]; float* glr = (float*)(ws + WS_GLR);
#pragma unroll
                for (int e = 0; e < 4; ++e) glr[(size_t)(row0 + 16 * mt + 4 * fq + e) * 16 + fr] = o[e]; }
        }
    }
}

constexpr int QP = 72, VP = 264;
__device__ __forceinline__ void attn_mfma(const Ctx& X, KArgs a, int dry = 0) {
    bf16_t* proj = (bf16_t*)(a->ws + WS_BIG); const f32x2* rope = (const f32x2*)(a->ws + WS_ROPE); float* lse = (float*)(a->ws + WS_LSE);
    LAS bf16_t* Qs = (LAS bf16_t*)X.lds; LAS bf16_t* Ks = (LAS bf16_t*)(X.lds + 128 * QP * 2); LAS bf16_t* Vt = (LAS bf16_t*)(X.lds + 384 * QP * 2);
    const int fr = X.lane & 15, fq = X.lane >> 4, w = X.wave, i0 = 16 * w;
    for (int unit = blockIdx.x; unit < 1536; unit += gridDim.x) {
        const int b = unit / 384, rem = unit % 384, h = rem >> 5, pn = rem & 31, g = h >> 2, hg = h & 3;
        const int r = (g == 0) ? 1 : (g == 1 ? 4 : 16), nblk = 32 / r, p = pn / nblk, n = pn % nblk;
        const int tb = b * SEQ + p;
        __syncthreads();
        { const int i = X.tid >> 2, c = X.tid & 3; const int t = tb + (128 * n + i) * r; const bf16_t* src = proj + (size_t)t * NMAIN + C_AQ + h * 64 + 16 * c;
          *(LAS u32x4*)(Qs + i * QP + 16 * c) = *(const u32x4*)src; *(LAS u32x4*)(Qs + i * QP + 16 * c + 8) = *(const u32x4*)(src + 8); }
#pragma unroll
        for (int q = 0; q < 2; ++q) { const int idx = X.tid + 512 * q, j = idx >> 2, c = idx & 3; int m = 128 * (n - 1) + j; m = m < 0 ? 0 : m; const int t = tb + m * r;
            const bf16_t* src = proj + (size_t)t * NMAIN + C_AK + h * 64 + 16 * c;
            *(LAS u32x4*)(Ks + j * QP + 16 * c) = *(const u32x4*)src; *(LAS u32x4*)(Ks + j * QP + 16 * c + 8) = *(const u32x4*)(src + 8); }
#pragma unroll
        for (int q = 0; q < 4; ++q) { const int idx = X.tid + 512 * q, j = idx & 255, c = idx >> 8; int m = 128 * (n - 1) + j; m = m < 0 ? 0 : m; const int t = tb + m * r;
            const u32x4 wv = *(const u32x4*)(proj + (size_t)t * NMAIN + C_AV + h * 64 + 8 * c);
            LAS bf16_t* vp = Vt + (8 * c) * VP + j;
            vp[0 * VP] = (bf16_t)(wv.x & 0xffff); vp[1 * VP] = (bf16_t)(wv.x >> 16); vp[2 * VP] = (bf16_t)(wv.y & 0xffff); vp[3 * VP] = (bf16_t)(wv.y >> 16);
            vp[4 * VP] = (bf16_t)(wv.z & 0xffff); vp[5 * VP] = (bf16_t)(wv.z >> 16); vp[6 * VP] = (bf16_t)(wv.w & 0xffff); vp[7 * VP] = (bf16_t)(wv.w >> 16); }
        __syncthreads();
        bf16x8 bq[2];
#pragma unroll
        for (int ks = 0; ks < 2; ++ks) bq[ks] = *(const LAS bf16x8*)(Qs + (i0 + fr) * QP + 32 * ks + 8 * fq);
        f32x4 sc[9];
#pragma unroll
        for (int q = 0; q < 9; ++q) { sc[q] = (f32x4){0.f, 0.f, 0.f, 0.f};
#pragma unroll
            for (int ks = 0; ks < 2; ++ks) { const bf16x8 ak = *(const LAS bf16x8*)(Ks + (16 * (w + q) + fr) * QP + 32 * ks + 8 * fq); sc[q] = __builtin_amdgcn_mfma_f32_16x16x32_bf16(ak, bq[ks], sc[q], 0, 0, 0); } }
        const int iq = i0 + fr;
        float mx = -INFINITY;
#pragma unroll
        for (int q = 0; q < 9; ++q)
#pragma unroll
            for (int e = 0; e < 4; ++e) { const int j = 16 * (w + q) + 4 * fq + e, dist = iq + 128 - j; const bool valid = (dist >= 0) && (dist <= 128) && (n > 0 || j >= 128);
                sc[q][e] = valid ? sc[q][e] : -INFINITY; mx = fmaxf(mx, sc[q][e]); }
        mx = fmaxf(mx, __shfl_xor(mx, 16)); mx = fmaxf(mx, __shfl_xor(mx, 32));
        float l = 0.f;
#pragma unroll
        for (int q = 0; q < 9; ++q)
#pragma unroll
            for (int e = 0; e < 4; ++e) { sc[q][e] = __expf(sc[q][e] - mx); l += sc[q][e]; }
        l += __shfl_xor(l, 16); l += __shfl_xor(l, 32);
        f32x4 o[4];
#pragma unroll
        for (int dt = 0; dt < 4; ++dt) o[dt] = (f32x4){0.f, 0.f, 0.f, 0.f};
#pragma unroll
        for (int c = 0; c < 5; ++c) { const int jtA = w + 2 * c; int jtB = w + 2 * c + 1; jtB = jtB > 15 ? 15 : jtB;
            const f32x4 pa = sc[2 * c]; const f32x4 pb = (2 * c + 1 <= 8) ? sc[(2 * c + 1 <= 8) ? 2 * c + 1 : 8] : (f32x4){0.f, 0.f, 0.f, 0.f};
            u32x4 pw; pw.x = pk2(pa[0], pa[1]); pw.y = pk2(pa[2], pa[3]); pw.z = pk2(pb[0], pb[1]); pw.w = pk2(pb[2], pb[3]);
            const bf16x8 bfrag = __builtin_bit_cast(bf16x8, pw);
#pragma unroll
            for (int dt = 0; dt < 4; ++dt) { const LAS bf16_t* vr = Vt + (16 * dt + fr) * VP + 4 * fq;
                const u32x2 lo = *(const LAS u32x2*)(vr + 16 * jtA), hi = *(const LAS u32x2*)(vr + 16 * jtB); const u32x4 av = {lo.x, lo.y, hi.x, hi.y};
                o[dt] = __builtin_amdgcn_mfma_f32_16x16x32_bf16(__builtin_bit_cast(bf16x8, av), bfrag, o[dt], 0, 0, 0); } }
        const float il = 1.0f / l; const int tq = tb + (128 * n + iq) * r;
        bf16_t* op = (dry ? proj + (size_t)NT * NMAIN + (size_t)(tq & 63) * NMAIN : proj + (size_t)tq * NMAIN) + C_AQ + h * 64 + 4 * fq;
#pragma unroll
        for (int dt = 0; dt < 4; ++dt) { u32x2 wv; wv.x = pk2(o[dt][0] * il, o[dt][1] * il); wv.y = pk2(o[dt][2] * il, o[dt][3] * il); *(u32x2*)(op + 16 * dt) = wv; }
        if (fq == 0) lse[((size_t)g * NT + tq) * 4 + hg] = mx + __logf(l);
    }
}

__device__ __forceinline__ void attn_combine(const Ctx& X, KArgs a) {
    bf16_t* proj = (bf16_t*)(a->ws + WS_BIG); const float* lse = (const float*)(a->ws + WS_LSE);
    for (int base = X.gtid; base < NT * 32; base += 4 * X.nthr) {
        u32x4 o0[4], o1[4], o2[4]; float l0[4], l1[4], l2[4];
#pragma unroll
        for (int q = 0; q < 4; ++q) { const int idx = base + q * X.nthr; if (idx < NT * 32) { const int t = idx >> 5, c8 = (idx & 31) * 8, hg = c8 >> 6;
            l0[q] = lse[((size_t)0 * NT + t) * 4 + hg]; l1[q] = lse[((size_t)1 * NT + t) * 4 + hg]; l2[q] = lse[((size_t)2 * NT + t) * 4 + hg];
            const bf16_t* p = proj + (size_t)t * NMAIN + C_AQ + c8; o0[q] = *(const u32x4*)p; o1[q] = *(const u32x4*)(p + 256); o2[q] = *(const u32x4*)(p + 512); } }
#pragma unroll
        for (int q = 0; q < 4; ++q) { const int idx = base + q * X.nthr; if (idx < NT * 32) { const int t = idx >> 5, c8 = (idx & 31) * 8;
            const float mx = fmaxf(l0[q], fmaxf(l1[q], l2[q])); float w0 = __expf(l0[q] - mx), w1 = __expf(l1[q] - mx), w2 = __expf(l2[q] - mx); const float inv = 1.0f / (w0 + w1 + w2); w0 *= inv; w1 *= inv; w2 *= inv;
            float f0[8], f1[8], f2[8], o[8]; unpack8(o0[q], f0); unpack8(o1[q], f1); unpack8(o2[q], f2);
#pragma unroll
            for (int e = 0; e < 8; ++e) o[e] = w0 * f0[e] + w1 * f1[e] + w2 * f2[e];
            *(u32x4*)(proj + (size_t)t * NMAIN + C_AQ + c8) = pack8(o); } }
    }
}

constexpr int GP = 136;
__device__ __forceinline__ void gla_bcum(KArgs a, int tid, int t0, int h, LAS float* segtot, LAS float* glrs, float (&bc)[32], float& tot) {
    const int d = tid & 127, seg = __builtin_amdgcn_readfirstlane(tid >> 7), col = h * 128 + d;
    const float* glr = (const float*)(a->ws + WS_GLR);
    float w2r[16];
#pragma unroll
    for (int j = 0; j < 16; ++j) w2r[j] = a->gate_w2[j * 512 + col];
    const float bias = a->gate_b[col];
    *(LAS f32x4*)(glrs + tid * 4) = *(const f32x4*)(glr + (size_t)t0 * 16 + tid * 4);
    __syncthreads();
    float run = 0.f;
#pragma unroll
    for (int r = 0; r < 32; ++r) { const LAS f32x4* gp = (const LAS f32x4*)(glrs + (seg * 32 + r) * 16);
        float z = bias;
#pragma unroll
        for (int q = 0; q < 4; ++q) { const f32x4 g = gp[q]; z += g[0] * w2r[4 * q] + g[1] * w2r[4 * q + 1] + g[2] * w2r[4 * q + 2] + g[3] * w2r[4 * q + 3]; }
        const float la = (fminf(z, 0.f) - __logf(1.0f + __expf(-fabsf(z)))) * (1.0f / 16.0f);
        run += la; bc[r] = run; }
    segtot[seg * 128 + d] = run;
    __syncthreads();
    float off = 0.f; tot = 0.f;
#pragma unroll
    for (int s2 = 0; s2 < 4; ++s2) { const float v = segtot[s2 * 128 + d]; tot += v; if (s2 < seg) off += v; }
#pragma unroll
    for (int r = 0; r < 32; ++r) bc[r] += off;
}
__device__ __forceinline__ void gla_stage_vT(const bf16_t* proj, int tid, int t0, int h, LAS bf16_t* vT) {
#pragma unroll
    for (int q = 0; q < 8; ++q) { const int i = tid >> 2, c = (tid & 3) + 4 * q;
        const u32x4 wv = *(const u32x4*)(proj + (size_t)(t0 + i) * NMAIN + C_GV + h * 256 + 8 * c);
        LAS bf16_t* vp = vT + (8 * c) * GP + i;
        vp[0 * GP] = (bf16_t)(wv.x & 0xffff); vp[1 * GP] = (bf16_t)(wv.x >> 16); vp[2 * GP] = (bf16_t)(wv.y & 0xffff); vp[3 * GP] = (bf16_t)(wv.y >> 16);
        vp[4 * GP] = (bf16_t)(wv.z & 0xffff); vp[5 * GP] = (bf16_t)(wv.z >> 16); vp[6 * GP] = (bf16_t)(wv.w & 0xffff); vp[7 * GP] = (bf16_t)(wv.w >> 16); }
}
__device__ __forceinline__ void gla_a1(const Ctx& X, KArgs a, float* kvt, float* decb) {
    const bf16_t* proj = (const bf16_t*)(a->ws + WS_BIG);
    LAS bf16_t* kdT = (LAS bf16_t*)X.lds; LAS bf16_t* vT = (LAS bf16_t*)(X.lds + 128 * GP * 2); LAS float* segtot = (LAS float*)(X.lds + 384 * GP * 2);
    const int fr = X.lane & 15, fq = X.lane >> 4, w = X.wave;
    for (int unit = blockIdx.x; unit < 512; unit += gridDim.x) {
        const int bh = unit >> 5, n = unit & 31, b = bh >> 2, h = bh & 3, t0 = b * SEQ + n * 128;
        __syncthreads();
        float bc[32], tot; gla_bcum(a, X.tid, t0, h, segtot, (LAS float*)vT, bc, tot);
        { const int d = X.tid & 127, seg = X.tid >> 7;
#pragma unroll
          for (int r8 = 0; r8 < 4; ++r8) { float kd[8];
#pragma unroll
              for (int e = 0; e < 8; ++e) { const int r = r8 * 8 + e; kd[e] = bf2f(proj[(size_t)(t0 + seg * 32 + r) * NMAIN + C_GK + h * 128 + d]) * __expf(tot - bc[r]); }
              *(LAS u32x4*)(kdT + d * GP + seg * 32 + r8 * 8) = pack8(kd); }
          if (seg == 0) decb[unit * 128 + d] = __expf(tot); }
        gla_stage_vT(proj, X.tid, t0, h, vT);
        __syncthreads();
        f32x4 acc[8][2];
#pragma unroll
        for (int mt = 0; mt < 8; ++mt) { acc[mt][0] = (f32x4){0.f, 0.f, 0.f, 0.f}; acc[mt][1] = (f32x4){0.f, 0.f, 0.f, 0.f}; }
#pragma unroll
        for (int ks = 0; ks < 4; ++ks) {
            bf16x8 bfr[2];
#pragma unroll
            for (int nt = 0; nt < 2; ++nt) bfr[nt] = *(const LAS bf16x8*)(vT + (32 * w + 16 * nt + fr) * GP + 32 * ks + 8 * fq);
#pragma unroll
            for (int mt = 0; mt < 8; ++mt) { const bf16x8 af = *(const LAS bf16x8*)(kdT + (16 * mt + fr) * GP + 32 * ks + 8 * fq);
#pragma unroll
                for (int nt = 0; nt < 2; ++nt) acc[mt][nt] = __builtin_amdgcn_mfma_f32_16x16x32_bf16(af, bfr[nt], acc[mt][nt], 0, 0, 0); }
        }
        bf16_t* ko = (bf16_t*)kvt + (size_t)unit * 32768;
#pragma unroll
        for (int mt = 0; mt < 8; ++mt)
#pragma unroll
            for (int nt = 0; nt < 2; ++nt) { u32x2 wv; wv.x = pk2(acc[mt][nt][0], acc[mt][nt][1]); wv.y = pk2(acc[mt][nt][2], acc[mt][nt][3]);
                *(u32x2*)(ko + (32 * w + 16 * nt + fr) * 128 + 16 * mt + 4 * fq) = wv; }
    }
}
__device__ __forceinline__ void gla_a2(const Ctx& X, KArgs a, float* kvt, const float* decb, int dry = 0) {
    u32x2* kb = (u32x2*)kvt;
    for (int gid = X.gtid; gid < 131072; gid += X.nthr) {
        const int bh = gid >> 13, e4 = gid & 8191, d4 = (e4 & 31) * 4;
        f32x4 S = {0.f, 0.f, 0.f, 0.f};
#pragma unroll 1
        for (int n0 = 0; n0 < 32; n0 += 16) {
            u32x2 kv[16]; f32x4 dc[16];
#pragma unroll
            for (int j = 0; j < 16; ++j) { const int unit = bh * 32 + n0 + j; kv[j] = kb[(size_t)unit * 8192 + e4]; dc[j] = *(const f32x4*)(decb + unit * 128 + d4); }
#pragma unroll
            for (int j = 0; j < 16; ++j) { const int unit = bh * 32 + n0 + j; u32x2 wv; wv.x = pk2(S[0], S[1]); wv.y = pk2(S[2], S[3]);
                if (dry) *((u32x2*)(a->ws + WS_BIG + (size_t)NT * NMAIN * 2) + gid) = wv; else kb[(size_t)unit * 8192 + e4] = wv;
                const f32x4 kf = {lo16(kv[j].x), hi16(kv[j].x), lo16(kv[j].y), hi16(kv[j].y)}; S = dc[j] * S + kf; }
        }
    }
}
__device__ __forceinline__ void gla_a3(const Ctx& X, KArgs a, const float* kvt, int dry = 0) {
    bf16_t* proj = (bf16_t*)(a->ws + WS_BIG);
    LAS bf16_t* qgs = (LAS bf16_t*)X.lds; LAS bf16_t* kgs = (LAS bf16_t*)(X.lds + 128 * GP * 2); LAS bf16_t* vT = (LAS bf16_t*)(X.lds + 256 * GP * 2); LAS float* segtot = (LAS float*)(X.lds + 512 * GP * 2);
    const int fr = X.lane & 15, fq = X.lane >> 4, w = X.wave, i0 = 16 * w;
    for (int unit = blockIdx.x; unit < 512; unit += gridDim.x) {
        const int bh = unit >> 5, n = unit & 31, b = bh >> 2, h = bh & 3, t0 = b * SEQ + n * 128;
        __syncthreads();
        { float bc[32], tot; gla_bcum(a, X.tid, t0, h, segtot, (LAS float*)vT, bc, tot);
          const int d = X.tid & 127, seg = X.tid >> 7;
#pragma unroll
          for (int r = 0; r < 32; ++r) { const int i = seg * 32 + r; const bf16_t* row = proj + (size_t)(t0 + i) * NMAIN + h * 128 + d;
              const float qv = bf2f(row[C_GQ]), kv = bf2f(row[C_GK]);
              qgs[i * GP + d] = (bf16_t)f2bf(qv * 0.08838834764831845f * __expf(bc[r])); kgs[i * GP + d] = (bf16_t)f2bf(kv * __expf(-bc[r])); } }
        gla_stage_vT(proj, X.tid, t0, h, vT);
        __syncthreads();
        bf16x8 afr[4];
#pragma unroll
        for (int ks = 0; ks < 4; ++ks) afr[ks] = *(const LAS bf16x8*)(qgs + (i0 + fr) * GP + 32 * ks + 8 * fq);
        f32x4 acc[16];
#pragma unroll
        for (int nt = 0; nt < 16; ++nt) acc[nt] = (f32x4){0.f, 0.f, 0.f, 0.f};
        for (int jt = 0; jt <= (w | 1); ++jt) {
            f32x4 att = {0.f, 0.f, 0.f, 0.f};
            if (jt <= w) {
#pragma unroll
                for (int ks = 0; ks < 4; ++ks) { const bf16x8 bf = *(const LAS bf16x8*)(kgs + (16 * jt + fr) * GP + 32 * ks + 8 * fq); att = __builtin_amdgcn_mfma_f32_16x16x32_bf16(afr[ks], bf, att, 0, 0, 0); }
            }
#pragma unroll
            for (int e = 0; e < 4; ++e) { const int i = i0 + 4 * fq + e, j = 16 * jt + fr; qgs[i * GP + j] = (bf16_t)f2bf(j <= i ? att[e] : 0.f); }
        }
        asm volatile("s_waitcnt lgkmcnt(0)" ::: "memory");
        for (int ks = 0; ks <= (w >> 1); ++ks) { const bf16x8 af = *(const LAS bf16x8*)(qgs + (i0 + fr) * GP + 32 * ks + 8 * fq);
#pragma unroll
            for (int nt = 0; nt < 16; ++nt) { const bf16x8 bf = *(const LAS bf16x8*)(vT + (16 * nt + fr) * GP + 32 * ks + 8 * fq); acc[nt] = __builtin_amdgcn_mfma_f32_16x16x32_bf16(af, bf, acc[nt], 0, 0, 0); } }
        if (n > 0) {
            __syncthreads();
            const bf16_t* sb = (const bf16_t*)kvt + (size_t)unit * 32768;
#pragma unroll
            for (int q = 0; q < 8; ++q) { const int sidx = X.tid + 512 * q; const u32x4 wv = *(const u32x4*)(sb + (size_t)sidx * 8);
                *(LAS u32x4*)(vT + (sidx >> 4) * GP + (sidx & 15) * 8) = wv; }
            __syncthreads();
#pragma unroll
            for (int ks = 0; ks < 4; ++ks)
#pragma unroll
                for (int nt = 0; nt < 16; ++nt) { const bf16x8 bf = *(const LAS bf16x8*)(vT + (16 * nt + fr) * GP + 32 * ks + 8 * fq); acc[nt] = __builtin_amdgcn_mfma_f32_16x16x32_bf16(afr[ks], bf, acc[nt], 0, 0, 0); }
        }
        float rs[4];
#pragma unroll
        for (int e = 0; e < 4; ++e) { float s2 = 0.f;
#pragma unroll
            for (int nt = 0; nt < 16; ++nt) s2 += acc[nt][e] * acc[nt][e];
            s2 += __shfl_xor(s2, 1); s2 += __shfl_xor(s2, 2); s2 += __shfl_xor(s2, 4); s2 += __shfl_xor(s2, 8);
            rs[e] = 1.0f / sqrtf(s2 * (1.0f / 256.0f) + EPS); }
        __syncthreads();
        { LAS bf16_t* ost = (LAS bf16_t*)(X.lds + w * 8704);
#pragma unroll
          for (int nt = 0; nt < 16; ++nt) { const float nw = a->gla_norm_w[16 * nt + fr];
#pragma unroll
              for (int e = 0; e < 4; ++e) ost[(4 * fq + e) * 272 + 16 * nt + fr] = (bf16_t)f2bf(acc[nt][e] * rs[e] * nw); }
          asm volatile("s_waitcnt lgkmcnt(0)" ::: "memory");
          const int r = X.lane >> 2, cgp = X.lane & 3;
          bf16_t* orow = proj + (size_t)(t0 + i0 + r) * NMAIN + C_GR + h * 256;
          bf16_t* drow = dry ? proj + (size_t)NT * NMAIN + (size_t)((t0 + i0 + r) & 63) * NMAIN + C_GR + h * 256 : orow;
          u32x4 gv[8];
#pragma unroll
          for (int q = 0; q < 8; ++q) gv[q] = *(const u32x4*)(orow + 8 * (cgp + 4 * q));
#pragma unroll
          for (int q = 0; q < 8; ++q) { const int c = cgp + 4 * q; float v[8], gr[8]; unpack8(*(const LAS u32x4*)(ost + r * 272 + 8 * c), v); unpack8(gv[q], gr);
#pragma unroll
              for (int e = 0; e < 8; ++e) v[e] *= gr[e] * sigmoidf_(gr[e]);
              *(u32x4*)(drow + 8 * c) = pack8(v); } }
    }
}

__global__ void __launch_bounds__(512, 2) fwd_megakernel(Args a_kernarg) {
    extern __shared__ __attribute__((aligned(16))) unsigned char lds_raw[];
    cg::grid_group grid = cg::this_grid();
#define X make_ctx(lds_raw)
    { volatile LAS unsigned* st0 = (volatile LAS unsigned*)((LAS unsigned char*)lds_raw + LDS_BYTES - 64); if (threadIdx.x < 2) st0[threadIdx.x] = 0u; }
    __syncthreads();
    const XcdBarrier xbar = xcd_barrier_post((unsigned*)(kargs()->ws), (volatile LAS unsigned*)((LAS unsigned char*)lds_raw + LDS_BYTES - 64));
#define WSP(T, off) ((T*)(a->ws + (off)))

    phase0(X, kargs());
    if (gridDim.x == 0x7fffffffu) grid.sync();
    xcd_barrier(xbar);
    { KArgs a = kargs(); norm_pass<0>(X, a, a->x, WSP(bf16_t, WS_HBUF), nullptr); }
    __syncthreads();
    phase0_transposes(X, kargs(), 0, 16 * 96 + 16 * 72 + 16 * 64, X.gw, X.ngw);
    xcd_barrier(xbar);
    { KArgs a = kargs(); pg8::Gemm g{WSP(bf16_t, WS_HBUF), WSP(bf16_t, WS_WMAIN), NT, NMAIN, DM, DM, DM}; run_gemm<0>(X, g, FStoreProj{WSP(bf16_t, WS_BIG), WSP(f32x2, WS_ROPE)}); }
    { const int nfull = (gridDim.x > 64) ? 64 : 0;
      if ((int)blockIdx.x >= nfull) phase0_transposes(X, kargs(), 16 * 96 + 16 * 72 + 16 * 64, -1, ((int)blockIdx.x - nfull) * 8 + X.wave, ((int)gridDim.x - nfull) * 8); }
    xcd_barrier(xbar);
#pragma unroll 1
    for (int step = 0; step < 2; ++step) {
        if (((step ^ (int)blockIdx.x) & 1) == 0) { KArgs a = kargs(); gla_a1(X, a, a->out, WSP(float, WS_SSQ)); }
        else attn_mfma(X, kargs());
        __syncthreads();
    }
    xcd_barrier(xbar);
    { KArgs a = kargs(); gla_a2(X, a, a->out, WSP(float, WS_SSQ)); }
    xcd_barrier(xbar);
    if ((blockIdx.x & 1) == 0) { KArgs a = kargs(); pg8::Gemm g{WSP(bf16_t, WS_HBUF), WSP(bf16_t, WS_WMAB), NT, NGATE, DM, DM, DM};
        run_gemm<1>(X, g, FSigmoidSplit{(bf16_t*)a->out + (size_t)NT * DM, WSP(bf16_t, WS_BIG) + C_AK}); }
    __syncthreads();
    { KArgs a = kargs(); gla_a3(X, a, a->out); }
    attn_combine(X, kargs());
    __syncthreads();
    if ((blockIdx.x & 1) != 0) { KArgs a = kargs(); pg8::Gemm g{WSP(bf16_t, WS_HBUF), WSP(bf16_t, WS_WMAB), NT, NGATE, DM, DM, DM};
        run_gemm<1>(X, g, FSigmoidSplit{(bf16_t*)a->out + (size_t)NT * DM, WSP(bf16_t, WS_BIG) + C_AK}); }
    xcd_barrier(xbar);
    { KArgs a = kargs(); pg8::Gemm g{WSP(bf16_t, WS_BIG) + C_GR, WSP(bf16_t, WS_WG), NT, DM, 1280, NMAIN, 1280};
      pg8::StaticOrder S; S.init(NT, DM, (int)gridDim.x, (int)blockIdx.x);
      EpiMixed2 E{(const bf16_t*)a->out + (size_t)NT * DM, WSP(bf16_t, WS_BIG) + C_AK, WSP(bf16_t, WS_HBUF)};
      pg8::gemm_phase<EpiMixed2, true, false, 1>(X.lds, g, S, E); }
    xcd_barrier(xbar);
    { KArgs a = kargs(); pg8::Gemm g{WSP(bf16_t, WS_HBUF), WSP(bf16_t, WS_WOUT), NT, DM, DM, DM, DM};
      pg8::StaticOrder S; S.init(NT, DM, (int)gridDim.x, (int)blockIdx.x);
      EpiResNorm E{a->x, WSP(bf16_t, WS_BIG) + (size_t)48 * 1024 * 1024, WSP(bf16_t, WS_HBUF), WSP(float, WS_MOD), a->norm2_w, RmsPanel{WSP(float, WS_GLR), (unsigned*)(a->ws + 16384)}};
      pg8::gemm_phase<EpiResNorm, false>(X.lds, g, S, E); }
    xcd_barrier(xbar);
    { KArgs a = kargs(); pg8::Gemm g{WSP(bf16_t, WS_HBUF) - 2 * DM, WSP(bf16_t, WS_WUP), NT, NUP, DM, DM, DM};
      pg8::StaticOrder S; S.init_tiles(66, NUP / 256, (int)gridDim.x, (int)blockIdx.x);
      EpiConvGeglu E{WSP(bf16_t, WS_BIG), a->conv_w, a->conv_b};
      pg8::gemm_phase<EpiConvGeglu, true, true>(X.lds, g, S, E); }
    xcd_barrier(xbar);
    { KArgs a = kargs(); pg8::Gemm g{WSP(bf16_t, WS_BIG), WSP(bf16_t, WS_WDOWN), NT, DM, DFF, DFF, DFF};
      pg8::StaticOrder S; S.init(NT, DM, (int)gridDim.x, (int)blockIdx.x);
      EpiResFinal E{WSP(bf16_t, WS_BIG) + (size_t)48 * 1024 * 1024, a->out, WSP(float, WS_MOD), a->final_w, RmsPanel{WSP(float, WS_GLR) + 65536, (unsigned*)(a->ws + 32768)}};
      pg8::gemm_phase<EpiResFinal, false>(X.lds, g, S, E); }
#undef WSP
#undef X
}

extern "C" void kernel_launch(void* const* d_in, const int* in_sizes, int n_in, void* d_out, int out_size, void* d_ws, size_t ws_size, hipStream_t stream) {
    static int grid_blocks = 0;
    if (grid_blocks == 0) {
        if (n_in != 19 || out_size != NT * DM || ws_size < WS_END) { fprintf(stderr, "kernel_launch: unexpected sizes (n_in %d out %d ws %zu)\n", n_in, out_size, ws_size); grid_blocks = -1; return; }
        int dev = 0, cus = 0, per_cu = 0;
        hipGetDevice(&dev); hipDeviceGetAttribute(&cus, hipDeviceAttributeMultiprocessorCount, dev);
        hipFuncSetAttribute((const void*)fwd_megakernel, hipFuncAttributeMaxDynamicSharedMemorySize, LDS_BYTES);
        hipOccupancyMaxActiveBlocksPerMultiprocessor(&per_cu, (const void*)fwd_megakernel, 512, LDS_BYTES);
        if (per_cu < 1) { fprintf(stderr, "kernel_launch: occupancy query says %d blocks per CU\n", per_cu); per_cu = 1; }
        if (per_cu > 1) per_cu = 1;
        grid_blocks = cus * per_cu;
        (void)hipGetLastError();
    }
    if (grid_blocks < 0) return;
    Args a{};
    a.x = (const float*)d_in[0]; a.c = (const float*)d_in[1]; a.positions = (const int*)d_in[2]; a.ada_w = (const float*)d_in[3]; a.ada_b = (const float*)d_in[4];
    a.norm1_w = (const float*)d_in[5]; a.w_in = (const float*)d_in[6]; a.gate_w2 = (const float*)d_in[7]; a.gate_b = (const float*)d_in[8]; a.gla_norm_w = (const float*)d_in[9];
    a.w_gla = (const float*)d_in[10]; a.w_attn = (const float*)d_in[11]; a.w_out = (const float*)d_in[12]; a.norm2_w = (const float*)d_in[13]; a.w_up = (const float*)d_in[14];
    a.conv_w = (const float*)d_in[15]; a.conv_b = (const float*)d_in[16]; a.w_down = (const float*)d_in[17]; a.final_w = (const float*)d_in[18];
    a.out = (float*)d_out; a.ws = (unsigned char*)d_ws;
    (void)hipMemsetAsync(d_ws, 0, 65536, stream);
    void* args[] = {&a};
    hipError_t e = hipLaunchCooperativeKernel((const void*)fwd_megakernel, dim3(grid_blocks), dim3(512), args, LDS_BYTES, stream);
    if (e != hipSuccess) fprintf(stderr, "cooperative launch failed: %s (grid %d)\n", hipGetErrorString(e), grid_blocks);
}
```

```cpp
#include <hip/hip_runtime.h>
#include <hip/hip_cooperative_groups.h>
#include <cstdio>
#include <cstdint>
namespace cg = cooperative_groups;


#define LAS __attribute__((address_space(3)))
typedef unsigned short bf16_t;
typedef short bf16x8 __attribute__((ext_vector_type(8)));
typedef float f32x4 __attribute__((ext_vector_type(4)));
typedef float f32x2 __attribute__((ext_vector_type(2)));
typedef unsigned u32x4 __attribute__((ext_vector_type(4)));
typedef unsigned u32x2 __attribute__((ext_vector_type(2)));

constexpr int NB = 4, SEQ = 4096, DM = 1024, NT = NB * SEQ;
constexpr int DIN = 7440, NMAIN = 5376, NGATE = 2048;
constexpr int C_GQ = 0, C_GK = 512, C_GV = 1024, C_GR = 2048, C_AQ = 3072, C_AK = 3840, C_AV = 4608;
constexpr int DFF = 2816, NUP = 5632;
constexpr float EPS = 1e-6f;

constexpr size_t KiB = 1024, MiB = 1024 * 1024;
constexpr size_t WS_MOD = 256 * KiB;
constexpr size_t WS_WLR = 512 * KiB;
constexpr size_t WS_SSQ = 768 * KiB;
constexpr size_t WS_GLR = 1 * MiB;
constexpr size_t WS_LSE = 2 * MiB;
constexpr size_t WS_MODP = 3 * MiB;
constexpr size_t WS_ROPE = 6 * MiB;
constexpr size_t WS_WMAIN = 10 * MiB;
constexpr size_t WS_WMAB = WS_WMAIN + (size_t)NMAIN * DM * 2;
constexpr size_t WS_WG = WS_WMAB + (size_t)NGATE * DM * 2;
constexpr size_t WS_WA = WS_WG + (size_t)DM * DM * 2;
constexpr size_t WS_WOUT = WS_WA + (size_t)DM * 256 * 2;
constexpr size_t WS_WUP = WS_WOUT + (size_t)DM * DM * 2;
constexpr size_t WS_WDOWN = WS_WUP + (size_t)NUP * DM * 2;
constexpr size_t WS_WEND = WS_WDOWN + (size_t)DM * DFF * 2;
constexpr size_t WS_HBUF = 47 * MiB;
constexpr size_t WS_BIG = 79 * MiB;
constexpr size_t WS_END = 255 * MiB;
static_assert(WS_WEND <= WS_HBUF, "weights overflow");

constexpr int LDS_BYTES = 147456;

__device__ const double INVF_REV[32] = {
1.59154943091895346e-01, 1.19349370211248862e-01, 8.94994016088910133e-02, 6.71150830052272551e-02, 5.03292121044870353e-02, 3.77415847174197711e-02, 2.83021958306233987e-02, 2.12236527647776604e-02,
1.59154943091895339e-02, 1.19349370211248862e-02, 8.94994016088910237e-03, 6.71150830052272534e-03, 5.03292121044870370e-03, 3.77415847174197719e-03, 2.83021958306233987e-03, 2.12236527647776622e-03,
1.59154943091895356e-03, 1.19349370211248849e-03, 8.94994016088910237e-04, 6.71150830052272599e-04, 5.03292121044870326e-04, 3.77415847174197741e-04, 2.83021958306233954e-04, 2.12236527647776605e-04,
1.59154943091895351e-04, 1.19349370211248862e-04, 8.94994016088910182e-05, 6.71150830052272545e-05, 5.03292121044870354e-05, 3.77415847174197768e-05, 2.83021958306233961e-05, 2.12236527647776592e-05};

__device__ __forceinline__ float bf2f(bf16_t v) { return __uint_as_float((unsigned)v << 16); }

typedef __bf16 bf16x2_hw __attribute__((ext_vector_type(2)));
__device__ __forceinline__ unsigned f2bf(float f) { return (unsigned)__builtin_bit_cast(unsigned short, (__bf16)f); }
__device__ __forceinline__ unsigned pk2(float lo, float hi) { const f32x2 v = {lo, hi}; return __builtin_bit_cast(unsigned, __builtin_convertvector(v, bf16x2_hw)); }
__device__ __forceinline__ float lo16(unsigned w) { return __uint_as_float(w << 16); }
__device__ __forceinline__ float hi16(unsigned w) { return __uint_as_float(w & 0xffff0000u); }
__device__ __forceinline__ void unpack8(u32x4 w, float* f) { f[0] = lo16(w.x); f[1] = hi16(w.x); f[2] = lo16(w.y); f[3] = hi16(w.y); f[4] = lo16(w.z); f[5] = hi16(w.z); f[6] = lo16(w.w); f[7] = hi16(w.w); }
__device__ __forceinline__ u32x4 pack8(const float* f) { u32x4 w; w.x = pk2(f[0], f[1]); w.y = pk2(f[2], f[3]); w.z = pk2(f[4], f[5]); w.w = pk2(f[6], f[7]); return w; }
__device__ __forceinline__ float wave_sum(float v) {
#pragma unroll
    for (int o = 1; o < 64; o <<= 1) v += __shfl_xor(v, o);
    return v;
}
__device__ __forceinline__ float sigmoidf_(float x) { return __builtin_amdgcn_rcpf(1.0f + __expf(-x)); }

namespace pg8 {
constexpr int BM = 256, BK = 64, HALF = 128, HTB = HALF * BK * 2, STAGE_BYTES = 8 * HTB, NXCD = 8, WGM = 8;
__host__ __device__ __forceinline__ int lds_byte(int r, int c) { const int st = (r >> 4) * 2 + (c >> 5), rr = r & 15, cc = c & 31, ob = rr * 64 + cc * 2; return st * 1024 + (ob ^ (((ob >> 9) & 1) << 5)); }
__host__ __device__ __forceinline__ void stage_rc(int b, int& R, int& C) { const int st = b / 1024, sb = b % 1024, swz = sb ^ (((sb >> 9) & 1) << 5); R = (st >> 1) * 16 + swz / 64; C = (st & 1) * 32 + (swz % 64) / 2; }
__host__ __device__ __forceinline__ int perm32(int rho) { const int n = rho >> 4, i = rho & 15; return 8 * (i >> 2) + 4 * n + (i & 3); }

struct Unit { int pm, pn; };
struct Gemm { const bf16_t* A; const bf16_t* Bt; int M, N, K, lda, ldb; };

struct StaticOrder {
    int nM, nN, nwg, G, c;
    __host__ __device__ void init(int M, int N, int G_, int c_) { nM = M / BM; nN = N / BM; nwg = nM * nN; G = G_; c = c_; }
    __host__ __device__ void init_tiles(int nM_, int nN_, int G_, int c_) { nM = nM_; nN = nN_; nwg = nM * nN; G = G_; c = c_; }
    __host__ __device__ bool next(int i, Unit& u) const {
        const long L = (long)i * G + c; if (L >= nwg) return false;
        int wgid = (int)L; { const int q = nwg / NXCD, r = nwg % NXCD, xcd = wgid % NXCD, off = wgid / NXCD; wgid = (xcd < r ? xcd * (q + 1) : r * (q + 1) + (xcd - r) * q) + off; }
        const int nig = WGM * nN, gid = wgid / nig, fm = gid * WGM, gsz = (nM - fm) < WGM ? (nM - fm) : WGM;
        u.pm = fm + ((wgid % nig) % gsz); u.pn = (wgid % nig) / gsz; return true;
    }
};

template <class F> struct EpiRow8 {
    static constexpr bool PERM = true, AFTER_DRAIN = false, MIDHOOK = false;
    F f;
    __device__ __forceinline__ void operator()(const f32x4 (&acc)[2][2][4][2], const Unit& u, int wr, int wc, int fr, int fq) const {
        const int row0 = u.pm * BM + wr * 64 + fr, col0 = u.pn * BM + wc * 32 + 8 * fq;
#pragma unroll
        for (int ai = 0; ai < 2; ++ai)
#pragma unroll
            for (int m = 0; m < 4; ++m) {
#pragma unroll
                for (int bj = 0; bj < 2; ++bj) f(row0 + ai * HALF + m * 16, col0 + bj * HALF, acc[ai][bj][m][0], acc[ai][bj][m][1]);
                if (m == 3) asm volatile("" ::: "memory");
            }
    }
};

template <class Epi, bool ALIGN_EPI = true, bool CONVMAP = false, int AKSPLIT = 0>
__device__ __forceinline__ void gemm_phase(LAS unsigned char* lds, const Gemm g, const StaticOrder& S, const Epi& E) {
    int tid_ = threadIdx.x; asm volatile("" : "+v"(tid_));
    const int tid = tid_, wid = __builtin_amdgcn_readfirstlane(tid >> 6), lane = tid & 63, wr = wid >> 2, wc = wid & 3, fr = lane & 15, fq = lane >> 4;
    const int K = g.K, nt = K / BK;
    unsigned voffA[2], voffB[2];
#pragma unroll
    for (int i = 0; i < 2; ++i) { int R, C; stage_rc(tid * 16 + i * 8192, R, C); const int Rb = Epi::PERM ? ((R & ~31) + perm32(R & 31)) : R;
        const int Ra = CONVMAP ? (126 * (R >> 6) + 8 * (R & 15) + ((R >> 4) & 3)) : R;
        voffA[i] = (unsigned)(Ra * g.lda + C) * 2u; voffB[i] = (unsigned)(Rb * g.ldb + C) * 2u; }
    const unsigned kstep = (unsigned)(BK * 2);
    const unsigned hstepA = (unsigned)(CONVMAP ? 4 : HALF) * g.lda * 2, hstepB = (unsigned)HALF * g.ldb * 2;
    const unsigned tstepA = CONVMAP ? 252u * g.lda * 2 : 2 * hstepA, tstepB = 2 * hstepB;
    const char* const baseA = (const char*)g.A; const char* const baseB = (const char*)g.Bt;
    const unsigned ldsw = (unsigned)wid * 1024u;
    const int aoff = lds_byte(wr * 64 + fr, fq * 8), boff = lds_byte(wc * 32 + fr, fq * 8);
#define PG8_SA(b, h) (((b) * 2 + (h)) * HTB)
#define PG8_SB(b, h) ((4 + (b) * 2 + (h)) * HTB)
#define PG8_STAGE(bufoff, goff, voff) do { _Pragma("unroll") for (int _i = 0; _i < 2; ++_i) { unsigned _vo = (voff)[_i] + (goff); asm volatile("" : "+v"(_vo)); \
        __builtin_amdgcn_global_load_lds((const unsigned*)(base_##voff + _vo), (LAS unsigned*)(lds + (bufoff) + ldsw + _i * 8192), 16, 0, 0); } } while (0)
#define base_voffA baseA
#define base_voffB baseB
#define PG8_LDA(dst, b, h) do { _Pragma("unroll") for (int m = 0; m < 4; ++m) _Pragma("unroll") for (int k = 0; k < 2; ++k) dst[m][k] = *(const LAS bf16x8*)(lds + PG8_SA(b, h) + aoff + m * 2048 + k * 1024); } while (0)
#define PG8_LDB(dst, b, h) do { _Pragma("unroll") for (int n = 0; n < 2; ++n) _Pragma("unroll") for (int k = 0; k < 2; ++k) dst[n][k] = *(const LAS bf16x8*)(lds + PG8_SB(b, h) + boff + n * 2048 + k * 1024); } while (0)
#define PG8_MMA(ai, bj, At, Bt) do { __builtin_amdgcn_s_setprio(1); _Pragma("unroll") for (int m = 0; m < 4; ++m) _Pragma("unroll") for (int n = 0; n < 2; ++n) _Pragma("unroll") for (int k = 0; k < 2; ++k) \
        acc[ai][bj][m][n] = __builtin_amdgcn_mfma_f32_16x16x32_bf16(Bt[n][k], At[m][k], acc[ai][bj][m][n], 0, 0, 0); __builtin_amdgcn_s_setprio(0); } while (0)
#define PG8_KOFFA(x) ((unsigned)(x) * kstep + (AKSPLIT ? ((x) < 4 ? 2048u : 0xFFFFFE00u) : 0u))
#define PG8_WAIT_V(n) asm volatile("s_waitcnt vmcnt(" #n ")" ::: "memory")
#define PG8_WAIT_L(n) asm volatile("s_waitcnt lgkmcnt(" #n ")" ::: "memory")
#define PG8_BAR __builtin_amdgcn_s_barrier()
#define PG8_SCHED __builtin_amdgcn_sched_barrier(0)
    Unit cur, nxt; int ui = 0;
    if (!S.next(0, cur)) return;
    f32x4 acc[2][2][4][2];
#pragma unroll
    for (int a = 0; a < 2; ++a)
#pragma unroll
        for (int b = 0; b < 2; ++b)
#pragma unroll
            for (int m = 0; m < 4; ++m)
#pragma unroll
                for (int n = 0; n < 2; ++n) acc[a][b][m][n] = (f32x4){0.f, 0.f, 0.f, 0.f};
    bf16x8 At[4][2], B0[2][2], B1[2][2];
    unsigned cA = (unsigned)cur.pm * tstepA, cB = (unsigned)cur.pn * tstepB;
    PG8_STAGE(PG8_SB(0, 0), cB, voffB); PG8_STAGE(PG8_SB(0, 1), cB + hstepB, voffB); PG8_STAGE(PG8_SA(0, 0), cA + PG8_KOFFA(0), voffA); PG8_STAGE(PG8_SA(0, 1), cA + hstepA + PG8_KOFFA(0), voffA);
    if (wr == 1) PG8_BAR;
    PG8_WAIT_V(2); PG8_BAR;
    PG8_STAGE(PG8_SB(1, 0), cB + kstep, voffB); PG8_STAGE(PG8_SA(1, 0), cA + PG8_KOFFA(1), voffA); PG8_STAGE(PG8_SB(1, 1), cB + hstepB + kstep, voffB);
    PG8_WAIT_V(6); PG8_BAR;
    for (;;) {
        const bool has_next = S.next(ui + 1, nxt);
        const unsigned nA = has_next ? (unsigned)nxt.pm * tstepA : cA, nB = has_next ? (unsigned)nxt.pn * tstepB : cB;
#define PG8_ITER(t) do { \
            const bool last = (t == nt - 2); \
            const unsigned a1 = cA + PG8_KOFFA(t + 1); \
            const unsigned a2 = last ? nA + PG8_KOFFA(0) : cA + PG8_KOFFA(t + 2), b2 = last ? nB : cB + (unsigned)(t + 2) * kstep; \
            const unsigned a3 = a2 + kstep, b3 = b2 + kstep; \
            PG8_LDB(B0, 0, 0); PG8_LDB(B1, 0, 1); PG8_SCHED; PG8_LDA(At, 0, 0); PG8_STAGE(PG8_SA(1, 1), a1 + hstepA, voffA); \
            PG8_WAIT_V(8); PG8_WAIT_L(0); PG8_BAR; PG8_MMA(0, 0, At, B0); PG8_MMA(0, 1, At, B1); PG8_BAR; PG8_SCHED; \
            PG8_LDA(At, 0, 1); PG8_STAGE(PG8_SB(0, 0), b2, voffB); PG8_STAGE(PG8_SB(0, 1), b2 + hstepB, voffB); PG8_STAGE(PG8_SA(0, 0), a2, voffA); \
            PG8_WAIT_V(8); PG8_WAIT_L(0); PG8_BAR; PG8_MMA(1, 0, At, B0); PG8_MMA(1, 1, At, B1); PG8_BAR; PG8_SCHED; \
            PG8_LDB(B0, 1, 0); PG8_LDB(B1, 1, 1); PG8_SCHED; PG8_LDA(At, 1, 0); PG8_STAGE(PG8_SA(0, 1), a2 + hstepA, voffA); \
            PG8_WAIT_V(8); PG8_WAIT_L(0); PG8_BAR; PG8_MMA(0, 0, At, B0); PG8_MMA(0, 1, At, B1); PG8_BAR; PG8_SCHED; \
            PG8_LDA(At, 1, 1); PG8_STAGE(PG8_SB(1, 0), b3, voffB); PG8_STAGE(PG8_SB(1, 1), b3 + hstepB, voffB); PG8_STAGE(PG8_SA(1, 0), a3, voffA); \
            PG8_WAIT_V(8); PG8_WAIT_L(0); PG8_BAR; PG8_MMA(1, 0, At, B0); PG8_MMA(1, 1, At, B1); PG8_BAR; PG8_SCHED; \
        } while (0)
        if constexpr (Epi::MIDHOOK) {
            for (int t = 0; t < 4; t += 2) PG8_ITER(t);
            E.mid(acc, cur, wr, wc, fr, fq);
            for (int t = 4; t < nt; t += 2) PG8_ITER(t);
        } else {
            for (int t = 0; t < nt; t += 2) PG8_ITER(t);
        }
#undef PG8_ITER
        if constexpr (ALIGN_EPI) { if (wr == 0) PG8_BAR; }
        if constexpr (!Epi::AFTER_DRAIN) { E(acc, cur, wr, wc, fr, fq); }
        if (!has_next) break;
#pragma unroll
        for (int a = 0; a < 2; ++a)
#pragma unroll
            for (int b = 0; b < 2; ++b)
#pragma unroll
                for (int m = 0; m < 4; ++m)
#pragma unroll
                    for (int n = 0; n < 2; ++n) acc[a][b][m][n] = (f32x4){0.f, 0.f, 0.f, 0.f};
        cur = nxt; cA = nA; cB = nB; ++ui;
        if constexpr (ALIGN_EPI) { if (wr == 1) PG8_BAR; }
    }
    PG8_WAIT_V(0);
    if constexpr (!ALIGN_EPI) { if (wr == 0) PG8_BAR; }
    PG8_BAR;
    if constexpr (Epi::AFTER_DRAIN) { E.fused(acc, cur, wr, wc, fr, fq, lds, wid, lane); }
#undef PG8_SA
#undef PG8_SB
#undef PG8_STAGE
#undef base_voffA
#undef base_voffB
#undef PG8_LDA
#undef PG8_LDB
#undef PG8_MMA
#undef PG8_WAIT_V
#undef PG8_KOFFA
#undef PG8_WAIT_L
#undef PG8_BAR
#undef PG8_SCHED
}
}


#define XB_TMO      128
#define XB_XCNT(j)  (256  + 64 * (j))
#define XB_XSUB(j)  (1280 + 64 * (j))
#define XB_XGEN(j)  (2304 + 64 * (j))
#define XB_TOP      3328
#define XB_TOPGEN   3392
#define XCD_BAR_WORDS 3456
#define XB_SPIN_CAP (1u << 18)
__device__ __forceinline__ unsigned xb_ld(unsigned* p)              { return __hip_atomic_load(p, __ATOMIC_RELAXED, __HIP_MEMORY_SCOPE_AGENT); }
__device__ __forceinline__ unsigned xb_add(unsigned* p, unsigned v) { return __hip_atomic_fetch_add(p, v, __ATOMIC_RELAXED, __HIP_MEMORY_SCOPE_AGENT); }
__device__ __forceinline__ unsigned xb_xcc_id() { return (unsigned)__builtin_amdgcn_s_getreg((3 << 11) | 20) & 0xFu; }
#define XB_SPIN(cond, bar) do { unsigned _sp = 0; while (cond) { __builtin_amdgcn_s_sleep(1); \
    if ((++_sp & 255u) == 0u) { if (xb_ld(&(bar)[XB_TMO])) break; if (_sp > XB_SPIN_CAP) { atomicAdd(&(bar)[XB_TMO], 1u); break; } } } } while (0)
struct XcdBarrier { unsigned* bar; unsigned x; volatile LAS unsigned* st; };
__device__ __forceinline__ XcdBarrier xcd_barrier_post(unsigned* bar, volatile LAS unsigned* st) {
    XcdBarrier b; b.bar = bar; b.x = xb_xcc_id(); b.st = st;
    if (threadIdx.x == 0) (void)xb_add(&bar[XB_XCNT(b.x)], 1u);
    return b;
}
__device__ __forceinline__ void xcd_barrier_complete(unsigned* bar, unsigned x, unsigned& nloc, unsigned& nx) {
    const unsigned G = gridDim.x * gridDim.y * gridDim.z;
    unsigned sum, cnt, mine, sp = 0u;
    for (;;) {
        sum = 0u; cnt = 0u; mine = 0u;
#pragma unroll
        for (unsigned j = 0; j < 16; ++j) { const unsigned c = xb_ld(&bar[XB_XCNT(j)]); sum += c; cnt += (c > 0u) ? 1u : 0u; mine = (j == x) ? c : mine; }
        if (sum == G) break;
        __builtin_amdgcn_s_sleep(1);
        if ((++sp & 255u) == 0u) { if (xb_ld(&bar[XB_TMO])) break; if (sp > XB_SPIN_CAP) { atomicAdd(&bar[XB_TMO], 1u); break; } }
    }
    nloc = mine > 0u ? mine : 1u; nx = cnt > 0u ? cnt : 1u;
}
__device__ __forceinline__ void xcd_barrier(const XcdBarrier& b) {
    asm volatile("s_waitcnt vmcnt(0)" ::: "memory");
    __syncthreads();
    if (threadIdx.x == 0) {
        unsigned* bar = b.bar;
        __builtin_amdgcn_s_waitcnt(0);
        unsigned nloc = b.st[0], nx = b.st[1];
        if (nloc == 0u) { xcd_barrier_complete(bar, b.x, nloc, nx); b.st[0] = nloc; b.st[1] = nx; }
        const unsigned old = xb_add(&bar[XB_XSUB(b.x)], 1u);
        const unsigned gen = old / nloc;
        if (old + 1u == (gen + 1u) * nloc) {
            __builtin_amdgcn_fence(__ATOMIC_RELEASE, "agent");
            asm volatile("s_waitcnt vmcnt(0)" ::: "memory");
            const unsigned og = xb_add(&bar[XB_TOP], 1u);
            const unsigned tg = og / nx;
            if (og + 1u == (tg + 1u) * nx) xb_add(&bar[XB_TOPGEN], 1u);
            else XB_SPIN(xb_ld(&bar[XB_TOPGEN]) == tg, bar);
            __builtin_amdgcn_fence(__ATOMIC_ACQUIRE, "agent");
            xb_add(&bar[XB_XGEN(b.x)], 1u);
            asm volatile("s_waitcnt vmcnt(0)" ::: "memory");
        } else {
            XB_SPIN(xb_ld(&bar[XB_XGEN(b.x)]) == gen, bar);
            __builtin_amdgcn_fence(__ATOMIC_ACQUIRE, "agent");
            asm volatile("s_waitcnt vmcnt(0)" ::: "memory");
        }
    }
    __syncthreads();
}

struct Args {
    const float* x; const float* c; const int* positions; const float* ada_w; const float* ada_b; const float* norm1_w; const float* w_in;
    const float* gate_w2; const float* gate_b; const float* gla_norm_w; const float* w_gla; const float* w_attn; const float* w_out; const float* norm2_w;
    const float* w_up; const float* conv_w; const float* conv_b; const float* w_down; const float* final_w;
    float* out; unsigned char* ws;
};

typedef const __attribute__((address_space(4))) Args* KArgs;
__device__ __forceinline__ KArgs kargs() { KArgs p = (KArgs)__builtin_amdgcn_kernarg_segment_ptr(); asm volatile("" : "+s"(p)); return p; }

struct Ctx { int tid, lane, wave, gtid, nthr, gw, ngw; LAS unsigned char* lds; };

__device__ __forceinline__ Ctx make_ctx(unsigned char* lds_raw) {
    Ctx X; int t = threadIdx.x; asm volatile("" : "+v"(t)); X.tid = t; X.lane = X.tid & 63; X.wave = __builtin_amdgcn_readfirstlane(X.tid >> 6);
    X.gtid = blockIdx.x * 512 + X.tid; X.nthr = gridDim.x * 512; X.gw = blockIdx.x * 8 + X.wave; X.ngw = gridDim.x * 8; X.lds = (LAS unsigned char*)lds_raw; return X; }

template <int ID, class F> __device__ __forceinline__ void run_gemm(const Ctx& X, const pg8::Gemm g, const F& f) {
    pg8::StaticOrder S; S.init(g.M, g.N, (int)gridDim.x, (int)blockIdx.x);
    pg8::EpiRow8<F> E{f};
    pg8::gemm_phase<pg8::EpiRow8<F>, true>(X.lds, g, S, E);
}

struct FStoreProj { bf16_t* O; const f32x2* rope;
    __device__ __forceinline__ void operator()(int row, int col, f32x4 v0, f32x4 v1) const {
        if (col >= C_AQ && col < C_AV) { const int g8 = ((col - C_AQ) & 63) >> 3; const f32x4* rp = (const f32x4*)(rope + (size_t)row * 32 + 4 * g8); const f32x4 r0 = rp[0], r1 = rp[1];
            const f32x4 cs = {r0[0], r0[2], r1[0], r1[2]}, sn = {r0[1], r0[3], r1[1], r1[3]}; const float sc = col < C_AK ? 0.125f * 1.44269504088896f : 1.0f;
            const f32x4 a0 = (v0 * cs - v1 * sn) * sc, a1 = (v1 * cs + v0 * sn) * sc; v0 = a0; v1 = a1; }
        u32x4 w; w.x = pk2(v0[0], v0[1]); w.y = pk2(v0[2], v0[3]); w.z = pk2(v1[0], v1[1]); w.w = pk2(v1[2], v1[3]);
        *(u32x4*)(O + (size_t)row * NMAIN + col) = w; } };
struct FSigmoidSplit { bf16_t* GA; bf16_t* GB;
    __device__ __forceinline__ void operator()(int row, int col, f32x4 v0, f32x4 v1) const {
        u32x4 w; w.x = pk2(sigmoidf_(v0[0]), sigmoidf_(v0[1])); w.y = pk2(sigmoidf_(v0[2]), sigmoidf_(v0[3])); w.z = pk2(sigmoidf_(v1[0]), sigmoidf_(v1[1])); w.w = pk2(sigmoidf_(v1[2]), sigmoidf_(v1[3]));
        if (col < 1024) *(u32x4*)(GA + (size_t)row * DM + col) = w; else *(u32x4*)(GB + (size_t)row * NMAIN + (col - 1024)) = w; } };
__device__ __forceinline__ f32x2 gelu_pk(f32x2 v) {
    const f32x2 av = __builtin_elementwise_abs(v), d = av * 0.2316418882f + 1.0f;
    f32x2 t; t.x = __builtin_amdgcn_rcpf(d.x); t.y = __builtin_amdgcn_rcpf(d.y);
    f32x2 q = t * 0.5307027145f + (-0.7265760135f); q = q * t + 0.7107068705f; q = q * t + (-0.142248368f); q = q * t + 0.127414796f; q = q * t;
    const f32x2 s = (v * v) * (-0.72134752044f);
    f32x2 e; e.x = __builtin_amdgcn_exp2f(s.x); e.y = __builtin_amdgcn_exp2f(s.y);
    const f32x2 m = av * (q * e);
    f32x2 o; o.x = fmaxf(v.x, 0.f) - m.x; o.y = fmaxf(v.y, 0.f) - m.y; return o;
}
__device__ __forceinline__ f32x4 dpp_shr1(f32x4 x) {
    f32x4 r;
#pragma unroll
    for (int j = 0; j < 4; ++j) r[j] = __int_as_float(__builtin_amdgcn_update_dpp(0, __float_as_int(x[j]), 0x111, 0xf, 0xf, false));
    return r;
}
struct EpiConvGeglu {
    static constexpr bool PERM = true, AFTER_DRAIN = false, MIDHOOK = false;
    bf16_t* hidden; const float* conv_w; const float* conv_b;
    template <bool EDGE> __device__ __forceinline__ void body(const f32x4 (&acc)[2][2][4][2], const pg8::Unit& u, int wr, int wc, int fr, int fq) const {
        const int tw0 = 252 * u.pm - 2 + 126 * wr;
        const int chb = 128 * u.pn + 32 * wc + 8 * fq;
#pragma unroll
        for (int n = 0; n < 2; ++n) {
            const int ch = chb + 4 * n;
            const f32x4 wv0 = *(const f32x4*)(conv_w + ch), wv1 = *(const f32x4*)(conv_w + NUP + ch), wv2 = *(const f32x4*)(conv_w + 2 * NUP + ch), bv = *(const f32x4*)(conv_b + ch);
            const f32x4 wg0 = *(const f32x4*)(conv_w + DFF + ch), wg1 = *(const f32x4*)(conv_w + NUP + DFF + ch), wg2 = *(const f32x4*)(conv_w + 2 * NUP + DFF + ch), bg = *(const f32x4*)(conv_b + DFF + ch);
            const f32x4 v7 = dpp_shr1(acc[1][0][3][n]), v6 = dpp_shr1(acc[1][0][2][n]), g7 = dpp_shr1(acc[1][1][3][n]), g6 = dpp_shr1(acc[1][1][2][n]);
#pragma unroll
            for (int k = 0; k < 8; ++k) {
                const int ai = k >> 2, m = k & 3, lr = 8 * fr + k, tau = tw0 + lr, sp = tau & 4095;
                const f32x4 cv = acc[ai][0][m][n], cg = acc[ai][1][m][n];
                const f32x4 p1v = k >= 1 ? acc[(k >= 1 ? k - 1 : 0) >> 2][0][(k >= 1 ? k - 1 : 0) & 3][n] : v7;
                const f32x4 p1g = k >= 1 ? acc[(k >= 1 ? k - 1 : 0) >> 2][1][(k >= 1 ? k - 1 : 0) & 3][n] : g7;
                const f32x4 p2v = k >= 2 ? acc[(k >= 2 ? k - 2 : 0) >> 2][0][(k >= 2 ? k - 2 : 0) & 3][n] : (k == 1 ? v7 : v6);
                const f32x4 p2g = k >= 2 ? acc[(k >= 2 ? k - 2 : 0) >> 2][1][(k >= 2 ? k - 2 : 0) & 3][n] : (k == 1 ? g7 : g6);
                f32x4 val, gat;
                if (EDGE) { const float m1 = sp >= 1 ? 1.f : 0.f, m2 = sp >= 2 ? 1.f : 0.f;
                    val = bv + wv2 * cv + (wv1 * m1) * p1v + (wv0 * m2) * p2v; gat = bg + wg2 * cg + (wg1 * m1) * p1g + (wg0 * m2) * p2g; }
                else { val = bv + wv2 * cv + wv1 * p1v + wv0 * p2v; gat = bg + wg2 * cg + wg1 * p1g + wg0 * p2g; }
                const f32x2 g01 = gelu_pk((f32x2){gat[0], gat[1]}), g23 = gelu_pk((f32x2){gat[2], gat[3]});
                u32x2 w; w.x = pk2(g01.x * val[0], g01.y * val[1]); w.y = pk2(g23.x * val[2], g23.y * val[3]);
                if (lr >= 2 && tau < NT) *(u32x2*)((char*)hidden + (unsigned)(tau * DFF + ch) * 2u) = w;
            }
            asm volatile("" ::: "memory");
        }
    }
    __device__ __forceinline__ void operator()(const f32x4 (&acc)[2][2][4][2], const pg8::Unit& u, int wr, int wc, int fr, int fq) const {
        const int tw0 = 252 * u.pm - 2 + 126 * wr;
        const bool edge = (tw0 <= 1) || ((tw0 & 4095) < 2) || (((tw0 + 127) >> 12) != (tw0 >> 12));
        if (edge) body<true>(acc, u, wr, wc, fr, fq); else body<false>(acc, u, wr, wc, fr, fq);
    }
};

struct EpiMixed2 {
    static constexpr bool PERM = true, AFTER_DRAIN = false, MIDHOOK = true;
    const bf16_t* gA; const bf16_t* gB; bf16_t* O;
    __device__ __forceinline__ void mid(f32x4 (&acc)[2][2][4][2], const pg8::Unit& u, int wr, int wc, int fr, int fq) const {
        const int row0 = u.pm * 256 + wr * 64 + fr, col0 = u.pn * 256 + wc * 32 + 8 * fq;
#pragma unroll
        for (int ai = 0; ai < 2; ++ai)
#pragma unroll
            for (int m = 0; m < 4; ++m) { const int row = row0 + ai * 128 + m * 16;
#pragma unroll
                for (int bj = 0; bj < 2; ++bj) { const int col = col0 + bj * 128;
                    const u32x4 aw = *(const u32x4*)((const char*)gA + (unsigned)(row * DM + col) * 2u), bw = *(const u32x4*)((const char*)gB + (unsigned)(row * NMAIN + col) * 2u);
                    f32x4 r0, r1;
                    r0[0] = lo16(bw.x) * __builtin_amdgcn_rcpf(fmaxf(lo16(aw.x), 1e-20f)); r0[1] = hi16(bw.x) * __builtin_amdgcn_rcpf(fmaxf(hi16(aw.x), 1e-20f));
                    r0[2] = lo16(bw.y) * __builtin_amdgcn_rcpf(fmaxf(lo16(aw.y), 1e-20f)); r0[3] = hi16(bw.y) * __builtin_amdgcn_rcpf(fmaxf(hi16(aw.y), 1e-20f));
                    r1[0] = lo16(bw.z) * __builtin_amdgcn_rcpf(fmaxf(lo16(aw.z), 1e-20f)); r1[1] = hi16(bw.z) * __builtin_amdgcn_rcpf(fmaxf(hi16(aw.z), 1e-20f));
                    r1[2] = lo16(bw.w) * __builtin_amdgcn_rcpf(fmaxf(lo16(aw.w), 1e-20f)); r1[3] = hi16(bw.w) * __builtin_amdgcn_rcpf(fmaxf(hi16(aw.w), 1e-20f));
                    acc[ai][bj][m][0] *= r0; acc[ai][bj][m][1] *= r1;
                    asm volatile("" ::: "memory"); } }
    }
    __device__ __forceinline__ void operator()(const f32x4 (&acc)[2][2][4][2], const pg8::Unit& u, int wr, int wc, int fr, int fq) const {
        const int row0 = u.pm * 256 + wr * 64 + fr, col0 = u.pn * 256 + wc * 32 + 8 * fq;
#pragma unroll
        for (int ai = 0; ai < 2; ++ai) {
#pragma unroll
            for (int m = 0; m < 4; ++m) { const int row = row0 + ai * 128 + m * 16;
#pragma unroll
                for (int bj = 0; bj < 2; ++bj) { const int col = col0 + bj * 128; float a8[8]; unpack8(*(const u32x4*)(gA + (size_t)row * DM + col), a8);
                    const f32x4 v0 = acc[ai][bj][m][0], v1 = acc[ai][bj][m][1];
                    float o[8] = {v0[0] * a8[0], v0[1] * a8[1], v0[2] * a8[2], v0[3] * a8[3], v1[0] * a8[4], v1[1] * a8[5], v1[2] * a8[6], v1[3] * a8[7]};
                    *(u32x4*)(O + (size_t)row * DM + col) = pack8(o); } }
            asm volatile("" ::: "memory");
        }
    }
};

struct RmsPanel {
    float* xbuf;
    unsigned* cnt;
    __device__ __forceinline__ void run(const pg8::Unit& u, LAS unsigned char* lds, int wid, int lane) const {
        LAS float* P = (LAS float*)lds; LAS float* S = (LAS float*)(lds + 4096);
        asm volatile("s_waitcnt lgkmcnt(0)" ::: "memory"); __builtin_amdgcn_s_barrier(); asm volatile("" ::: "memory");
        const int row = wid * 32 + (lane & 31);
        if (lane < 32) { const float tot = (P[row * 4 + 0] + P[row * 4 + 1]) + (P[row * 4 + 2] + P[row * 4 + 3]);
            __hip_atomic_store(xbuf + (size_t)(u.pm * 256 + row) * 4 + u.pn, tot, __ATOMIC_RELAXED, __HIP_MEMORY_SCOPE_AGENT); }
        asm volatile("s_waitcnt vmcnt(0)" ::: "memory");
        if (lane == 0) __hip_atomic_fetch_add(cnt + 64 * u.pm, 1u, __ATOMIC_RELAXED, __HIP_MEMORY_SCOPE_AGENT);
        if (wid == 0) { unsigned sp = 0;
            for (;;) { if ((unsigned)__builtin_amdgcn_readfirstlane(__hip_atomic_load(cnt + 64 * u.pm, __ATOMIC_RELAXED, __HIP_MEMORY_SCOPE_AGENT)) >= 32u) break;
                if (++sp > (1u << 22)) break; __builtin_amdgcn_s_sleep(2); }
            __builtin_amdgcn_fence(__ATOMIC_ACQUIRE, "agent"); }
        asm volatile("s_waitcnt vmcnt(0) lgkmcnt(0)" ::: "memory"); __builtin_amdgcn_s_barrier(); asm volatile("" ::: "memory");
        if (lane < 32) { const float* slot = xbuf + (size_t)(u.pm * 256 + row) * 4; float q = 0.f;
#pragma unroll
            for (int t = 0; t < 4; ++t) q += __hip_atomic_load(slot + t, __ATOMIC_RELAXED, __HIP_MEMORY_SCOPE_AGENT);
            S[row] = 1.0f / sqrtf(q * (1.0f / 1024.0f) + EPS); }
        asm volatile("s_waitcnt lgkmcnt(0)" ::: "memory"); __builtin_amdgcn_s_barrier(); asm volatile("" ::: "memory");
    }
};
struct EpiResNorm {
    static constexpr bool PERM = true, AFTER_DRAIN = true, MIDHOOK = false;
    const float* base; bf16_t* x1b; bf16_t* hn; const float* mod; const float* nw; RmsPanel st;
    __device__ __forceinline__ void fused(f32x4 (&acc)[2][2][4][2], const pg8::Unit& u, int wr, int wc, int fr, int fq, LAS unsigned char* lds, int wid, int lane) const {
        const int col0 = u.pn * 256 + wc * 32 + 8 * fq, b = (u.pm * 256) >> 12; const float* mb = mod + (size_t)b * 6144;
        { LAS float* P = (LAS float*)lds;
          f32x4 gg[2][2];
#pragma unroll
          for (int bj = 0; bj < 2; ++bj) { gg[bj][0] = *(const f32x4*)(mb + 2048 + col0 + bj * 128); gg[bj][1] = *(const f32x4*)(mb + 2048 + col0 + bj * 128 + 4); }
          f32x4 nb[2][2];
          { const float* bp = base + (size_t)(u.pm * 256 + wr * 64 + fr) * DM + col0;
#pragma unroll
            for (int bj = 0; bj < 2; ++bj) { nb[bj][0] = __builtin_nontemporal_load((const f32x4*)(bp + bj * 128)); nb[bj][1] = __builtin_nontemporal_load((const f32x4*)(bp + bj * 128 + 4)); } }
#pragma unroll
          for (int k = 0; k < 8; ++k) { const int ai = k >> 2, m = k & 3, r = ai * 128 + wr * 64 + m * 16 + fr; float s = 0.f;
              f32x4 cb[2][2];
#pragma unroll
              for (int bj = 0; bj < 2; ++bj) { cb[bj][0] = nb[bj][0]; cb[bj][1] = nb[bj][1]; }
              if (k < 7) { const int k2 = k + 1; const float* bp = base + (size_t)(u.pm * 256 + (k2 >> 2) * 128 + wr * 64 + (k2 & 3) * 16 + fr) * DM + col0;
#pragma unroll
                  for (int bj = 0; bj < 2; ++bj) { nb[bj][0] = __builtin_nontemporal_load((const f32x4*)(bp + bj * 128)); nb[bj][1] = __builtin_nontemporal_load((const f32x4*)(bp + bj * 128 + 4)); } }
#pragma unroll
              for (int bj = 0; bj < 2; ++bj) { const f32x4 x0 = cb[bj][0] + gg[bj][0] * acc[ai][bj][m][0], x1 = cb[bj][1] + gg[bj][1] * acc[ai][bj][m][1];
                  acc[ai][bj][m][0] = x0; acc[ai][bj][m][1] = x1;
                  s += ((x0[0] * x0[0] + x0[1] * x0[1]) + (x0[2] * x0[2] + x0[3] * x0[3])) + ((x1[0] * x1[0] + x1[1] * x1[1]) + (x1[2] * x1[2] + x1[3] * x1[3])); }
              s += __shfl_xor(s, 16); s += __shfl_xor(s, 32);
              if (fq == 0) P[r * 4 + wc] = s;
              asm volatile("" ::: "memory"); } }
        st.run(u, lds, wid, lane);
        const LAS float* S = (const LAS float*)(lds + 4096);
#pragma unroll
        for (int bj = 0; bj < 2; ++bj) { const int col = col0 + bj * 128;
            f32x4 g2[2], s2[2];
#pragma unroll
            for (int n = 0; n < 2; ++n) { g2[n] = *(const f32x4*)(nw + col + 4 * n) * (*(const f32x4*)(mb + 4096 + col + 4 * n) + 1.0f); s2[n] = *(const f32x4*)(mb + 3072 + col + 4 * n); }
#pragma unroll
            for (int ai = 0; ai < 2; ++ai)
#pragma unroll
                for (int m = 0; m < 4; ++m) { const int r = ai * 128 + wr * 64 + m * 16 + fr; const float rstd = S[r]; const size_t off = (size_t)(u.pm * 256 + r) * DM + col;
                    { u32x4 xw; xw.x = pk2(acc[ai][bj][m][0][0], acc[ai][bj][m][0][1]); xw.y = pk2(acc[ai][bj][m][0][2], acc[ai][bj][m][0][3]); xw.z = pk2(acc[ai][bj][m][1][0], acc[ai][bj][m][1][1]); xw.w = pk2(acc[ai][bj][m][1][2], acc[ai][bj][m][1][3]);
                      *(u32x4*)(x1b + off) = xw; }
                    const f32x4 y0 = acc[ai][bj][m][0] * rstd * g2[0] + s2[0], y1 = acc[ai][bj][m][1] * rstd * g2[1] + s2[1];
                    u32x4 w; w.x = pk2(y0[0], y0[1]); w.y = pk2(y0[2], y0[3]); w.z = pk2(y1[0], y1[1]); w.w = pk2(y1[2], y1[3]);
                    *(u32x4*)(hn + off) = w; } }
    }
};
struct EpiResFinal {
    static constexpr bool PERM = true, AFTER_DRAIN = true, MIDHOOK = false;
    const bf16_t* x1b; float* out; const float* mod; const float* fw; RmsPanel st;
    __device__ __forceinline__ void fused(f32x4 (&acc)[2][2][4][2], const pg8::Unit& u, int wr, int wc, int fr, int fq, LAS unsigned char* lds, int wid, int lane) const {
        const int col0 = u.pn * 256 + wc * 32 + 8 * fq, b = (u.pm * 256) >> 12; const float* mb = mod + (size_t)b * 6144;
        { LAS float* P = (LAS float*)lds;
          f32x4 gg[2][2];
#pragma unroll
          for (int bj = 0; bj < 2; ++bj) { gg[bj][0] = *(const f32x4*)(mb + 5120 + col0 + bj * 128); gg[bj][1] = *(const f32x4*)(mb + 5120 + col0 + bj * 128 + 4); }
          u32x4 nb[2];
          { const bf16_t* bp = x1b + (size_t)(u.pm * 256 + wr * 64 + fr) * DM + col0;
#pragma unroll
            for (int bj = 0; bj < 2; ++bj) nb[bj] = __builtin_nontemporal_load((const u32x4*)(bp + bj * 128)); }
#pragma unroll
          for (int k = 0; k < 8; ++k) { const int ai = k >> 2, m = k & 3, r = ai * 128 + wr * 64 + m * 16 + fr; float s = 0.f;
              f32x4 cb[2][2];
#pragma unroll
              for (int bj = 0; bj < 2; ++bj) { cb[bj][0] = (f32x4){lo16(nb[bj].x), hi16(nb[bj].x), lo16(nb[bj].y), hi16(nb[bj].y)}; cb[bj][1] = (f32x4){lo16(nb[bj].z), hi16(nb[bj].z), lo16(nb[bj].w), hi16(nb[bj].w)}; }
              if (k < 7) { const int k2 = k + 1; const bf16_t* bp = x1b + (size_t)(u.pm * 256 + (k2 >> 2) * 128 + wr * 64 + (k2 & 3) * 16 + fr) * DM + col0;
#pragma unroll
                  for (int bj = 0; bj < 2; ++bj) nb[bj] = __builtin_nontemporal_load((const u32x4*)(bp + bj * 128)); }
#pragma unroll
              for (int bj = 0; bj < 2; ++bj) { const f32x4 x0 = cb[bj][0] + gg[bj][0] * acc[ai][bj][m][0], x1 = cb[bj][1] + gg[bj][1] * acc[ai][bj][m][1];
                  acc[ai][bj][m][0] = x0; acc[ai][bj][m][1] = x1;
                  s += ((x0[0] * x0[0] + x0[1] * x0[1]) + (x0[2] * x0[2] + x0[3] * x0[3])) + ((x1[0] * x1[0] + x1[1] * x1[1]) + (x1[2] * x1[2] + x1[3] * x1[3])); }
              s += __shfl_xor(s, 16); s += __shfl_xor(s, 32);
              if (fq == 0) P[r * 4 + wc] = s;
              asm volatile("" ::: "memory"); } }
        st.run(u, lds, wid, lane);
        const LAS float* S = (const LAS float*)(lds + 4096);
#pragma unroll
        for (int bj = 0; bj < 2; ++bj) { const int col = col0 + bj * 128; const f32x4 w0 = *(const f32x4*)(fw + col), w1 = *(const f32x4*)(fw + col + 4);
#pragma unroll
            for (int ai = 0; ai < 2; ++ai)
#pragma unroll
                for (int m = 0; m < 4; ++m) { const int r = ai * 128 + wr * 64 + m * 16 + fr; const float rstd = S[r]; const size_t off = (size_t)(u.pm * 256 + r) * DM + col;
                    __builtin_nontemporal_store(acc[ai][bj][m][0] * rstd * w0, (f32x4*)(out + off)); __builtin_nontemporal_store(acc[ai][bj][m][1] * rstd * w1, (f32x4*)(out + off + 4)); } }
    }
};

__device__ __forceinline__ void transpose_item(const float* W, int ldw, int col0, int K, bf16_t* WT, int drow0, int k0, int n0, LAS float* scr, int lane, int perm = 0, int d0 = 0) {
#pragma unroll 8
    for (int i = 0; i < 32; ++i) { const int kk = 2 * i + (lane >> 5); scr[kk * 33 + (lane & 31)] = __builtin_nontemporal_load(&W[(size_t)(k0 + kk) * ldw + col0 + n0 + (lane & 31)]); }
    asm volatile("s_waitcnt lgkmcnt(0)" ::: "memory");
    const int c = lane & 7;
#pragma unroll
    for (int j = 0; j < 4; ++j) { const int n = (lane >> 3) + 8 * j; const LAS float* s = scr + (8 * c) * 33 + n;
        u32x4 o; o.x = pk2(s[0 * 33], s[1 * 33]); o.y = pk2(s[2 * 33], s[3 * 33]); o.z = pk2(s[4 * 33], s[5 * 33]); o.w = pk2(s[6 * 33], s[7 * 33]);
        const int drow = perm ? (drow0 + 8 * (n >> 2) + (n & 3) + (d0 ? 4 : 0)) : (drow0 + n);
        *(u32x4*)(WT + (size_t)drow * K + k0 + 8 * c) = o; }
    asm volatile("s_waitcnt lgkmcnt(0)" ::: "memory");
}

__device__ __forceinline__ void phase0_transposes(const Ctx& X, KArgs a, int it0, int it1, int gw, int ngw) {
    unsigned char* ws = a->ws;
    LAS float* scr = (LAS float*)(X.lds + X.wave * 16384);
    constexpr int I1 = 16 * 96, I2 = 16 * 72, I3 = 16 * 64, I4 = 16 * 32, I5 = 4 * 32, I6 = 16 * 32, I7 = 16 * 176, I8 = 44 * 32;
    constexpr int NITEMS = I1 + I2 + I3 + I4 + I5 + I6 + I7 + I8;
    for (int it = it0 + gw; it < (it1 < 0 ? NITEMS : it1); it += ngw) {
        int r = it;
        if (r < I1) { const int nb = r % 96, kb = r / 96; transpose_item(a->w_in, DIN, 0, DM, (bf16_t*)(ws + WS_WMAIN), nb * 32, kb * 64, nb * 32, scr, X.lane); continue; } r -= I1;
        if (r < I2) { const int nb = r % 72, kb = r / 72; const bool rot = nb < 48;
            transpose_item(a->w_in, DIN, 3088, DM, (bf16_t*)(ws + WS_WMAIN), rot ? 3072 + (nb >> 1) * 64 : 3072 + nb * 32, kb * 64, nb * 32, scr, X.lane, rot ? 1 : 0, (nb & 1) * 32); continue; } r -= I2;
        if (r < I3) { const int nb = r % 64, kb = r / 64; transpose_item(a->w_in, DIN, 5392, DM, (bf16_t*)(ws + WS_WMAB), nb * 32, kb * 64, nb * 32, scr, X.lane); continue; } r -= I3;
        if (r < I4) { const int nb = r % 32, kb = r / 32; transpose_item(a->w_gla, DM, 0, 1280, (bf16_t*)(ws + WS_WG) + 256, nb * 32, kb * 64, nb * 32, scr, X.lane); continue; } r -= I4;
        if (r < I5) { const int nb = r % 32, kb = r / 32; transpose_item(a->w_attn, DM, 0, 1280, (bf16_t*)(ws + WS_WG), nb * 32, kb * 64, nb * 32, scr, X.lane); continue; } r -= I5;
        if (r < I6) { const int nb = r % 32, kb = r / 32; transpose_item(a->w_out, DM, 0, DM, (bf16_t*)(ws + WS_WOUT), nb * 32, kb * 64, nb * 32, scr, X.lane); continue; } r -= I6;
        if (r < I7) { const int nb = r % 176, kb = r / 176; const int n0 = nb * 32; const int ch = n0 % DFF; const int drow = (ch / 128) * 256 + (n0 >= DFF ? 128 : 0) + (ch % 128);
            transpose_item(a->w_up, NUP, 0, DM, (bf16_t*)(ws + WS_WUP), drow, kb * 64, n0, scr, X.lane); continue; } r -= I7;
        { const int nb = r % 32, kb = r / 32; transpose_item(a->w_down, DM, 0, DFF, (bf16_t*)(ws + WS_WDOWN), nb * 32, kb * 64, nb * 32, scr, X.lane); }
    }
}

__device__ __forceinline__ void phase0(const Ctx& X, KArgs a) {
    unsigned char* ws = a->ws;
    { bf16_t* wlr = (bf16_t*)(ws + WS_WLR);
      for (int idx = X.gtid; idx < 16 * DM; idx += X.nthr) { const int j = idx >> 10, k = idx & 1023; wlr[idx] = (bf16_t)f2bf(a->w_in[(size_t)k * DIN + 3072 + j]); } }
    { float* modp = (float*)(ws + WS_MODP);
      for (int u = X.gw; u < 96 * 32; u += X.ngw) { const int cgp = u % 96, kc = u / 96, j = cgp * 64 + X.lane;
          float w[32];
#pragma unroll
          for (int kk = 0; kk < 32; ++kk) w[kk] = __builtin_nontemporal_load(&a->ada_w[(size_t)(kc * 32 + kk) * 6144 + j]);
          const float cA = a->c[(X.lane >> 5) * DM + kc * 32 + (X.lane & 31)], cB = a->c[((X.lane >> 5) + 2) * DM + kc * 32 + (X.lane & 31)];
          const int sA = __float_as_int(cA / (1.0f + __expf(-cA))), sB = __float_as_int(cB / (1.0f + __expf(-cB)));
          float acc[4] = {0.f, 0.f, 0.f, 0.f};
#pragma unroll
          for (int kk = 0; kk < 32; ++kk) {
              acc[0] += __int_as_float(__builtin_amdgcn_readlane(sA, kk)) * w[kk]; acc[1] += __int_as_float(__builtin_amdgcn_readlane(sA, 32 + kk)) * w[kk];
              acc[2] += __int_as_float(__builtin_amdgcn_readlane(sB, kk)) * w[kk]; acc[3] += __int_as_float(__builtin_amdgcn_readlane(sB, 32 + kk)) * w[kk]; }
#pragma unroll
          for (int b = 0; b < 4; ++b) modp[(size_t)(kc * 4 + b) * 6144 + j] = acc[b]; } }
    { f32x2* rope = (f32x2*)(ws + WS_ROPE);
      for (int idx = X.gtid; idx < NT * 32; idx += X.nthr) { const int t = idx >> 5, i = idx & 31;
          const double rev = (double)a->positions[t] * INVF_REV[i]; const float fr = (float)(rev - floor(rev));
          rope[idx] = (f32x2){__builtin_amdgcn_cosf(fr), __builtin_amdgcn_sinf(fr)}; } }
}

template <int MODE> __device__ __forceinline__ void norm_pass(const Ctx& X, KArgs a, const float* xin, bf16_t* hout, float* fout) {
    unsigned char* ws = a->ws;
    const float* modp = (const float*)(ws + WS_MODP); float* mod = (float*)(ws + WS_MOD);
    if (MODE == 0) { for (int idx = X.gtid; idx < 4 * 6144; idx += X.nthr) { const int b = idx / 6144, j = idx % 6144; float s = a->ada_b[j];
            float pv[32];
#pragma unroll
            for (int kc = 0; kc < 32; ++kc) pv[kc] = modp[(size_t)(kc * 4 + b) * 6144 + j];
#pragma unroll
            for (int kc = 0; kc < 32; ++kc) s += pv[kc];
            mod[idx] = s; } }
    LAS float* gs = (LAS float*)X.lds;
    LAS bf16_t* hs = (LAS bf16_t*)(X.lds + 8192);
    for (int rt = blockIdx.x; rt < NT / 64; rt += gridDim.x) {
        const int row0 = rt * 64, b = row0 >> 12;
        __syncthreads();
        for (int idx = X.tid; idx < DM; idx += 512) {
            float g, s;
            if (MODE == 0) { float sc = a->ada_b[1024 + idx], sh = a->ada_b[idx];
                float pa[32], pb[32];
#pragma unroll
                for (int kc = 0; kc < 32; ++kc) { pa[kc] = modp[(size_t)(kc * 4 + b) * 6144 + 1024 + idx]; pb[kc] = modp[(size_t)(kc * 4 + b) * 6144 + idx]; }
#pragma unroll
                for (int kc = 0; kc < 32; ++kc) { sc += pa[kc]; sh += pb[kc]; }
                g = a->norm1_w[idx] * (1.0f + sc); s = sh; }
            else if (MODE == 1) { g = a->norm2_w[idx] * (1.0f + mod[b * 6144 + 4096 + idx]); s = mod[b * 6144 + 3072 + idx]; }
            else { g = a->final_w[idx]; s = 0.f; }
            gs[idx] = g; gs[1024 + idx] = s;
        }
        __syncthreads();
#pragma unroll 1
        for (int rb = 0; rb < 8; rb += 4) {
            f32x4 v[4][4];
#pragma unroll
            for (int r = 0; r < 4; ++r) { const f32x4* xr = (const f32x4*)(xin + (size_t)(row0 + X.wave * 8 + rb + r) * DM) + X.lane;
#pragma unroll
                for (int j = 0; j < 4; ++j) v[r][j] = __builtin_nontemporal_load(xr + 64 * j); }
#pragma unroll
            for (int r = 0; r < 4; ++r) {
                const int lr = X.wave * 8 + rb + r, row = row0 + lr;
                float ss = 0.f;
#pragma unroll
                for (int j = 0; j < 4; ++j) ss += (v[r][j][0] * v[r][j][0] + v[r][j][1] * v[r][j][1]) + (v[r][j][2] * v[r][j][2] + v[r][j][3] * v[r][j][3]);
                const float rstd = 1.0f / sqrtf(wave_sum(ss) * (1.0f / DM) + EPS);
#pragma unroll
                for (int j = 0; j < 4; ++j) { const int k = 4 * X.lane + 256 * j;
                    const f32x4 g = *(const LAS f32x4*)(gs + k), sft = *(const LAS f32x4*)(gs + 1024 + k);
                    const f32x4 y = v[r][j] * rstd * g + sft;
                    if (MODE == 2) { *((f32x4*)(fout + (size_t)row * DM) + X.lane + 64 * j) = y; }
                    else { u32x2 w; w.x = pk2(y[0], y[1]); w.y = pk2(y[2], y[3]);
                        *(u32x2*)(hout + (size_t)row * DM + k) = w;
                        if (MODE == 0) *(LAS u32x2*)(hs + lr * 1032 + k) = w; } }
            }
        }
        if (MODE == 0) {
            __syncthreads();
            const bf16_t* wlr = (const bf16_t*)(ws + WS_WLR);
            const int mt = X.wave & 3, kh = X.wave >> 2, fr = X.lane & 15, fq = X.lane >> 4;
            f32x4 acc = {0.f, 0.f, 0.f, 0.f};
#pragma unroll 4
            for (int ks = 0; ks < 16; ++ks) { const int k0 = kh * 512 + ks * 32 + 8 * fq;
                const bf16x8 av = *(const LAS bf16x8*)(hs + (16 * mt + fr) * 1032 + k0);
                const bf16x8 bv = *(const bf16x8*)(wlr + fr * 1024 + k0);
                acc = __builtin_amdgcn_mfma_f32_16x16x32_bf16(av, bv, acc, 0, 0, 0); }
            LAS f32x4* red = (LAS f32x4*)X.lds;
            if (kh == 1) red[mt * 64 + X.lane] = acc;
            __syncthreads();
            if (kh == 0) { const f32x4 o = acc + red[mt * 64 + X.lane]; float* glr = (float*)(ws + WS_GLR);
#pragma unroll
                for (int e = 0; e < 4; ++e) glr[(size_t)(row0 + 16 * mt + 4 * fq + e) * 16 + fr] = o[e]; }
        }
    }
}

constexpr int QP = 72, VP = 264;
__device__ __forceinline__ void attn_mfma(const Ctx& X, KArgs a, int dry = 0) {
    bf16_t* proj = (bf16_t*)(a->ws + WS_BIG); const f32x2* rope = (const f32x2*)(a->ws + WS_ROPE); float* lse = (float*)(a->ws + WS_LSE);
    LAS bf16_t* Qs = (LAS bf16_t*)X.lds; LAS bf16_t* Ks = (LAS bf16_t*)(X.lds + 128 * QP * 2); LAS bf16_t* Vt = (LAS bf16_t*)(X.lds + 384 * QP * 2);
    const int fr = X.lane & 15, fq = X.lane >> 4, w = X.wave, i0 = 16 * w;
    const int per = (1536 + (int)gridDim.x - 1) / (int)gridDim.x, u0 = (int)blockIdx.x * per, u1 = (u0 + per < 1536) ? u0 + per : 1536;
    int cur_half = 1;
    for (int unit = u0; unit < u1; ++unit) {
        const int b = unit / 384, rem = unit % 384, h = rem >> 5, pn = rem & 31, g = h >> 2, hg = h & 3;
        const int r = (g == 0) ? 1 : (g == 1 ? 4 : 16), nblk = 32 / r, p = pn / nblk, n = pn % nblk;
        const int tb = b * SEQ + p;
        const bool reuse = (unit > u0) && (n >= 1);
        if (reuse) cur_half ^= 1;
        const int prev_half = cur_half ^ 1;
        __syncthreads();
        { const int i = X.tid >> 2, c = X.tid & 3; const int t = tb + (128 * n + i) * r; const bf16_t* src = proj + (size_t)t * NMAIN + C_AQ + h * 64 + 16 * c;
          *(LAS u32x4*)(Qs + i * QP + 16 * c) = *(const u32x4*)src; *(LAS u32x4*)(Qs + i * QP + 16 * c + 8) = *(const u32x4*)(src + 8); }
        for (int blk = reuse ? 1 : 0; blk < 2; ++blk) {
            const int half = blk ? cur_half : prev_half;
            { const int j = X.tid >> 2, c = X.tid & 3; int m = 128 * (n - 1 + blk) + j; m = m < 0 ? 0 : m; const int t = tb + m * r;
              const bf16_t* src = proj + (size_t)t * NMAIN + C_AK + h * 64 + 16 * c;
              *(LAS u32x4*)(Ks + (half * 128 + j) * QP + 16 * c) = *(const u32x4*)src; *(LAS u32x4*)(Ks + (half * 128 + j) * QP + 16 * c + 8) = *(const u32x4*)(src + 8); }
#pragma unroll
            for (int q = 0; q < 2; ++q) { const int idx = X.tid + 512 * q, j = idx & 127, c = idx >> 7; int m = 128 * (n - 1 + blk) + j; m = m < 0 ? 0 : m; const int t = tb + m * r;
                const u32x4 wv = *(const u32x4*)(proj + (size_t)t * NMAIN + C_AV + h * 64 + 8 * c);
                LAS bf16_t* vp = Vt + (8 * c) * VP + half * 128 + j;
                vp[0 * VP] = (bf16_t)(wv.x & 0xffff); vp[1 * VP] = (bf16_t)(wv.x >> 16); vp[2 * VP] = (bf16_t)(wv.y & 0xffff); vp[3 * VP] = (bf16_t)(wv.y >> 16);
                vp[4 * VP] = (bf16_t)(wv.z & 0xffff); vp[5 * VP] = (bf16_t)(wv.z >> 16); vp[6 * VP] = (bf16_t)(wv.w & 0xffff); vp[7 * VP] = (bf16_t)(wv.w >> 16); }
        }
        __syncthreads();
#define KOFF(t_) ((((t_) >> 3) ? cur_half : prev_half) * 128 + 16 * ((t_) & 7))
        bf16x8 bq[2];
#pragma unroll
        for (int ks = 0; ks < 2; ++ks) bq[ks] = *(const LAS bf16x8*)(Qs + (i0 + fr) * QP + 32 * ks + 8 * fq);
        f32x4 sc[9];
#pragma unroll
        for (int q = 0; q < 9; ++q) { sc[q] = (f32x4){0.f, 0.f, 0.f, 0.f};
#pragma unroll
            for (int ks = 0; ks < 2; ++ks) { const bf16x8 ak = *(const LAS bf16x8*)(Ks + (KOFF(w + q) + fr) * QP + 32 * ks + 8 * fq); sc[q] = __builtin_amdgcn_mfma_f32_16x16x32_bf16(ak, bq[ks], sc[q], 0, 0, 0); } }
        const int iq = i0 + fr;
        float mx = -INFINITY;
#pragma unroll
        for (int q = 0; q < 9; ++q) { const bool tile_ok = (n > 0) || (w + q >= 8);
#pragma unroll
            for (int e = 0; e < 4; ++e) { bool valid = tile_ok;
                if (q == 0) valid = valid && (4 * fq + e >= fr);
                if (q == 8) valid = valid && (4 * fq + e <= fr);
                sc[q][e] = valid ? sc[q][e] : -INFINITY; mx = fmaxf(mx, sc[q][e]); } }
        mx = fmaxf(mx, __shfl_xor(mx, 16)); mx = fmaxf(mx, __shfl_xor(mx, 32));
        float l = 0.f;
#pragma unroll
        for (int q = 0; q < 9; ++q)
#pragma unroll
            for (int e = 0; e < 4; ++e) { sc[q][e] = __builtin_amdgcn_exp2f(sc[q][e] - mx); l += sc[q][e]; }
        l += __shfl_xor(l, 16); l += __shfl_xor(l, 32);
        f32x4 o[4];
#pragma unroll
        for (int dt = 0; dt < 4; ++dt) o[dt] = (f32x4){0.f, 0.f, 0.f, 0.f};
#pragma unroll
        for (int c = 0; c < 5; ++c) { const int jtA = w + 2 * c; int jtB = w + 2 * c + 1; jtB = jtB > 15 ? 15 : jtB;
            const f32x4 pa = sc[2 * c]; const f32x4 pb = (2 * c + 1 <= 8) ? sc[(2 * c + 1 <= 8) ? 2 * c + 1 : 8] : (f32x4){0.f, 0.f, 0.f, 0.f};
            u32x4 pw; pw.x = pk2(pa[0], pa[1]); pw.y = pk2(pa[2], pa[3]); pw.z = pk2(pb[0], pb[1]); pw.w = pk2(pb[2], pb[3]);
            const bf16x8 bfrag = __builtin_bit_cast(bf16x8, pw);
#pragma unroll
            for (int dt = 0; dt < 4; ++dt) { const LAS bf16_t* vr = Vt + (16 * dt + fr) * VP + 4 * fq;
                const u32x2 lo = *(const LAS u32x2*)(vr + KOFF(jtA)), hi = *(const LAS u32x2*)(vr + KOFF(jtB)); const u32x4 av = {lo.x, lo.y, hi.x, hi.y};
                o[dt] = __builtin_amdgcn_mfma_f32_16x16x32_bf16(__builtin_bit_cast(bf16x8, av), bfrag, o[dt], 0, 0, 0); } }
        const float il = 1.0f / l; const int tq = tb + (128 * n + iq) * r;
        bf16_t* op = (dry ? proj + (size_t)NT * NMAIN + (size_t)(tq & 63) * NMAIN : proj + (size_t)tq * NMAIN) + C_AQ + h * 64 + 4 * fq;
#pragma unroll
        for (int dt = 0; dt < 4; ++dt) { u32x2 wv; wv.x = pk2(o[dt][0] * il, o[dt][1] * il); wv.y = pk2(o[dt][2] * il, o[dt][3] * il); *(u32x2*)(op + 16 * dt) = wv; }
        if (fq == 0) lse[((size_t)g * NT + tq) * 4 + hg] = mx * 0.6931471805599453f + __logf(l);
    }
}
#undef KOFF

__device__ __forceinline__ void attn_combine(const Ctx& X, KArgs a) {
    bf16_t* proj = (bf16_t*)(a->ws + WS_BIG); const float* lse = (const float*)(a->ws + WS_LSE);
    for (int base = X.gtid; base < NT * 32; base += 4 * X.nthr) {
        u32x4 o0[4], o1[4], o2[4]; float l0[4], l1[4], l2[4];
#pragma unroll
        for (int q = 0; q < 4; ++q) { const int idx = base + q * X.nthr; if (idx < NT * 32) { const int t = idx >> 5, c8 = (idx & 31) * 8, hg = c8 >> 6;
            l0[q] = lse[((size_t)0 * NT + t) * 4 + hg]; l1[q] = lse[((size_t)1 * NT + t) * 4 + hg]; l2[q] = lse[((size_t)2 * NT + t) * 4 + hg];
            const bf16_t* p = proj + (size_t)t * NMAIN + C_AQ + c8; o0[q] = *(const u32x4*)p; o1[q] = *(const u32x4*)(p + 256); o2[q] = *(const u32x4*)(p + 512); } }
#pragma unroll
        for (int q = 0; q < 4; ++q) { const int idx = base + q * X.nthr; if (idx < NT * 32) { const int t = idx >> 5, c8 = (idx & 31) * 8;
            const float mx = fmaxf(l0[q], fmaxf(l1[q], l2[q])); float w0 = __expf(l0[q] - mx), w1 = __expf(l1[q] - mx), w2 = __expf(l2[q] - mx); const float inv = 1.0f / (w0 + w1 + w2); w0 *= inv; w1 *= inv; w2 *= inv;
            float f0[8], f1[8], f2[8], o[8]; unpack8(o0[q], f0); unpack8(o1[q], f1); unpack8(o2[q], f2);
#pragma unroll
            for (int e = 0; e < 8; ++e) o[e] = w0 * f0[e] + w1 * f1[e] + w2 * f2[e];
            *(u32x4*)(proj + (size_t)t * NMAIN + C_AQ + c8) = pack8(o); } }
    }
}

constexpr int GP = 136;
__device__ __forceinline__ void gla_bcum(KArgs a, int tid, int t0, int h, LAS float* segtot, LAS float* glrs, float (&bc)[32], float& tot) {
    const int d = tid & 127, seg = __builtin_amdgcn_readfirstlane(tid >> 7), col = h * 128 + d;
    const float* glr = (const float*)(a->ws + WS_GLR);
    float w2r[16];
#pragma unroll
    for (int j = 0; j < 16; ++j) w2r[j] = a->gate_w2[j * 512 + col];
    const float bias = a->gate_b[col];
    *(LAS f32x4*)(glrs + tid * 4) = *(const f32x4*)(glr + (size_t)t0 * 16 + tid * 4);
    __syncthreads();
    float run = 0.f;
#pragma unroll
    for (int r = 0; r < 32; ++r) { const LAS f32x4* gp = (const LAS f32x4*)(glrs + (seg * 32 + r) * 16);
        float z = bias;
#pragma unroll
        for (int q = 0; q < 4; ++q) { const f32x4 g = gp[q]; z += g[0] * w2r[4 * q] + g[1] * w2r[4 * q + 1] + g[2] * w2r[4 * q + 2] + g[3] * w2r[4 * q + 3]; }
        const float la = (fminf(z, 0.f) - __logf(1.0f + __expf(-fabsf(z)))) * (1.0f / 16.0f);
        run += la; bc[r] = run; }
    segtot[seg * 128 + d] = run;
    __syncthreads();
    float off = 0.f; tot = 0.f;
#pragma unroll
    for (int s2 = 0; s2 < 4; ++s2) { const float v = segtot[s2 * 128 + d]; tot += v; if (s2 < seg) off += v; }
#pragma unroll
    for (int r = 0; r < 32; ++r) bc[r] += off;
}
__device__ __forceinline__ void gla_stage_vT(const bf16_t* proj, int tid, int t0, int h, LAS bf16_t* vT) {
#pragma unroll
    for (int q = 0; q < 8; ++q) { const int i = tid >> 2, c = (tid & 3) + 4 * q;
        const u32x4 wv = *(const u32x4*)(proj + (size_t)(t0 + i) * NMAIN + C_GV + h * 256 + 8 * c);
        LAS bf16_t* vp = vT + (8 * c) * GP + i;
        vp[0 * GP] = (bf16_t)(wv.x & 0xffff); vp[1 * GP] = (bf16_t)(wv.x >> 16); vp[2 * GP] = (bf16_t)(wv.y & 0xffff); vp[3 * GP] = (bf16_t)(wv.y >> 16);
        vp[4 * GP] = (bf16_t)(wv.z & 0xffff); vp[5 * GP] = (bf16_t)(wv.z >> 16); vp[6 * GP] = (bf16_t)(wv.w & 0xffff); vp[7 * GP] = (bf16_t)(wv.w >> 16); }
}
__device__ __forceinline__ void gla_a1(const Ctx& X, KArgs a, float* kvt, float* decb) {
    const bf16_t* proj = (const bf16_t*)(a->ws + WS_BIG);
    LAS bf16_t* kdT = (LAS bf16_t*)X.lds; LAS bf16_t* vT = (LAS bf16_t*)(X.lds + 128 * GP * 2); LAS float* segtot = (LAS float*)(X.lds + 384 * GP * 2);
    const int fr = X.lane & 15, fq = X.lane >> 4, w = X.wave;
    for (int unit = blockIdx.x; unit < 512; unit += gridDim.x) {
        const int bh = unit >> 5, n = unit & 31, b = bh >> 2, h = bh & 3, t0 = b * SEQ + n * 128;
        __syncthreads();
        float bc[32], tot; gla_bcum(a, X.tid, t0, h, segtot, (LAS float*)vT, bc, tot);
        { const int d = X.tid & 127, seg = X.tid >> 7;
#pragma unroll
          for (int r8 = 0; r8 < 4; ++r8) { float kd[8];
#pragma unroll
              for (int e = 0; e < 8; ++e) { const int r = r8 * 8 + e; kd[e] = bf2f(proj[(size_t)(t0 + seg * 32 + r) * NMAIN + C_GK + h * 128 + d]) * __expf(tot - bc[r]); }
              *(LAS u32x4*)(kdT + d * GP + seg * 32 + r8 * 8) = pack8(kd); }
          if (seg == 0) decb[unit * 128 + d] = __expf(tot); }
        gla_stage_vT(proj, X.tid, t0, h, vT);
        __syncthreads();
        f32x4 acc[8][2];
#pragma unroll
        for (int mt = 0; mt < 8; ++mt) { acc[mt][0] = (f32x4){0.f, 0.f, 0.f, 0.f}; acc[mt][1] = (f32x4){0.f, 0.f, 0.f, 0.f}; }
#pragma unroll
        for (int ks = 0; ks < 4; ++ks) {
            bf16x8 bfr[2];
#pragma unroll
            for (int nt = 0; nt < 2; ++nt) bfr[nt] = *(const LAS bf16x8*)(vT + (32 * w + 16 * nt + fr) * GP + 32 * ks + 8 * fq);
#pragma unroll
            for (int mt = 0; mt < 8; ++mt) { const bf16x8 af = *(const LAS bf16x8*)(kdT + (16 * mt + fr) * GP + 32 * ks + 8 * fq);
#pragma unroll
                for (int nt = 0; nt < 2; ++nt) acc[mt][nt] = __builtin_amdgcn_mfma_f32_16x16x32_bf16(af, bfr[nt], acc[mt][nt], 0, 0, 0); }
        }
        bf16_t* ko = (bf16_t*)kvt + (size_t)unit * 32768;
#pragma unroll
        for (int mt = 0; mt < 8; ++mt)
#pragma unroll
            for (int nt = 0; nt < 2; ++nt) { u32x2 wv; wv.x = pk2(acc[mt][nt][0], acc[mt][nt][1]); wv.y = pk2(acc[mt][nt][2], acc[mt][nt][3]);
                *(u32x2*)(ko + (32 * w + 16 * nt + fr) * 128 + 16 * mt + 4 * fq) = wv; }
    }
}
__device__ __forceinline__ void gla_a2(const Ctx& X, KArgs a, float* kvt, const float* decb, int dry = 0) {
    u32x2* kb = (u32x2*)kvt;
    for (int gid = X.gtid; gid < 131072; gid += X.nthr) {
        const int bh = gid >> 13, e4 = gid & 8191, d4 = (e4 & 31) * 4;
        f32x4 S = {0.f, 0.f, 0.f, 0.f};
#pragma unroll 1
        for (int n0 = 0; n0 < 32; n0 += 16) {
            u32x2 kv[16]; f32x4 dc[16];
#pragma unroll
            for (int j = 0; j < 16; ++j) { const int unit = bh * 32 + n0 + j; kv[j] = kb[(size_t)unit * 8192 + e4]; dc[j] = *(const f32x4*)(decb + unit * 128 + d4); }
#pragma unroll
            for (int j = 0; j < 16; ++j) { const int unit = bh * 32 + n0 + j; u32x2 wv; wv.x = pk2(S[0], S[1]); wv.y = pk2(S[2], S[3]);
                if (dry) *((u32x2*)(a->ws + WS_BIG + (size_t)NT * NMAIN * 2) + gid) = wv; else kb[(size_t)unit * 8192 + e4] = wv;
                const f32x4 kf = {lo16(kv[j].x), hi16(kv[j].x), lo16(kv[j].y), hi16(kv[j].y)}; S = dc[j] * S + kf; }
        }
    }
}
__device__ __forceinline__ void gla_a3(const Ctx& X, KArgs a, const float* kvt, int dry = 0) {
    bf16_t* proj = (bf16_t*)(a->ws + WS_BIG);
    LAS bf16_t* qgs = (LAS bf16_t*)X.lds; LAS bf16_t* kgs = (LAS bf16_t*)(X.lds + 128 * GP * 2); LAS bf16_t* vT = (LAS bf16_t*)(X.lds + 256 * GP * 2); LAS float* segtot = (LAS float*)(X.lds + 512 * GP * 2);
    const int fr = X.lane & 15, fq = X.lane >> 4, w = X.wave, i0 = 16 * w;
    for (int unit = blockIdx.x; unit < 512; unit += gridDim.x) {
        const int bh = unit >> 5, n = unit & 31, b = bh >> 2, h = bh & 3, t0 = b * SEQ + n * 128;
        __syncthreads();
        { float bc[32], tot; gla_bcum(a, X.tid, t0, h, segtot, (LAS float*)vT, bc, tot);
          const int d = X.tid & 127, seg = X.tid >> 7;
#pragma unroll
          for (int r = 0; r < 32; ++r) { const int i = seg * 32 + r; const bf16_t* row = proj + (size_t)(t0 + i) * NMAIN + h * 128 + d;
              const float qv = bf2f(row[C_GQ]), kv = bf2f(row[C_GK]);
              qgs[i * GP + d] = (bf16_t)f2bf(qv * 0.08838834764831845f * __expf(bc[r])); kgs[i * GP + d] = (bf16_t)f2bf(kv * __expf(-bc[r])); } }
        gla_stage_vT(proj, X.tid, t0, h, vT);
        __syncthreads();
        bf16x8 afr[4];
#pragma unroll
        for (int ks = 0; ks < 4; ++ks) afr[ks] = *(const LAS bf16x8*)(qgs + (i0 + fr) * GP + 32 * ks + 8 * fq);
        f32x4 acc[16];
#pragma unroll
        for (int nt = 0; nt < 16; ++nt) acc[nt] = (f32x4){0.f, 0.f, 0.f, 0.f};
        for (int jt = 0; jt <= (w | 1); ++jt) {
            f32x4 att = {0.f, 0.f, 0.f, 0.f};
            if (jt <= w) {
#pragma unroll
                for (int ks = 0; ks < 4; ++ks) { const bf16x8 bf = *(const LAS bf16x8*)(kgs + (16 * jt + fr) * GP + 32 * ks + 8 * fq); att = __builtin_amdgcn_mfma_f32_16x16x32_bf16(afr[ks], bf, att, 0, 0, 0); }
            }
#pragma unroll
            for (int e = 0; e < 4; ++e) { const int i = i0 + 4 * fq + e, j = 16 * jt + fr; qgs[i * GP + j] = (bf16_t)f2bf(j <= i ? att[e] : 0.f); }
        }
        asm volatile("s_waitcnt lgkmcnt(0)" ::: "memory");
        for (int ks = 0; ks <= (w >> 1); ++ks) { const bf16x8 af = *(const LAS bf16x8*)(qgs + (i0 + fr) * GP + 32 * ks + 8 * fq);
#pragma unroll
            for (int nt = 0; nt < 16; ++nt) { const bf16x8 bf = *(const LAS bf16x8*)(vT + (16 * nt + fr) * GP + 32 * ks + 8 * fq); acc[nt] = __builtin_amdgcn_mfma_f32_16x16x32_bf16(af, bf, acc[nt], 0, 0, 0); } }
        if (n > 0) {
            __syncthreads();
            const bf16_t* sb = (const bf16_t*)kvt + (size_t)unit * 32768;
#pragma unroll
            for (int q = 0; q < 8; ++q) { const int sidx = X.tid + 512 * q; const u32x4 wv = *(const u32x4*)(sb + (size_t)sidx * 8);
                *(LAS u32x4*)(vT + (sidx >> 4) * GP + (sidx & 15) * 8) = wv; }
            __syncthreads();
#pragma unroll
            for (int ks = 0; ks < 4; ++ks)
#pragma unroll
                for (int nt = 0; nt < 16; ++nt) { const bf16x8 bf = *(const LAS bf16x8*)(vT + (16 * nt + fr) * GP + 32 * ks + 8 * fq); acc[nt] = __builtin_amdgcn_mfma_f32_16x16x32_bf16(afr[ks], bf, acc[nt], 0, 0, 0); }
        }
        float rs[4];
#pragma unroll
        for (int e = 0; e < 4; ++e) { float s2 = 0.f;
#pragma unroll
            for (int nt = 0; nt < 16; ++nt) s2 += acc[nt][e] * acc[nt][e];
            s2 += __shfl_xor(s2, 1); s2 += __shfl_xor(s2, 2); s2 += __shfl_xor(s2, 4); s2 += __shfl_xor(s2, 8);
            rs[e] = 1.0f / sqrtf(s2 * (1.0f / 256.0f) + EPS); }
        __syncthreads();
        { LAS bf16_t* ost = (LAS bf16_t*)(X.lds + w * 8704);
#pragma unroll
          for (int nt = 0; nt < 16; ++nt) { const float nw = a->gla_norm_w[16 * nt + fr];
#pragma unroll
              for (int e = 0; e < 4; ++e) ost[(4 * fq + e) * 272 + 16 * nt + fr] = (bf16_t)f2bf(acc[nt][e] * rs[e] * nw); }
          asm volatile("s_waitcnt lgkmcnt(0)" ::: "memory");
          const int r = X.lane >> 2, cgp = X.lane & 3;
          bf16_t* orow = proj + (size_t)(t0 + i0 + r) * NMAIN + C_GR + h * 256;
          bf16_t* drow = dry ? proj + (size_t)NT * NMAIN + (size_t)((t0 + i0 + r) & 63) * NMAIN + C_GR + h * 256 : orow;
          u32x4 gv[8];
#pragma unroll
          for (int q = 0; q < 8; ++q) gv[q] = *(const u32x4*)(orow + 8 * (cgp + 4 * q));
#pragma unroll
          for (int q = 0; q < 8; ++q) { const int c = cgp + 4 * q; float v[8], gr[8]; unpack8(*(const LAS u32x4*)(ost + r * 272 + 8 * c), v); unpack8(gv[q], gr);
#pragma unroll
              for (int e = 0; e < 8; ++e) v[e] *= gr[e] * sigmoidf_(gr[e]);
              *(u32x4*)(drow + 8 * c) = pack8(v); } }
    }
}

__global__ void __launch_bounds__(512, 2) fwd_megakernel(Args a_kernarg) {
    extern __shared__ __attribute__((aligned(16))) unsigned char lds_raw[];
    cg::grid_group grid = cg::this_grid();
#define X make_ctx(lds_raw)
    { volatile LAS unsigned* st0 = (volatile LAS unsigned*)((LAS unsigned char*)lds_raw + LDS_BYTES - 64); if (threadIdx.x < 2) st0[threadIdx.x] = 0u; }
    __syncthreads();
    const XcdBarrier xbar = xcd_barrier_post((unsigned*)(kargs()->ws), (volatile LAS unsigned*)((LAS unsigned char*)lds_raw + LDS_BYTES - 64));
#define WSP(T, off) ((T*)(a->ws + (off)))

    phase0(X, kargs());
    if (gridDim.x == 0x7fffffffu) grid.sync();
    xcd_barrier(xbar);
    { KArgs a = kargs(); norm_pass<0>(X, a, a->x, WSP(bf16_t, WS_HBUF), nullptr); }
    __syncthreads();
    phase0_transposes(X, kargs(), 0, 16 * 96 + 16 * 72 + 16 * 64, X.gw, X.ngw);
    xcd_barrier(xbar);
    { KArgs a = kargs(); pg8::Gemm g{WSP(bf16_t, WS_HBUF), WSP(bf16_t, WS_WMAIN), NT, NMAIN, DM, DM, DM}; run_gemm<0>(X, g, FStoreProj{WSP(bf16_t, WS_BIG), WSP(f32x2, WS_ROPE)}); }
    { const int nfull = (gridDim.x > 64) ? 64 : 0;
      if ((int)blockIdx.x >= nfull) phase0_transposes(X, kargs(), 16 * 96 + 16 * 72 + 16 * 64, -1, ((int)blockIdx.x - nfull) * 8 + X.wave, ((int)gridDim.x - nfull) * 8); }
    xcd_barrier(xbar);
#pragma unroll 1
    for (int step = 0; step < 2; ++step) {
        if (((step ^ (int)blockIdx.x) & 1) == 0) { KArgs a = kargs(); gla_a1(X, a, a->out, WSP(float, WS_SSQ)); }
        else attn_mfma(X, kargs());
        __syncthreads();
    }
    xcd_barrier(xbar);
    { KArgs a = kargs(); gla_a2(X, a, a->out, WSP(float, WS_SSQ)); }
    xcd_barrier(xbar);
    if ((blockIdx.x & 1) == 0) { KArgs a = kargs(); pg8::Gemm g{WSP(bf16_t, WS_HBUF), WSP(bf16_t, WS_WMAB), NT, NGATE, DM, DM, DM};
        run_gemm<1>(X, g, FSigmoidSplit{(bf16_t*)a->out + (size_t)NT * DM, WSP(bf16_t, WS_BIG) + C_AK}); }
    __syncthreads();
    { KArgs a = kargs(); gla_a3(X, a, a->out); }
    attn_combine(X, kargs());
    __syncthreads();
    if ((blockIdx.x & 1) != 0) { KArgs a = kargs(); pg8::Gemm g{WSP(bf16_t, WS_HBUF), WSP(bf16_t, WS_WMAB), NT, NGATE, DM, DM, DM};
        run_gemm<1>(X, g, FSigmoidSplit{(bf16_t*)a->out + (size_t)NT * DM, WSP(bf16_t, WS_BIG) + C_AK}); }
    xcd_barrier(xbar);
    { KArgs a = kargs(); pg8::Gemm g{WSP(bf16_t, WS_BIG) + C_GR, WSP(bf16_t, WS_WG), NT, DM, 1280, NMAIN, 1280};
      pg8::StaticOrder S; S.init(NT, DM, (int)gridDim.x, (int)blockIdx.x);
      EpiMixed2 E{(const bf16_t*)a->out + (size_t)NT * DM, WSP(bf16_t, WS_BIG) + C_AK, WSP(bf16_t, WS_HBUF)};
      pg8::gemm_phase<EpiMixed2, true, false, 1>(X.lds, g, S, E); }
    xcd_barrier(xbar);
    { KArgs a = kargs(); pg8::Gemm g{WSP(bf16_t, WS_HBUF), WSP(bf16_t, WS_WOUT), NT, DM, DM, DM, DM};
      pg8::StaticOrder S; S.init(NT, DM, (int)gridDim.x, (int)blockIdx.x);
      EpiResNorm E{a->x, WSP(bf16_t, WS_BIG) + (size_t)48 * 1024 * 1024, WSP(bf16_t, WS_HBUF), WSP(float, WS_MOD), a->norm2_w, RmsPanel{WSP(float, WS_GLR), (unsigned*)(a->ws + 16384)}};
      pg8::gemm_phase<EpiResNorm, false>(X.lds, g, S, E); }
    xcd_barrier(xbar);
    { KArgs a = kargs(); pg8::Gemm g{WSP(bf16_t, WS_HBUF) - 2 * DM, WSP(bf16_t, WS_WUP), NT, NUP, DM, DM, DM};
      pg8::StaticOrder S; S.init_tiles(66, NUP / 256, (int)gridDim.x, (int)blockIdx.x);
      EpiConvGeglu E{WSP(bf16_t, WS_BIG), a->conv_w, a->conv_b};
      pg8::gemm_phase<EpiConvGeglu, true, true>(X.lds, g, S, E); }
    xcd_barrier(xbar);
    { KArgs a = kargs(); pg8::Gemm g{WSP(bf16_t, WS_BIG), WSP(bf16_t, WS_WDOWN), NT, DM, DFF, DFF, DFF};
      pg8::StaticOrder S; S.init(NT, DM, (int)gridDim.x, (int)blockIdx.x);
      EpiResFinal E{WSP(bf16_t, WS_BIG) + (size_t)48 * 1024 * 1024, a->out, WSP(float, WS_MOD), a->final_w, RmsPanel{WSP(float, WS_GLR) + 65536, (unsigned*)(a->ws + 32768)}};
      pg8::gemm_phase<EpiResFinal, false>(X.lds, g, S, E); }
#undef WSP
#undef X
}

extern "C" void kernel_launch(void* const* d_in, const int* in_sizes, int n_in, void* d_out, int out_size, void* d_ws, size_t ws_size, hipStream_t stream) {
    static int grid_blocks = 0;
    if (grid_blocks == 0) {
        if (n_in != 19 || out_size != NT * DM || ws_size < WS_END) { fprintf(stderr, "kernel_launch: unexpected sizes (n_in %d out %d ws %zu)\n", n_in, out_size, ws_size); grid_blocks = -1; return; }
        int dev = 0, cus = 0, per_cu = 0;
        hipGetDevice(&dev); hipDeviceGetAttribute(&cus, hipDeviceAttributeMultiprocessorCount, dev);
        hipFuncSetAttribute((const void*)fwd_megakernel, hipFuncAttributeMaxDynamicSharedMemorySize, LDS_BYTES);
        hipOccupancyMaxActiveBlocksPerMultiprocessor(&per_cu, (const void*)fwd_megakernel, 512, LDS_BYTES);
        if (per_cu < 1) { fprintf(stderr, "kernel_launch: occupancy query says %d blocks per CU\n", per_cu); per_cu = 1; }
        if (per_cu > 1) per_cu = 1;
        grid_blocks = cus * per_cu;
        (void)hipGetLastError();
    }
    if (grid_blocks < 0) return;
    Args a{};
    a.x = (const float*)d_in[0]; a.c = (const float*)d_in[1]; a.positions = (const int*)d_in[2]; a.ada_w = (const float*)d_in[3]; a.ada_b = (const float*)d_in[4];
    a.norm1_w = (const float*)d_in[5]; a.w_in = (const float*)d_in[6]; a.gate_w2 = (const float*)d_in[7]; a.gate_b = (const float*)d_in[8]; a.gla_norm_w = (const float*)d_in[9];
    a.w_gla = (const float*)d_in[10]; a.w_attn = (const float*)d_in[11]; a.w_out = (const float*)d_in[12]; a.norm2_w = (const float*)d_in[13]; a.w_up = (const float*)d_in[14];
    a.conv_w = (const float*)d_in[15]; a.conv_b = (const float*)d_in[16]; a.w_down = (const float*)d_in[17]; a.final_w = (const float*)d_in[18];
    a.out = (float*)d_out; a.ws = (unsigned char*)d_ws;
    (void)hipMemsetAsync(d_ws, 0, 65536, stream);
    void* args[] = {&a};
    hipError_t e = hipLaunchCooperativeKernel((const void*)fwd_megakernel, dim3(grid_blocks), dim3(512), args, LDS_BYTES, stream);
    if (e != hipSuccess) fprintf(stderr, "cooperative launch failed: %s (grid %d)\n", hipGetErrorString(e), grid_blocks);
}
```

```cpp
#include <hip/hip_runtime.h>
#include <hip/hip_cooperative_groups.h>
#include <cstdio>
#include <cstdint>
namespace cg = cooperative_groups;


#define LAS __attribute__((address_space(3)))
typedef unsigned short bf16_t;
typedef short bf16x8 __attribute__((ext_vector_type(8)));
typedef float f32x4 __attribute__((ext_vector_type(4)));
typedef float f32x2 __attribute__((ext_vector_type(2)));
typedef unsigned u32x4 __attribute__((ext_vector_type(4)));
typedef unsigned u32x2 __attribute__((ext_vector_type(2)));

constexpr int NB = 4, SEQ = 4096, DM = 1024, NT = NB * SEQ;
constexpr int DIN = 7440, NMAIN = 5376, NGATE = 2048;
constexpr int C_GQ = 0, C_GK = 512, C_GV = 1024, C_GR = 2048, C_AQ = 3072, C_AK = 3840, C_AV = 4608;
constexpr int DFF = 2816, NUP = 5632;
constexpr float EPS = 1e-6f;

constexpr size_t KiB = 1024, MiB = 1024 * 1024;
constexpr size_t WS_MOD = 256 * KiB;
constexpr size_t WS_WLR = 512 * KiB;
constexpr size_t WS_SSQ = 768 * KiB;
constexpr size_t WS_GLR = 1 * MiB;
constexpr size_t WS_LSE = 2 * MiB;
constexpr size_t WS_MODP = 3 * MiB;
constexpr size_t WS_ROPE = 6 * MiB;
constexpr size_t WS_WMAIN = 10 * MiB;
constexpr size_t WS_WMAB = WS_WMAIN + (size_t)NMAIN * DM * 2;
constexpr size_t WS_WG = WS_WMAB + (size_t)NGATE * DM * 2;
constexpr size_t WS_WA = WS_WG + (size_t)DM * DM * 2;
constexpr size_t WS_WOUT = WS_WA + (size_t)DM * 256 * 2;
constexpr size_t WS_WUP = WS_WOUT + (size_t)DM * DM * 2;
constexpr size_t WS_WDOWN = WS_WUP + (size_t)NUP * DM * 2;
constexpr size_t WS_WEND = WS_WDOWN + (size_t)DM * DFF * 2;
constexpr size_t WS_HBUF = 47 * MiB;
constexpr size_t WS_BIG = 79 * MiB;
constexpr size_t WS_END = 255 * MiB;
static_assert(WS_WEND <= WS_HBUF, "weights overflow");

constexpr int LDS_BYTES = 147456;

__device__ const double INVF_REV[32] = {
1.59154943091895346e-01, 1.19349370211248862e-01, 8.94994016088910133e-02, 6.71150830052272551e-02, 5.03292121044870353e-02, 3.77415847174197711e-02, 2.83021958306233987e-02, 2.12236527647776604e-02,
1.59154943091895339e-02, 1.19349370211248862e-02, 8.94994016088910237e-03, 6.71150830052272534e-03, 5.03292121044870370e-03, 3.77415847174197719e-03, 2.83021958306233987e-03, 2.12236527647776622e-03,
1.59154943091895356e-03, 1.19349370211248849e-03, 8.94994016088910237e-04, 6.71150830052272599e-04, 5.03292121044870326e-04, 3.77415847174197741e-04, 2.83021958306233954e-04, 2.12236527647776605e-04,
1.59154943091895351e-04, 1.19349370211248862e-04, 8.94994016088910182e-05, 6.71150830052272545e-05, 5.03292121044870354e-05, 3.77415847174197768e-05, 2.83021958306233961e-05, 2.12236527647776592e-05};

__device__ __forceinline__ float bf2f(bf16_t v) { return __uint_as_float((unsigned)v << 16); }

typedef __bf16 bf16x2_hw __attribute__((ext_vector_type(2)));
__device__ __forceinline__ unsigned f2bf(float f) { return (unsigned)__builtin_bit_cast(unsigned short, (__bf16)f); }
__device__ __forceinline__ unsigned pk2(float lo, float hi) { const f32x2 v = {lo, hi}; return __builtin_bit_cast(unsigned, __builtin_convertvector(v, bf16x2_hw)); }
__device__ __forceinline__ float lo16(unsigned w) { return __uint_as_float(w << 16); }
__device__ __forceinline__ float hi16(unsigned w) { return __uint_as_float(w & 0xffff0000u); }
__device__ __forceinline__ void unpack8(u32x4 w, float* f) { f[0] = lo16(w.x); f[1] = hi16(w.x); f[2] = lo16(w.y); f[3] = hi16(w.y); f[4] = lo16(w.z); f[5] = hi16(w.z); f[6] = lo16(w.w); f[7] = hi16(w.w); }
__device__ __forceinline__ u32x4 pack8(const float* f) { u32x4 w; w.x = pk2(f[0], f[1]); w.y = pk2(f[2], f[3]); w.z = pk2(f[4], f[5]); w.w = pk2(f[6], f[7]); return w; }
__device__ __forceinline__ float wave_sum(float v) {
#pragma unroll
    for (int o = 1; o < 64; o <<= 1) v += __shfl_xor(v, o);
    return v;
}
__device__ __forceinline__ float sigmoidf_(float x) { return __builtin_amdgcn_rcpf(1.0f + __expf(-x)); }

namespace pg8 {
constexpr int BM = 256, BK = 64, HALF = 128, HTB = HALF * BK * 2, STAGE_BYTES = 8 * HTB, NXCD = 8, WGM = 8;
__host__ __device__ __forceinline__ int lds_byte(int r, int c) { const int st = (r >> 4) * 2 + (c >> 5), rr = r & 15, cc = c & 31, ob = rr * 64 + cc * 2; return st * 1024 + (ob ^ (((ob >> 9) & 1) << 5)); }
__host__ __device__ __forceinline__ void stage_rc(int b, int& R, int& C) { const int st = b / 1024, sb = b % 1024, swz = sb ^ (((sb >> 9) & 1) << 5); R = (st >> 1) * 16 + swz / 64; C = (st & 1) * 32 + (swz % 64) / 2; }
__host__ __device__ __forceinline__ int perm32(int rho) { const int n = rho >> 4, i = rho & 15; return 8 * (i >> 2) + 4 * n + (i & 3); }

struct Unit { int pm, pn; };
struct Gemm { const bf16_t* A; const bf16_t* Bt; int M, N, K, lda, ldb; };

struct StaticOrder {
    int nM, nN, nwg, G, c;
    __host__ __device__ void init(int M, int N, int G_, int c_) { nM = M / BM; nN = N / BM; nwg = nM * nN; G = G_; c = c_; }
    __host__ __device__ void init_tiles(int nM_, int nN_, int G_, int c_) { nM = nM_; nN = nN_; nwg = nM * nN; G = G_; c = c_; }
    __host__ __device__ bool next(int i, Unit& u) const {
        const long L = (long)i * G + c; if (L >= nwg) return false;
        int wgid = (int)L; { const int q = nwg / NXCD, r = nwg % NXCD, xcd = wgid % NXCD, off = wgid / NXCD; wgid = (xcd < r ? xcd * (q + 1) : r * (q + 1) + (xcd - r) * q) + off; }
        const int nig = WGM * nN, gid = wgid / nig, fm = gid * WGM, gsz = (nM - fm) < WGM ? (nM - fm) : WGM;
        u.pm = fm + ((wgid % nig) % gsz); u.pn = (wgid % nig) / gsz; return true;
    }
};

template <class F> struct EpiRow8 {
    static constexpr bool PERM = true, AFTER_DRAIN = false, MIDHOOK = false;
    F f;
    __device__ __forceinline__ void operator()(const f32x4 (&acc)[2][2][4][2], const Unit& u, int wr, int wc, int fr, int fq) const {
        const int row0 = u.pm * BM + wr * 64 + fr, col0 = u.pn * BM + wc * 32 + 8 * fq;
#pragma unroll
        for (int ai = 0; ai < 2; ++ai)
#pragma unroll
            for (int m = 0; m < 4; ++m) {
#pragma unroll
                for (int bj = 0; bj < 2; ++bj) f(row0 + ai * HALF + m * 16, col0 + bj * HALF, acc[ai][bj][m][0], acc[ai][bj][m][1]);
                if (m == 3) asm volatile("" ::: "memory");
            }
    }
};

template <class Epi, bool ALIGN_EPI = true, bool CONVMAP = false, int AKSPLIT = 0>
__device__ __forceinline__ void gemm_phase(LAS unsigned char* lds, const Gemm g, const StaticOrder& S, const Epi& E) {
    int tid_ = threadIdx.x; asm volatile("" : "+v"(tid_));
    const int tid = tid_, wid = __builtin_amdgcn_readfirstlane(tid >> 6), lane = tid & 63, wr = wid >> 2, wc = wid & 3, fr = lane & 15, fq = lane >> 4;
    const int K = g.K, nt = K / BK;
    unsigned voffA[2], voffB[2];
#pragma unroll
    for (int i = 0; i < 2; ++i) { int R, C; stage_rc(tid * 16 + i * 8192, R, C); const int Rb = Epi::PERM ? ((R & ~31) + perm32(R & 31)) : R;
        const int Ra = CONVMAP ? (126 * (R >> 6) + 8 * (R & 15) + ((R >> 4) & 3)) : R;
        voffA[i] = (unsigned)(Ra * g.lda + C) * 2u; voffB[i] = (unsigned)(Rb * g.ldb + C) * 2u; }
    const unsigned kstep = (unsigned)(BK * 2);
    const unsigned hstepA = (unsigned)(CONVMAP ? 4 : HALF) * g.lda * 2, hstepB = (unsigned)HALF * g.ldb * 2;
    const unsigned tstepA = CONVMAP ? 252u * g.lda * 2 : 2 * hstepA, tstepB = 2 * hstepB;
    const char* const baseA = (const char*)g.A; const char* const baseB = (const char*)g.Bt;
    const unsigned ldsw = (unsigned)wid * 1024u;
    const int aoff = lds_byte(wr * 64 + fr, fq * 8), boff = lds_byte(wc * 32 + fr, fq * 8);
#define PG8_SA(b, h) (((b) * 2 + (h)) * HTB)
#define PG8_SB(b, h) ((4 + (b) * 2 + (h)) * HTB)
#define PG8_STAGE(bufoff, goff, voff) do { _Pragma("unroll") for (int _i = 0; _i < 2; ++_i) { unsigned _vo = (voff)[_i] + (goff); asm volatile("" : "+v"(_vo)); \
        __builtin_amdgcn_global_load_lds((const unsigned*)(base_##voff + _vo), (LAS unsigned*)(lds + (bufoff) + ldsw + _i * 8192), 16, 0, 0); } } while (0)
#define base_voffA baseA
#define base_voffB baseB
#define PG8_LDA(dst, b, h) do { _Pragma("unroll") for (int m = 0; m < 4; ++m) _Pragma("unroll") for (int k = 0; k < 2; ++k) dst[m][k] = *(const LAS bf16x8*)(lds + PG8_SA(b, h) + aoff + m * 2048 + k * 1024); } while (0)
#define PG8_LDB(dst, b, h) do { _Pragma("unroll") for (int n = 0; n < 2; ++n) _Pragma("unroll") for (int k = 0; k < 2; ++k) dst[n][k] = *(const LAS bf16x8*)(lds + PG8_SB(b, h) + boff + n * 2048 + k * 1024); } while (0)
#define PG8_MMA(ai, bj, At, Bt) do { __builtin_amdgcn_s_setprio(1); _Pragma("unroll") for (int m = 0; m < 4; ++m) _Pragma("unroll") for (int n = 0; n < 2; ++n) _Pragma("unroll") for (int k = 0; k < 2; ++k) \
        acc[ai][bj][m][n] = __builtin_amdgcn_mfma_f32_16x16x32_bf16(Bt[n][k], At[m][k], acc[ai][bj][m][n], 0, 0, 0); __builtin_amdgcn_s_setprio(0); } while (0)
#define PG8_KOFFA(x) ((unsigned)(x) * kstep + (AKSPLIT ? ((x) < 4 ? 2048u : 0xFFFFFE00u) : 0u))
#define PG8_WAIT_V(n) asm volatile("s_waitcnt vmcnt(" #n ")" ::: "memory")
#define PG8_WAIT_L(n) asm volatile("s_waitcnt lgkmcnt(" #n ")" ::: "memory")
#define PG8_BAR __builtin_amdgcn_s_barrier()
#define PG8_SCHED __builtin_amdgcn_sched_barrier(0)
    Unit cur, nxt; int ui = 0;
    if (!S.next(0, cur)) return;
    f32x4 acc[2][2][4][2];
#pragma unroll
    for (int a = 0; a < 2; ++a)
#pragma unroll
        for (int b = 0; b < 2; ++b)
#pragma unroll
            for (int m = 0; m < 4; ++m)
#pragma unroll
                for (int n = 0; n < 2; ++n) acc[a][b][m][n] = (f32x4){0.f, 0.f, 0.f, 0.f};
    bf16x8 At[4][2], B0[2][2], B1[2][2];
    unsigned cA = (unsigned)cur.pm * tstepA, cB = (unsigned)cur.pn * tstepB;
    PG8_STAGE(PG8_SB(0, 0), cB, voffB); PG8_STAGE(PG8_SB(0, 1), cB + hstepB, voffB); PG8_STAGE(PG8_SA(0, 0), cA + PG8_KOFFA(0), voffA); PG8_STAGE(PG8_SA(0, 1), cA + hstepA + PG8_KOFFA(0), voffA);
    if (wr == 1) PG8_BAR;
    PG8_WAIT_V(2); PG8_BAR;
    PG8_STAGE(PG8_SB(1, 0), cB + kstep, voffB); PG8_STAGE(PG8_SA(1, 0), cA + PG8_KOFFA(1), voffA); PG8_STAGE(PG8_SB(1, 1), cB + hstepB + kstep, voffB);
    PG8_WAIT_V(6); PG8_BAR;
    for (;;) {
        const bool has_next = S.next(ui + 1, nxt);
        const unsigned nA = has_next ? (unsigned)nxt.pm * tstepA : cA, nB = has_next ? (unsigned)nxt.pn * tstepB : cB;
#define PG8_ITER(t) do { \
            const bool last = (t == nt - 2); \
            const unsigned a1 = cA + PG8_KOFFA(t + 1); \
            const unsigned a2 = last ? nA + PG8_KOFFA(0) : cA + PG8_KOFFA(t + 2), b2 = last ? nB : cB + (unsigned)(t + 2) * kstep; \
            const unsigned a3 = a2 + kstep, b3 = b2 + kstep; \
            PG8_LDB(B0, 0, 0); PG8_LDB(B1, 0, 1); PG8_SCHED; PG8_LDA(At, 0, 0); PG8_STAGE(PG8_SA(1, 1), a1 + hstepA, voffA); \
            PG8_WAIT_V(8); PG8_WAIT_L(0); PG8_BAR; PG8_MMA(0, 0, At, B0); PG8_MMA(0, 1, At, B1); PG8_BAR; PG8_SCHED; \
            PG8_LDA(At, 0, 1); PG8_STAGE(PG8_SB(0, 0), b2, voffB); PG8_STAGE(PG8_SB(0, 1), b2 + hstepB, voffB); PG8_STAGE(PG8_SA(0, 0), a2, voffA); \
            PG8_WAIT_V(8); PG8_WAIT_L(0); PG8_BAR; PG8_MMA(1, 0, At, B0); PG8_MMA(1, 1, At, B1); PG8_BAR; PG8_SCHED; \
            PG8_LDB(B0, 1, 0); PG8_LDB(B1, 1, 1); PG8_SCHED; PG8_LDA(At, 1, 0); PG8_STAGE(PG8_SA(0, 1), a2 + hstepA, voffA); \
            PG8_WAIT_V(8); PG8_WAIT_L(0); PG8_BAR; PG8_MMA(0, 0, At, B0); PG8_MMA(0, 1, At, B1); PG8_BAR; PG8_SCHED; \
            PG8_LDA(At, 1, 1); PG8_STAGE(PG8_SB(1, 0), b3, voffB); PG8_STAGE(PG8_SB(1, 1), b3 + hstepB, voffB); PG8_STAGE(PG8_SA(1, 0), a3, voffA); \
            PG8_WAIT_V(8); PG8_WAIT_L(0); PG8_BAR; PG8_MMA(1, 0, At, B0); PG8_MMA(1, 1, At, B1); PG8_BAR; PG8_SCHED; \
        } while (0)
        if constexpr (Epi::MIDHOOK) {
            for (int t = 0; t < 4; t += 2) PG8_ITER(t);
            E.mid(acc, cur, wr, wc, fr, fq);
            for (int t = 4; t < nt; t += 2) PG8_ITER(t);
        } else {
            for (int t = 0; t < nt; t += 2) PG8_ITER(t);
        }
#undef PG8_ITER
        if constexpr (ALIGN_EPI) { if (wr == 0) PG8_BAR; }
        if constexpr (!Epi::AFTER_DRAIN) { E(acc, cur, wr, wc, fr, fq); }
        if (!has_next) break;
#pragma unroll
        for (int a = 0; a < 2; ++a)
#pragma unroll
            for (int b = 0; b < 2; ++b)
#pragma unroll
                for (int m = 0; m < 4; ++m)
#pragma unroll
                    for (int n = 0; n < 2; ++n) acc[a][b][m][n] = (f32x4){0.f, 0.f, 0.f, 0.f};
        cur = nxt; cA = nA; cB = nB; ++ui;
        if constexpr (ALIGN_EPI) { if (wr == 1) PG8_BAR; }
    }
    PG8_WAIT_V(0);
    if constexpr (!ALIGN_EPI) { if (wr == 0) PG8_BAR; }
    PG8_BAR;
    if constexpr (Epi::AFTER_DRAIN) { E.fused(acc, cur, wr, wc, fr, fq, lds, wid, lane); }
#undef PG8_SA
#undef PG8_SB
#undef PG8_STAGE
#undef base_voffA
#undef base_voffB
#undef PG8_LDA
#undef PG8_LDB
#undef PG8_MMA
#undef PG8_WAIT_V
#undef PG8_KOFFA
#undef PG8_WAIT_L
#undef PG8_BAR
#undef PG8_SCHED
}
}


#define XB_TMO      128
#define XB_XCNT(j)  (256  + 64 * (j))
#define XB_XSUB(j)  (1280 + 64 * (j))
#define XB_XGEN(j)  (2304 + 64 * (j))
#define XB_TOP      3328
#define XB_TOPGEN   3392
#define XCD_BAR_WORDS 3456
#define XB_SPIN_CAP (1u << 18)
__device__ __forceinline__ unsigned xb_ld(unsigned* p)              { return __hip_atomic_load(p, __ATOMIC_RELAXED, __HIP_MEMORY_SCOPE_AGENT); }
__device__ __forceinline__ unsigned xb_add(unsigned* p, unsigned v) { return __hip_atomic_fetch_add(p, v, __ATOMIC_RELAXED, __HIP_MEMORY_SCOPE_AGENT); }
__device__ __forceinline__ unsigned xb_xcc_id() { return (unsigned)__builtin_amdgcn_s_getreg((3 << 11) | 20) & 0xFu; }
#define XB_SPIN(cond, bar) do { unsigned _sp = 0; while (cond) { __builtin_amdgcn_s_sleep(1); \
    if ((++_sp & 255u) == 0u) { if (xb_ld(&(bar)[XB_TMO])) break; if (_sp > XB_SPIN_CAP) { atomicAdd(&(bar)[XB_TMO], 1u); break; } } } } while (0)
struct XcdBarrier { unsigned* bar; unsigned x; volatile LAS unsigned* st; };
__device__ __forceinline__ XcdBarrier xcd_barrier_post(unsigned* bar, volatile LAS unsigned* st) {
    XcdBarrier b; b.bar = bar; b.x = xb_xcc_id(); b.st = st;
    if (threadIdx.x == 0) (void)xb_add(&bar[XB_XCNT(b.x)], 1u);
    return b;
}
__device__ __forceinline__ void xcd_barrier_complete(unsigned* bar, unsigned x, unsigned& nloc, unsigned& nx) {
    const unsigned G = gridDim.x * gridDim.y * gridDim.z;
    unsigned sum, cnt, mine, sp = 0u;
    for (;;) {
        sum = 0u; cnt = 0u; mine = 0u;
#pragma unroll
        for (unsigned j = 0; j < 16; ++j) { const unsigned c = xb_ld(&bar[XB_XCNT(j)]); sum += c; cnt += (c > 0u) ? 1u : 0u; mine = (j == x) ? c : mine; }
        if (sum == G) break;
        __builtin_amdgcn_s_sleep(1);
        if ((++sp & 255u) == 0u) { if (xb_ld(&bar[XB_TMO])) break; if (sp > XB_SPIN_CAP) { atomicAdd(&bar[XB_TMO], 1u); break; } }
    }
    nloc = mine > 0u ? mine : 1u; nx = cnt > 0u ? cnt : 1u;
}
__device__ __forceinline__ void xcd_barrier(const XcdBarrier& b) {
    asm volatile("s_waitcnt vmcnt(0)" ::: "memory");
    __syncthreads();
    if (threadIdx.x == 0) {
        unsigned* bar = b.bar;
        __builtin_amdgcn_s_waitcnt(0);
        unsigned nloc = b.st[0], nx = b.st[1];
        if (nloc == 0u) { xcd_barrier_complete(bar, b.x, nloc, nx); b.st[0] = nloc; b.st[1] = nx; }
        const unsigned old = xb_add(&bar[XB_XSUB(b.x)], 1u);
        const unsigned gen = old / nloc;
        if (old + 1u == (gen + 1u) * nloc) {
            __builtin_amdgcn_fence(__ATOMIC_RELEASE, "agent");
            asm volatile("s_waitcnt vmcnt(0)" ::: "memory");
            const unsigned og = xb_add(&bar[XB_TOP], 1u);
            const unsigned tg = og / nx;
            if (og + 1u == (tg + 1u) * nx) xb_add(&bar[XB_TOPGEN], 1u);
            else XB_SPIN(xb_ld(&bar[XB_TOPGEN]) == tg, bar);
            __builtin_amdgcn_fence(__ATOMIC_ACQUIRE, "agent");
            xb_add(&bar[XB_XGEN(b.x)], 1u);
            asm volatile("s_waitcnt vmcnt(0)" ::: "memory");
        } else {
            XB_SPIN(xb_ld(&bar[XB_XGEN(b.x)]) == gen, bar);
            __builtin_amdgcn_fence(__ATOMIC_ACQUIRE, "agent");
            asm volatile("s_waitcnt vmcnt(0)" ::: "memory");
        }
    }
    __syncthreads();
}

struct Args {
    const float* x; const float* c; const int* positions; const float* ada_w; const float* ada_b; const float* norm1_w; const float* w_in;
    const float* gate_w2; const float* gate_b; const float* gla_norm_w; const float* w_gla; const float* w_attn; const float* w_out; const float* norm2_w;
    const float* w_up; const float* conv_w; const float* conv_b; const float* w_down; const float* final_w;
    float* out; unsigned char* ws;
};

typedef const __attribute__((address_space(4))) Args* KArgs;
__device__ __forceinline__ KArgs kargs() { KArgs p = (KArgs)__builtin_amdgcn_kernarg_segment_ptr(); asm volatile("" : "+s"(p)); return p; }

struct Ctx { int tid, lane, wave, gtid, nthr, gw, ngw; LAS unsigned char* lds; };

__device__ __forceinline__ Ctx make_ctx(unsigned char* lds_raw) {
    Ctx X; int t = threadIdx.x; asm volatile("" : "+v"(t)); X.tid = t; X.lane = X.tid & 63; X.wave = __builtin_amdgcn_readfirstlane(X.tid >> 6);
    X.gtid = blockIdx.x * 512 + X.tid; X.nthr = gridDim.x * 512; X.gw = blockIdx.x * 8 + X.wave; X.ngw = gridDim.x * 8; X.lds = (LAS unsigned char*)lds_raw; return X; }

template <int ID, class F> __device__ __forceinline__ void run_gemm(const Ctx& X, const pg8::Gemm g, const F& f) {
    pg8::StaticOrder S; S.init(g.M, g.N, (int)gridDim.x, (int)blockIdx.x);
    pg8::EpiRow8<F> E{f};
    pg8::gemm_phase<pg8::EpiRow8<F>, true>(X.lds, g, S, E);
}

struct FStoreProj { bf16_t* O; const f32x2* rope;
    __device__ __forceinline__ void operator()(int row, int col, f32x4 v0, f32x4 v1) const {
        if (col >= C_AQ && col < C_AV) { const int g8 = ((col - C_AQ) & 63) >> 3; const f32x4* rp = (const f32x4*)(rope + (size_t)row * 32 + 4 * g8); const f32x4 r0 = rp[0], r1 = rp[1];
            const f32x4 cs = {r0[0], r0[2], r1[0], r1[2]}, sn = {r0[1], r0[3], r1[1], r1[3]}; const float sc = col < C_AK ? 0.125f * 1.44269504088896f : 1.0f;
            const f32x4 a0 = (v0 * cs - v1 * sn) * sc, a1 = (v1 * cs + v0 * sn) * sc; v0 = a0; v1 = a1; }
        u32x4 w; w.x = pk2(v0[0], v0[1]); w.y = pk2(v0[2], v0[3]); w.z = pk2(v1[0], v1[1]); w.w = pk2(v1[2], v1[3]);
        *(u32x4*)(O + (size_t)row * NMAIN + col) = w; } };
struct FSigmoidSplit { bf16_t* GA; bf16_t* GB;
    __device__ __forceinline__ void operator()(int row, int col, f32x4 v0, f32x4 v1) const {
        u32x4 w; w.x = pk2(sigmoidf_(v0[0]), sigmoidf_(v0[1])); w.y = pk2(sigmoidf_(v0[2]), sigmoidf_(v0[3])); w.z = pk2(sigmoidf_(v1[0]), sigmoidf_(v1[1])); w.w = pk2(sigmoidf_(v1[2]), sigmoidf_(v1[3]));
        if (col < 1024) *(u32x4*)(GA + (size_t)row * DM + col) = w; else *(u32x4*)(GB + (size_t)row * NMAIN + (col - 1024)) = w; } };
__device__ __forceinline__ f32x2 gelu_pk(f32x2 v) {
    const f32x2 av = __builtin_elementwise_abs(v), d = av * 0.2316418882f + 1.0f;
    f32x2 t; t.x = __builtin_amdgcn_rcpf(d.x); t.y = __builtin_amdgcn_rcpf(d.y);
    f32x2 q = t * 0.5307027145f + (-0.7265760135f); q = q * t + 0.7107068705f; q = q * t + (-0.142248368f); q = q * t + 0.127414796f; q = q * t;
    const f32x2 s = (v * v) * (-0.72134752044f);
    f32x2 e; e.x = __builtin_amdgcn_exp2f(s.x); e.y = __builtin_amdgcn_exp2f(s.y);
    const f32x2 m = av * (q * e);
    f32x2 o; o.x = fmaxf(v.x, 0.f) - m.x; o.y = fmaxf(v.y, 0.f) - m.y; return o;
}
__device__ __forceinline__ f32x4 dpp_shr1(f32x4 x) {
    f32x4 r;
#pragma unroll
    for (int j = 0; j < 4; ++j) r[j] = __int_as_float(__builtin_amdgcn_update_dpp(0, __float_as_int(x[j]), 0x111, 0xf, 0xf, false));
    return r;
}
struct EpiConvGeglu {
    static constexpr bool PERM = true, AFTER_DRAIN = false, MIDHOOK = false;
    bf16_t* hidden; const float* conv_w; const float* conv_b;
    template <bool EDGE> __device__ __forceinline__ void body(const f32x4 (&acc)[2][2][4][2], const pg8::Unit& u, int wr, int wc, int fr, int fq) const {
        const int tw0 = 252 * u.pm - 2 + 126 * wr;
        const int chb = 128 * u.pn + 32 * wc + 8 * fq;
#pragma unroll
        for (int n = 0; n < 2; ++n) {
            const int ch = chb + 4 * n;
            const f32x4 wv0 = *(const f32x4*)(conv_w + ch), wv1 = *(const f32x4*)(conv_w + NUP + ch), wv2 = *(const f32x4*)(conv_w + 2 * NUP + ch), bv = *(const f32x4*)(conv_b + ch);
            const f32x4 wg0 = *(const f32x4*)(conv_w + DFF + ch), wg1 = *(const f32x4*)(conv_w + NUP + DFF + ch), wg2 = *(const f32x4*)(conv_w + 2 * NUP + DFF + ch), bg = *(const f32x4*)(conv_b + DFF + ch);
            const f32x4 v7 = dpp_shr1(acc[1][0][3][n]), v6 = dpp_shr1(acc[1][0][2][n]), g7 = dpp_shr1(acc[1][1][3][n]), g6 = dpp_shr1(acc[1][1][2][n]);
#pragma unroll
            for (int k = 0; k < 8; ++k) {
                const int ai = k >> 2, m = k & 3, lr = 8 * fr + k, tau = tw0 + lr, sp = tau & 4095;
                const f32x4 cv = acc[ai][0][m][n], cg = acc[ai][1][m][n];
                const f32x4 p1v = k >= 1 ? acc[(k >= 1 ? k - 1 : 0) >> 2][0][(k >= 1 ? k - 1 : 0) & 3][n] : v7;
                const f32x4 p1g = k >= 1 ? acc[(k >= 1 ? k - 1 : 0) >> 2][1][(k >= 1 ? k - 1 : 0) & 3][n] : g7;
                const f32x4 p2v = k >= 2 ? acc[(k >= 2 ? k - 2 : 0) >> 2][0][(k >= 2 ? k - 2 : 0) & 3][n] : (k == 1 ? v7 : v6);
                const f32x4 p2g = k >= 2 ? acc[(k >= 2 ? k - 2 : 0) >> 2][1][(k >= 2 ? k - 2 : 0) & 3][n] : (k == 1 ? g7 : g6);
                f32x4 val, gat;
                if (EDGE) { const float m1 = sp >= 1 ? 1.f : 0.f, m2 = sp >= 2 ? 1.f : 0.f;
                    val = bv + wv2 * cv + (wv1 * m1) * p1v + (wv0 * m2) * p2v; gat = bg + wg2 * cg + (wg1 * m1) * p1g + (wg0 * m2) * p2g; }
                else { val = bv + wv2 * cv + wv1 * p1v + wv0 * p2v; gat = bg + wg2 * cg + wg1 * p1g + wg0 * p2g; }
                const f32x2 g01 = gelu_pk((f32x2){gat[0], gat[1]}), g23 = gelu_pk((f32x2){gat[2], gat[3]});
                u32x2 w; w.x = pk2(g01.x * val[0], g01.y * val[1]); w.y = pk2(g23.x * val[2], g23.y * val[3]);
                if (lr >= 2 && tau < NT) *(u32x2*)((char*)hidden + (unsigned)(tau * DFF + ch) * 2u) = w;
            }
            asm volatile("" ::: "memory");
        }
    }
    __device__ __forceinline__ void operator()(const f32x4 (&acc)[2][2][4][2], const pg8::Unit& u, int wr, int wc, int fr, int fq) const {
        const int tw0 = 252 * u.pm - 2 + 126 * wr;
        const bool edge = (tw0 <= 1) || ((tw0 & 4095) < 2) || (((tw0 + 127) >> 12) != (tw0 >> 12));
        if (edge) body<true>(acc, u, wr, wc, fr, fq); else body<false>(acc, u, wr, wc, fr, fq);
    }
};

struct EpiMixed2 {
    static constexpr bool PERM = true, AFTER_DRAIN = false, MIDHOOK = true;
    const bf16_t* gA; const bf16_t* gB; bf16_t* O;
    __device__ __forceinline__ void mid(f32x4 (&acc)[2][2][4][2], const pg8::Unit& u, int wr, int wc, int fr, int fq) const {
        const int row0 = u.pm * 256 + wr * 64 + fr, col0 = u.pn * 256 + wc * 32 + 8 * fq;
#pragma unroll
        for (int ai = 0; ai < 2; ++ai)
#pragma unroll
            for (int m = 0; m < 4; ++m) { const int row = row0 + ai * 128 + m * 16;
#pragma unroll
                for (int bj = 0; bj < 2; ++bj) { const int col = col0 + bj * 128;
                    const u32x4 aw = *(const u32x4*)((const char*)gA + (unsigned)(row * DM + col) * 2u), bw = *(const u32x4*)((const char*)gB + (unsigned)(row * NMAIN + col) * 2u);
                    f32x4 r0, r1;
                    r0[0] = lo16(bw.x) * __builtin_amdgcn_rcpf(fmaxf(lo16(aw.x), 1e-20f)); r0[1] = hi16(bw.x) * __builtin_amdgcn_rcpf(fmaxf(hi16(aw.x), 1e-20f));
                    r0[2] = lo16(bw.y) * __builtin_amdgcn_rcpf(fmaxf(lo16(aw.y), 1e-20f)); r0[3] = hi16(bw.y) * __builtin_amdgcn_rcpf(fmaxf(hi16(aw.y), 1e-20f));
                    r1[0] = lo16(bw.z) * __builtin_amdgcn_rcpf(fmaxf(lo16(aw.z), 1e-20f)); r1[1] = hi16(bw.z) * __builtin_amdgcn_rcpf(fmaxf(hi16(aw.z), 1e-20f));
                    r1[2] = lo16(bw.w) * __builtin_amdgcn_rcpf(fmaxf(lo16(aw.w), 1e-20f)); r1[3] = hi16(bw.w) * __builtin_amdgcn_rcpf(fmaxf(hi16(aw.w), 1e-20f));
                    acc[ai][bj][m][0] *= r0; acc[ai][bj][m][1] *= r1;
                    asm volatile("" ::: "memory"); } }
    }
    __device__ __forceinline__ void operator()(const f32x4 (&acc)[2][2][4][2], const pg8::Unit& u, int wr, int wc, int fr, int fq) const {
        const int row0 = u.pm * 256 + wr * 64 + fr, col0 = u.pn * 256 + wc * 32 + 8 * fq;
#pragma unroll
        for (int ai = 0; ai < 2; ++ai) {
#pragma unroll
            for (int m = 0; m < 4; ++m) { const int row = row0 + ai * 128 + m * 16;
#pragma unroll
                for (int bj = 0; bj < 2; ++bj) { const int col = col0 + bj * 128; float a8[8]; unpack8(*(const u32x4*)(gA + (size_t)row * DM + col), a8);
                    const f32x4 v0 = acc[ai][bj][m][0], v1 = acc[ai][bj][m][1];
                    float o[8] = {v0[0] * a8[0], v0[1] * a8[1], v0[2] * a8[2], v0[3] * a8[3], v1[0] * a8[4], v1[1] * a8[5], v1[2] * a8[6], v1[3] * a8[7]};
                    *(u32x4*)(O + (size_t)row * DM + col) = pack8(o); } }
            asm volatile("" ::: "memory");
        }
    }
};

struct RmsPanel {
    float* xbuf;
    unsigned* cnt;
    __device__ __forceinline__ void run(const pg8::Unit& u, LAS unsigned char* lds, int wid, int lane) const {
        LAS float* P = (LAS float*)lds; LAS float* S = (LAS float*)(lds + 4096);
        asm volatile("s_waitcnt lgkmcnt(0)" ::: "memory"); __builtin_amdgcn_s_barrier(); asm volatile("" ::: "memory");
        const int row = wid * 32 + (lane & 31);
        if (lane < 32) { const float tot = (P[row * 4 + 0] + P[row * 4 + 1]) + (P[row * 4 + 2] + P[row * 4 + 3]);
            __hip_atomic_store(xbuf + (size_t)(u.pm * 256 + row) * 4 + u.pn, tot, __ATOMIC_RELAXED, __HIP_MEMORY_SCOPE_AGENT); }
        asm volatile("s_waitcnt vmcnt(0)" ::: "memory");
        if (lane == 0) __hip_atomic_fetch_add(cnt + 64 * u.pm, 1u, __ATOMIC_RELAXED, __HIP_MEMORY_SCOPE_AGENT);
        if (wid == 0) { unsigned sp = 0;
            for (;;) { if ((unsigned)__builtin_amdgcn_readfirstlane(__hip_atomic_load(cnt + 64 * u.pm, __ATOMIC_RELAXED, __HIP_MEMORY_SCOPE_AGENT)) >= 32u) break;
                if (++sp > (1u << 22)) break; __builtin_amdgcn_s_sleep(2); }
            __builtin_amdgcn_fence(__ATOMIC_ACQUIRE, "agent"); }
        asm volatile("s_waitcnt vmcnt(0) lgkmcnt(0)" ::: "memory"); __builtin_amdgcn_s_barrier(); asm volatile("" ::: "memory");
        if (lane < 32) { const float* slot = xbuf + (size_t)(u.pm * 256 + row) * 4; float q = 0.f;
#pragma unroll
            for (int t = 0; t < 4; ++t) q += __hip_atomic_load(slot + t, __ATOMIC_RELAXED, __HIP_MEMORY_SCOPE_AGENT);
            S[row] = 1.0f / sqrtf(q * (1.0f / 1024.0f) + EPS); }
        asm volatile("s_waitcnt lgkmcnt(0)" ::: "memory"); __builtin_amdgcn_s_barrier(); asm volatile("" ::: "memory");
    }
};
struct EpiResNorm {
    static constexpr bool PERM = true, AFTER_DRAIN = true, MIDHOOK = false;
    const float* base; bf16_t* x1b; bf16_t* hn; const float* mod; const float* nw; RmsPanel st;
    __device__ __forceinline__ void fused(f32x4 (&acc)[2][2][4][2], const pg8::Unit& u, int wr, int wc, int fr, int fq, LAS unsigned char* lds, int wid, int lane) const {
        const int col0 = u.pn * 256 + wc * 32 + 8 * fq, b = (u.pm * 256) >> 12; const float* mb = mod + (size_t)b * 6144;
        { LAS float* P = (LAS float*)lds;
          f32x4 gg[2][2];
#pragma unroll
          for (int bj = 0; bj < 2; ++bj) { gg[bj][0] = *(const f32x4*)(mb + 2048 + col0 + bj * 128); gg[bj][1] = *(const f32x4*)(mb + 2048 + col0 + bj * 128 + 4); }
          f32x4 nb[2][2];
          { const float* bp = base + (size_t)(u.pm * 256 + wr * 64 + fr) * DM + col0;
#pragma unroll
            for (int bj = 0; bj < 2; ++bj) { nb[bj][0] = __builtin_nontemporal_load((const f32x4*)(bp + bj * 128)); nb[bj][1] = __builtin_nontemporal_load((const f32x4*)(bp + bj * 128 + 4)); } }
#pragma unroll
          for (int k = 0; k < 8; ++k) { const int ai = k >> 2, m = k & 3, r = ai * 128 + wr * 64 + m * 16 + fr; float s = 0.f;
              f32x4 cb[2][2];
#pragma unroll
              for (int bj = 0; bj < 2; ++bj) { cb[bj][0] = nb[bj][0]; cb[bj][1] = nb[bj][1]; }
              if (k < 7) { const int k2 = k + 1; const float* bp = base + (size_t)(u.pm * 256 + (k2 >> 2) * 128 + wr * 64 + (k2 & 3) * 16 + fr) * DM + col0;
#pragma unroll
                  for (int bj = 0; bj < 2; ++bj) { nb[bj][0] = __builtin_nontemporal_load((const f32x4*)(bp + bj * 128)); nb[bj][1] = __builtin_nontemporal_load((const f32x4*)(bp + bj * 128 + 4)); } }
#pragma unroll
              for (int bj = 0; bj < 2; ++bj) { const f32x4 x0 = cb[bj][0] + gg[bj][0] * acc[ai][bj][m][0], x1 = cb[bj][1] + gg[bj][1] * acc[ai][bj][m][1];
                  acc[ai][bj][m][0] = x0; acc[ai][bj][m][1] = x1;
                  s += ((x0[0] * x0[0] + x0[1] * x0[1]) + (x0[2] * x0[2] + x0[3] * x0[3])) + ((x1[0] * x1[0] + x1[1] * x1[1]) + (x1[2] * x1[2] + x1[3] * x1[3])); }
              s += __shfl_xor(s, 16); s += __shfl_xor(s, 32);
              if (fq == 0) P[r * 4 + wc] = s;
              asm volatile("" ::: "memory"); } }
        st.run(u, lds, wid, lane);
        const LAS float* S = (const LAS float*)(lds + 4096);
#pragma unroll
        for (int bj = 0; bj < 2; ++bj) { const int col = col0 + bj * 128;
            f32x4 g2[2], s2[2];
#pragma unroll
            for (int n = 0; n < 2; ++n) { g2[n] = *(const f32x4*)(nw + col + 4 * n) * (*(const f32x4*)(mb + 4096 + col + 4 * n) + 1.0f); s2[n] = *(const f32x4*)(mb + 3072 + col + 4 * n); }
#pragma unroll
            for (int ai = 0; ai < 2; ++ai)
#pragma unroll
                for (int m = 0; m < 4; ++m) { const int r = ai * 128 + wr * 64 + m * 16 + fr; const float rstd = S[r]; const size_t off = (size_t)(u.pm * 256 + r) * DM + col;
                    { u32x4 xw; xw.x = pk2(acc[ai][bj][m][0][0], acc[ai][bj][m][0][1]); xw.y = pk2(acc[ai][bj][m][0][2], acc[ai][bj][m][0][3]); xw.z = pk2(acc[ai][bj][m][1][0], acc[ai][bj][m][1][1]); xw.w = pk2(acc[ai][bj][m][1][2], acc[ai][bj][m][1][3]);
                      *(u32x4*)(x1b + off) = xw; }
                    const f32x4 y0 = acc[ai][bj][m][0] * rstd * g2[0] + s2[0], y1 = acc[ai][bj][m][1] * rstd * g2[1] + s2[1];
                    u32x4 w; w.x = pk2(y0[0], y0[1]); w.y = pk2(y0[2], y0[3]); w.z = pk2(y1[0], y1[1]); w.w = pk2(y1[2], y1[3]);
                    *(u32x4*)(hn + off) = w; } }
    }
};
struct EpiResFinal {
    static constexpr bool PERM = true, AFTER_DRAIN = true, MIDHOOK = false;
    const bf16_t* x1b; float* out; const float* mod; const float* fw; RmsPanel st;
    __device__ __forceinline__ void fused(f32x4 (&acc)[2][2][4][2], const pg8::Unit& u, int wr, int wc, int fr, int fq, LAS unsigned char* lds, int wid, int lane) const {
        const int col0 = u.pn * 256 + wc * 32 + 8 * fq, b = (u.pm * 256) >> 12; const float* mb = mod + (size_t)b * 6144;
        { LAS float* P = (LAS float*)lds;
          f32x4 gg[2][2];
#pragma unroll
          for (int bj = 0; bj < 2; ++bj) { gg[bj][0] = *(const f32x4*)(mb + 5120 + col0 + bj * 128); gg[bj][1] = *(const f32x4*)(mb + 5120 + col0 + bj * 128 + 4); }
          u32x4 nb[2];
          { const bf16_t* bp = x1b + (size_t)(u.pm * 256 + wr * 64 + fr) * DM + col0;
#pragma unroll
            for (int bj = 0; bj < 2; ++bj) nb[bj] = __builtin_nontemporal_load((const u32x4*)(bp + bj * 128)); }
#pragma unroll
          for (int k = 0; k < 8; ++k) { const int ai = k >> 2, m = k & 3, r = ai * 128 + wr * 64 + m * 16 + fr; float s = 0.f;
              f32x4 cb[2][2];
#pragma unroll
              for (int bj = 0; bj < 2; ++bj) { cb[bj][0] = (f32x4){lo16(nb[bj].x), hi16(nb[bj].x), lo16(nb[bj].y), hi16(nb[bj].y)}; cb[bj][1] = (f32x4){lo16(nb[bj].z), hi16(nb[bj].z), lo16(nb[bj].w), hi16(nb[bj].w)}; }
              if (k < 7) { const int k2 = k + 1; const bf16_t* bp = x1b + (size_t)(u.pm * 256 + (k2 >> 2) * 128 + wr * 64 + (k2 & 3) * 16 + fr) * DM + col0;
#pragma unroll
                  for (int bj = 0; bj < 2; ++bj) nb[bj] = __builtin_nontemporal_load((const u32x4*)(bp + bj * 128)); }
#pragma unroll
              for (int bj = 0; bj < 2; ++bj) { const f32x4 x0 = cb[bj][0] + gg[bj][0] * acc[ai][bj][m][0], x1 = cb[bj][1] + gg[bj][1] * acc[ai][bj][m][1];
                  acc[ai][bj][m][0] = x0; acc[ai][bj][m][1] = x1;
                  s += ((x0[0] * x0[0] + x0[1] * x0[1]) + (x0[2] * x0[2] + x0[3] * x0[3])) + ((x1[0] * x1[0] + x1[1] * x1[1]) + (x1[2] * x1[2] + x1[3] * x1[3])); }
              s += __shfl_xor(s, 16); s += __shfl_xor(s, 32);
              if (fq == 0) P[r * 4 + wc] = s;
              asm volatile("" ::: "memory"); } }
        st.run(u, lds, wid, lane);
        const LAS float* S = (const LAS float*)(lds + 4096);
#pragma unroll
        for (int bj = 0; bj < 2; ++bj) { const int col = col0 + bj * 128; const f32x4 w0 = *(const f32x4*)(fw + col), w1 = *(const f32x4*)(fw + col + 4);
#pragma unroll
            for (int ai = 0; ai < 2; ++ai)
#pragma unroll
                for (int m = 0; m < 4; ++m) { const int r = ai * 128 + wr * 64 + m * 16 + fr; const float rstd = S[r]; const size_t off = (size_t)(u.pm * 256 + r) * DM + col;
                    __builtin_nontemporal_store(acc[ai][bj][m][0] * rstd * w0, (f32x4*)(out + off)); __builtin_nontemporal_store(acc[ai][bj][m][1] * rstd * w1, (f32x4*)(out + off + 4)); } }
    }
};

__device__ __forceinline__ void transpose_item(const float* W, int ldw, int col0, int K, bf16_t* WT, int drow0, int k0, int n0, LAS float* scr, int lane, int perm = 0, int d0 = 0) {
#pragma unroll 8
    for (int i = 0; i < 32; ++i) { const int kk = 2 * i + (lane >> 5); scr[kk * 33 + (lane & 31)] = __builtin_nontemporal_load(&W[(size_t)(k0 + kk) * ldw + col0 + n0 + (lane & 31)]); }
    asm volatile("s_waitcnt lgkmcnt(0)" ::: "memory");
    const int c = lane & 7;
#pragma unroll
    for (int j = 0; j < 4; ++j) { const int n = (lane >> 3) + 8 * j; const LAS float* s = scr + (8 * c) * 33 + n;
        u32x4 o; o.x = pk2(s[0 * 33], s[1 * 33]); o.y = pk2(s[2 * 33], s[3 * 33]); o.z = pk2(s[4 * 33], s[5 * 33]); o.w = pk2(s[6 * 33], s[7 * 33]);
        const int drow = perm ? (drow0 + 8 * (n >> 2) + (n & 3) + (d0 ? 4 : 0)) : (drow0 + n);
        *(u32x4*)(WT + (size_t)drow * K + k0 + 8 * c) = o; }
    asm volatile("s_waitcnt lgkmcnt(0)" ::: "memory");
}

__device__ __forceinline__ void phase0_transposes(const Ctx& X, KArgs a, int it0, int it1, int gw, int ngw) {
    unsigned char* ws = a->ws;
    LAS float* scr = (LAS float*)(X.lds + X.wave * 16384);
    constexpr int I1 = 16 * 96, I2 = 16 * 72, I3 = 16 * 64, I4 = 16 * 32, I5 = 4 * 32, I6 = 16 * 32, I7 = 16 * 176, I8 = 44 * 32;
    constexpr int NITEMS = I1 + I2 + I3 + I4 + I5 + I6 + I7 + I8;
    for (int it = it0 + gw; it < (it1 < 0 ? NITEMS : it1); it += ngw) {
        int r = it;
        if (r < I1) { const int nb = r % 96, kb = r / 96; transpose_item(a->w_in, DIN, 0, DM, (bf16_t*)(ws + WS_WMAIN), nb * 32, kb * 64, nb * 32, scr, X.lane); continue; } r -= I1;
        if (r < I2) { const int nb = r % 72, kb = r / 72; const bool rot = nb < 48;
            transpose_item(a->w_in, DIN, 3088, DM, (bf16_t*)(ws + WS_WMAIN), rot ? 3072 + (nb >> 1) * 64 : 3072 + nb * 32, kb * 64, nb * 32, scr, X.lane, rot ? 1 : 0, (nb & 1) * 32); continue; } r -= I2;
        if (r < I3) { const int nb = r % 64, kb = r / 64; transpose_item(a->w_in, DIN, 5392, DM, (bf16_t*)(ws + WS_WMAB), nb * 32, kb * 64, nb * 32, scr, X.lane); continue; } r -= I3;
        if (r < I4) { const int nb = r % 32, kb = r / 32; transpose_item(a->w_gla, DM, 0, 1280, (bf16_t*)(ws + WS_WG) + 256, nb * 32, kb * 64, nb * 32, scr, X.lane); continue; } r -= I4;
        if (r < I5) { const int nb = r % 32, kb = r / 32; transpose_item(a->w_attn, DM, 0, 1280, (bf16_t*)(ws + WS_WG), nb * 32, kb * 64, nb * 32, scr, X.lane); continue; } r -= I5;
        if (r < I6) { const int nb = r % 32, kb = r / 32; transpose_item(a->w_out, DM, 0, DM, (bf16_t*)(ws + WS_WOUT), nb * 32, kb * 64, nb * 32, scr, X.lane); continue; } r -= I6;
        if (r < I7) { const int nb = r % 176, kb = r / 176; const int n0 = nb * 32; const int ch = n0 % DFF; const int drow = (ch / 128) * 256 + (n0 >= DFF ? 128 : 0) + (ch % 128);
            transpose_item(a->w_up, NUP, 0, DM, (bf16_t*)(ws + WS_WUP), drow, kb * 64, n0, scr, X.lane); continue; } r -= I7;
        { const int nb = r % 32, kb = r / 32; transpose_item(a->w_down, DM, 0, DFF, (bf16_t*)(ws + WS_WDOWN), nb * 32, kb * 64, nb * 32, scr, X.lane); }
    }
}

__device__ __forceinline__ void phase0(const Ctx& X, KArgs a) {
    unsigned char* ws = a->ws;
    { bf16_t* wlr = (bf16_t*)(ws + WS_WLR);
      for (int idx = X.gtid; idx < 16 * DM; idx += X.nthr) { const int j = idx >> 10, k = idx & 1023; wlr[idx] = (bf16_t)f2bf(a->w_in[(size_t)k * DIN + 3072 + j]); } }
    { float* modp = (float*)(ws + WS_MODP);
      for (int u = X.gw; u < 96 * 32; u += X.ngw) { const int cgp = u % 96, kc = u / 96, j = cgp * 64 + X.lane;
          float w[32];
#pragma unroll
          for (int kk = 0; kk < 32; ++kk) w[kk] = __builtin_nontemporal_load(&a->ada_w[(size_t)(kc * 32 + kk) * 6144 + j]);
          const float cA = a->c[(X.lane >> 5) * DM + kc * 32 + (X.lane & 31)], cB = a->c[((X.lane >> 5) + 2) * DM + kc * 32 + (X.lane & 31)];
          const int sA = __float_as_int(cA / (1.0f + __expf(-cA))), sB = __float_as_int(cB / (1.0f + __expf(-cB)));
          float acc[4] = {0.f, 0.f, 0.f, 0.f};
#pragma unroll
          for (int kk = 0; kk < 32; ++kk) {
              acc[0] += __int_as_float(__builtin_amdgcn_readlane(sA, kk)) * w[kk]; acc[1] += __int_as_float(__builtin_amdgcn_readlane(sA, 32 + kk)) * w[kk];
              acc[2] += __int_as_float(__builtin_amdgcn_readlane(sB, kk)) * w[kk]; acc[3] += __int_as_float(__builtin_amdgcn_readlane(sB, 32 + kk)) * w[kk]; }
#pragma unroll
          for (int b = 0; b < 4; ++b) modp[(size_t)(kc * 4 + b) * 6144 + j] = acc[b]; } }
    { f32x2* rope = (f32x2*)(ws + WS_ROPE);
      for (int idx = X.gtid; idx < NT * 32; idx += X.nthr) { const int t = idx >> 5, i = idx & 31;
          const double rev = (double)a->positions[t] * INVF_REV[i]; const float fr = (float)(rev - floor(rev));
          rope[idx] = (f32x2){__builtin_amdgcn_cosf(fr), __builtin_amdgcn_sinf(fr)}; } }
}

template <int MODE> __device__ __forceinline__ void norm_pass(const Ctx& X, KArgs a, const float* xin, bf16_t* hout, float* fout) {
    unsigned char* ws = a->ws;
    const float* modp = (const float*)(ws + WS_MODP); float* mod = (float*)(ws + WS_MOD);
    if (MODE == 0) { for (int idx = X.gtid; idx < 4 * 6144; idx += X.nthr) { const int b = idx / 6144, j = idx % 6144; float s = a->ada_b[j];
            float pv[32];
#pragma unroll
            for (int kc = 0; kc < 32; ++kc) pv[kc] = modp[(size_t)(kc * 4 + b) * 6144 + j];
#pragma unroll
            for (int kc = 0; kc < 32; ++kc) s += pv[kc];
            mod[idx] = s; } }
    LAS float* gs = (LAS float*)X.lds;
    LAS bf16_t* hs = (LAS bf16_t*)(X.lds + 8192);
    for (int rt = blockIdx.x; rt < NT / 64; rt += gridDim.x) {
        const int row0 = rt * 64, b = row0 >> 12;
        __syncthreads();
        for (int idx = X.tid; idx < DM; idx += 512) {
            float g, s;
            if (MODE == 0) { float sc = a->ada_b[1024 + idx], sh = a->ada_b[idx];
                float pa[32], pb[32];
#pragma unroll
                for (int kc = 0; kc < 32; ++kc) { pa[kc] = modp[(size_t)(kc * 4 + b) * 6144 + 1024 + idx]; pb[kc] = modp[(size_t)(kc * 4 + b) * 6144 + idx]; }
#pragma unroll
                for (int kc = 0; kc < 32; ++kc) { sc += pa[kc]; sh += pb[kc]; }
                g = a->norm1_w[idx] * (1.0f + sc); s = sh; }
            else if (MODE == 1) { g = a->norm2_w[idx] * (1.0f + mod[b * 6144 + 4096 + idx]); s = mod[b * 6144 + 3072 + idx]; }
            else { g = a->final_w[idx]; s = 0.f; }
            gs[idx] = g; gs[1024 + idx] = s;
        }
        __syncthreads();
#pragma unroll 1
        for (int rb = 0; rb < 8; rb += 4) {
            f32x4 v[4][4];
#pragma unroll
            for (int r = 0; r < 4; ++r) { const f32x4* xr = (const f32x4*)(xin + (size_t)(row0 + X.wave * 8 + rb + r) * DM) + X.lane;
#pragma unroll
                for (int j = 0; j < 4; ++j) v[r][j] = __builtin_nontemporal_load(xr + 64 * j); }
#pragma unroll
            for (int r = 0; r < 4; ++r) {
                const int lr = X.wave * 8 + rb + r, row = row0 + lr;
                float ss = 0.f;
#pragma unroll
                for (int j = 0; j < 4; ++j) ss += (v[r][j][0] * v[r][j][0] + v[r][j][1] * v[r][j][1]) + (v[r][j][2] * v[r][j][2] + v[r][j][3] * v[r][j][3]);
                const float rstd = 1.0f / sqrtf(wave_sum(ss) * (1.0f / DM) + EPS);
#pragma unroll
                for (int j = 0; j < 4; ++j) { const int k = 4 * X.lane + 256 * j;
                    const f32x4 g = *(const LAS f32x4*)(gs + k), sft = *(const LAS f32x4*)(gs + 1024 + k);
                    const f32x4 y = v[r][j] * rstd * g + sft;
                    if (MODE == 2) { *((f32x4*)(fout + (size_t)row * DM) + X.lane + 64 * j) = y; }
                    else { u32x2 w; w.x = pk2(y[0], y[1]); w.y = pk2(y[2], y[3]);
                        *(u32x2*)(hout + (size_t)row * DM + k) = w;
                        if (MODE == 0) *(LAS u32x2*)(hs + lr * 1032 + k) = w; } }
            }
        }
        if (MODE == 0) {
            __syncthreads();
            const bf16_t* wlr = (const bf16_t*)(ws + WS_WLR);
            const int mt = X.wave & 3, kh = X.wave >> 2, fr = X.lane & 15, fq = X.lane >> 4;
            f32x4 acc = {0.f, 0.f, 0.f, 0.f};
#pragma unroll 4
            for (int ks = 0; ks < 16; ++ks) { const int k0 = kh * 512 + ks * 32 + 8 * fq;
                const bf16x8 av = *(const LAS bf16x8*)(hs + (16 * mt + fr) * 1032 + k0);
                const bf16x8 bv = *(const bf16x8*)(wlr + fr * 1024 + k0);
                acc = __builtin_amdgcn_mfma_f32_16x16x32_bf16(av, bv, acc, 0, 0, 0); }
            LAS f32x4* red = (LAS f32x4*)X.lds;
            if (kh == 1) red[mt * 64 + X.lane] = acc;
            __syncthreads();
            if (kh == 0) { const f32x4 o = acc + red[mt * 64 + X.lane]; float* glr = (float*)(ws + WS_GLR);
#pragma unroll
                for (int e = 0; e < 4; ++e) glr[(size_t)(row0 + 16 * mt + 4 * fq + e) * 16 + fr] = o[e]; }
        }
    }
}

constexpr int QP = 72, VP = 264;
__device__ __forceinline__ void attn_mfma(const Ctx& X, KArgs a, int dry = 0) {
    bf16_t* proj = (bf16_t*)(a->ws + WS_BIG); const f32x2* rope = (const f32x2*)(a->ws + WS_ROPE); float* lse = (float*)(a->ws + WS_LSE);
    LAS bf16_t* Qs = (LAS bf16_t*)X.lds; LAS bf16_t* Ks = (LAS bf16_t*)(X.lds + 128 * QP * 2); LAS bf16_t* Vt = (LAS bf16_t*)(X.lds + 384 * QP * 2);
    const int fr = X.lane & 15, fq = X.lane >> 4, w = X.wave, i0 = 16 * w;
    const int per = (1536 + (int)gridDim.x - 1) / (int)gridDim.x, u0 = (int)blockIdx.x * per, u1 = (u0 + per < 1536) ? u0 + per : 1536;
    int cur_half = 1;
    for (int unit = u0; unit < u1; ++unit) {
        const int b = unit / 384, rem = unit % 384, h = rem >> 5, pn = rem & 31, g = h >> 2, hg = h & 3;
        const int r = (g == 0) ? 1 : (g == 1 ? 4 : 16), nblk = 32 / r, p = pn / nblk, n = pn % nblk;
        const int tb = b * SEQ + p;
        const bool reuse = (unit > u0) && (n >= 1);
        if (reuse) cur_half ^= 1;
        const int prev_half = cur_half ^ 1;
        __syncthreads();
        { const int i = X.tid >> 2, c = X.tid & 3; const int t = tb + (128 * n + i) * r; const bf16_t* src = proj + (size_t)t * NMAIN + C_AQ + h * 64 + 16 * c;
          *(LAS u32x4*)(Qs + i * QP + 16 * c) = *(const u32x4*)src; *(LAS u32x4*)(Qs + i * QP + 16 * c + 8) = *(const u32x4*)(src + 8); }
        for (int blk = reuse ? 1 : 0; blk < 2; ++blk) {
            const int half = blk ? cur_half : prev_half;
            { const int j = X.tid >> 2, c = X.tid & 3; int m = 128 * (n - 1 + blk) + j; m = m < 0 ? 0 : m; const int t = tb + m * r;
              const bf16_t* src = proj + (size_t)t * NMAIN + C_AK + h * 64 + 16 * c;
              *(LAS u32x4*)(Ks + (half * 128 + j) * QP + 16 * c) = *(const u32x4*)src; *(LAS u32x4*)(Ks + (half * 128 + j) * QP + 16 * c + 8) = *(const u32x4*)(src + 8); }
#pragma unroll
            for (int q = 0; q < 2; ++q) { const int idx = X.tid + 512 * q, j = idx & 127, c = idx >> 7; int m = 128 * (n - 1 + blk) + j; m = m < 0 ? 0 : m; const int t = tb + m * r;
                const u32x4 wv = *(const u32x4*)(proj + (size_t)t * NMAIN + C_AV + h * 64 + 8 * c);
                LAS bf16_t* vp = Vt + (8 * c) * VP + half * 128 + j;
                vp[0 * VP] = (bf16_t)(wv.x & 0xffff); vp[1 * VP] = (bf16_t)(wv.x >> 16); vp[2 * VP] = (bf16_t)(wv.y & 0xffff); vp[3 * VP] = (bf16_t)(wv.y >> 16);
                vp[4 * VP] = (bf16_t)(wv.z & 0xffff); vp[5 * VP] = (bf16_t)(wv.z >> 16); vp[6 * VP] = (bf16_t)(wv.w & 0xffff); vp[7 * VP] = (bf16_t)(wv.w >> 16); }
        }
        __syncthreads();
#define KOFF(t_) ((((t_) >> 3) ? cur_half : prev_half) * 128 + 16 * ((t_) & 7))
        bf16x8 bq[2];
#pragma unroll
        for (int ks = 0; ks < 2; ++ks) bq[ks] = *(const LAS bf16x8*)(Qs + (i0 + fr) * QP + 32 * ks + 8 * fq);
        f32x4 sc[9];
#pragma unroll
        for (int q = 0; q < 9; ++q) { sc[q] = (f32x4){0.f, 0.f, 0.f, 0.f};
#pragma unroll
            for (int ks = 0; ks < 2; ++ks) { const bf16x8 ak = *(const LAS bf16x8*)(Ks + (KOFF(w + q) + fr) * QP + 32 * ks + 8 * fq); sc[q] = __builtin_amdgcn_mfma_f32_16x16x32_bf16(ak, bq[ks], sc[q], 0, 0, 0); } }
        const int iq = i0 + fr;
        float mx = -INFINITY;
#pragma unroll
        for (int q = 0; q < 9; ++q) { const bool tile_ok = (n > 0) || (w + q >= 8);
#pragma unroll
            for (int e = 0; e < 4; ++e) { bool valid = tile_ok;
                if (q == 0) valid = valid && (4 * fq + e >= fr);
                if (q == 8) valid = valid && (4 * fq + e <= fr);
                sc[q][e] = valid ? sc[q][e] : -INFINITY; mx = fmaxf(mx, sc[q][e]); } }
        mx = fmaxf(mx, __shfl_xor(mx, 16)); mx = fmaxf(mx, __shfl_xor(mx, 32));
        float l = 0.f;
#pragma unroll
        for (int q = 0; q < 9; ++q)
#pragma unroll
            for (int e = 0; e < 4; ++e) { sc[q][e] = __builtin_amdgcn_exp2f(sc[q][e] - mx); l += sc[q][e]; }
        l += __shfl_xor(l, 16); l += __shfl_xor(l, 32);
        f32x4 o[4];
#pragma unroll
        for (int dt = 0; dt < 4; ++dt) o[dt] = (f32x4){0.f, 0.f, 0.f, 0.f};
#pragma unroll
        for (int c = 0; c < 5; ++c) { const int jtA = w + 2 * c; int jtB = w + 2 * c + 1; jtB = jtB > 15 ? 15 : jtB;
            const f32x4 pa = sc[2 * c]; const f32x4 pb = (2 * c + 1 <= 8) ? sc[(2 * c + 1 <= 8) ? 2 * c + 1 : 8] : (f32x4){0.f, 0.f, 0.f, 0.f};
            u32x4 pw; pw.x = pk2(pa[0], pa[1]); pw.y = pk2(pa[2], pa[3]); pw.z = pk2(pb[0], pb[1]); pw.w = pk2(pb[2], pb[3]);
            const bf16x8 bfrag = __builtin_bit_cast(bf16x8, pw);
#pragma unroll
            for (int dt = 0; dt < 4; ++dt) { const LAS bf16_t* vr = Vt + (16 * dt + fr) * VP + 4 * fq;
                const u32x2 lo = *(const LAS u32x2*)(vr + KOFF(jtA)), hi = *(const LAS u32x2*)(vr + KOFF(jtB)); const u32x4 av = {lo.x, lo.y, hi.x, hi.y};
                o[dt] = __builtin_amdgcn_mfma_f32_16x16x32_bf16(__builtin_bit_cast(bf16x8, av), bfrag, o[dt], 0, 0, 0); } }
        const float il = 1.0f / l; const int tq = tb + (128 * n + iq) * r;
        bf16_t* op = (dry ? proj + (size_t)NT * NMAIN + (size_t)(tq & 63) * NMAIN : proj + (size_t)tq * NMAIN) + C_AQ + h * 64 + 4 * fq;
#pragma unroll
        for (int dt = 0; dt < 4; ++dt) { u32x2 wv; wv.x = pk2(o[dt][0] * il, o[dt][1] * il); wv.y = pk2(o[dt][2] * il, o[dt][3] * il); *(u32x2*)(op + 16 * dt) = wv; }
        if (fq == 0) lse[((size_t)g * NT + tq) * 4 + hg] = mx * 0.6931471805599453f + __logf(l);
    }
}
#undef KOFF

__device__ __forceinline__ void attn_combine(const Ctx& X, KArgs a) {
    bf16_t* proj = (bf16_t*)(a->ws + WS_BIG); const float* lse = (const float*)(a->ws + WS_LSE);
    for (int base = X.gtid; base < NT * 32; base += 4 * X.nthr) {
        u32x4 o0[4], o1[4], o2[4]; float l0[4], l1[4], l2[4];
#pragma unroll
        for (int q = 0; q < 4; ++q) { const int idx = base + q * X.nthr; if (idx < NT * 32) { const int t = idx >> 5, c8 = (idx & 31) * 8, hg = c8 >> 6;
            l0[q] = lse[((size_t)0 * NT + t) * 4 + hg]; l1[q] = lse[((size_t)1 * NT + t) * 4 + hg]; l2[q] = lse[((size_t)2 * NT + t) * 4 + hg];
            const bf16_t* p = proj + (size_t)t * NMAIN + C_AQ + c8; o0[q] = *(const u32x4*)p; o1[q] = *(const u32x4*)(p + 256); o2[q] = *(const u32x4*)(p + 512); } }
#pragma unroll
        for (int q = 0; q < 4; ++q) { const int idx = base + q * X.nthr; if (idx < NT * 32) { const int t = idx >> 5, c8 = (idx & 31) * 8;
            const float mx = fmaxf(l0[q], fmaxf(l1[q], l2[q])); float w0 = __expf(l0[q] - mx), w1 = __expf(l1[q] - mx), w2 = __expf(l2[q] - mx); const float inv = 1.0f / (w0 + w1 + w2); w0 *= inv; w1 *= inv; w2 *= inv;
            float f0[8], f1[8], f2[8], o[8]; unpack8(o0[q], f0); unpack8(o1[q], f1); unpack8(o2[q], f2);
#pragma unroll
            for (int e = 0; e < 8; ++e) o[e] = w0 * f0[e] + w1 * f1[e] + w2 * f2[e];
            *(u32x4*)(proj + (size_t)t * NMAIN + C_AQ + c8) = pack8(o); } }
    }
}

constexpr int GP = 136;
__device__ __forceinline__ void gla_bcum(KArgs a, int tid, int t0, int h, LAS float* segtot, LAS float* glrs, float (&bc)[32], float& tot) {
    const int d = tid & 127, seg = __builtin_amdgcn_readfirstlane(tid >> 7), col = h * 128 + d;
    const float* glr = (const float*)(a->ws + WS_GLR);
    float w2r[16];
#pragma unroll
    for (int j = 0; j < 16; ++j) w2r[j] = a->gate_w2[j * 512 + col];
    const float bias = a->gate_b[col];
    *(LAS f32x4*)(glrs + tid * 4) = *(const f32x4*)(glr + (size_t)t0 * 16 + tid * 4);
    __syncthreads();
    float run = 0.f;
#pragma unroll
    for (int r = 0; r < 32; ++r) { const LAS f32x4* gp = (const LAS f32x4*)(glrs + (seg * 32 + r) * 16);
        float z = bias;
#pragma unroll
        for (int q = 0; q < 4; ++q) { const f32x4 g = gp[q]; z += g[0] * w2r[4 * q] + g[1] * w2r[4 * q + 1] + g[2] * w2r[4 * q + 2] + g[3] * w2r[4 * q + 3]; }
        const float la = (fminf(z, 0.f) - __logf(1.0f + __expf(-fabsf(z)))) * (1.0f / 16.0f);
        run += la; bc[r] = run; }
    segtot[seg * 128 + d] = run;
    __syncthreads();
    float off = 0.f; tot = 0.f;
#pragma unroll
    for (int s2 = 0; s2 < 4; ++s2) { const float v = segtot[s2 * 128 + d]; tot += v; if (s2 < seg) off += v; }
#pragma unroll
    for (int r = 0; r < 32; ++r) bc[r] += off;
}
__device__ __forceinline__ void gla_stage_vT(const bf16_t* proj, int tid, int t0, int h, LAS bf16_t* vT) {
#pragma unroll
    for (int q = 0; q < 8; ++q) { const int i = tid >> 2, c = (tid & 3) + 4 * q;
        const u32x4 wv = *(const u32x4*)(proj + (size_t)(t0 + i) * NMAIN + C_GV + h * 256 + 8 * c);
        LAS bf16_t* vp = vT + (8 * c) * GP + i;
        vp[0 * GP] = (bf16_t)(wv.x & 0xffff); vp[1 * GP] = (bf16_t)(wv.x >> 16); vp[2 * GP] = (bf16_t)(wv.y & 0xffff); vp[3 * GP] = (bf16_t)(wv.y >> 16);
        vp[4 * GP] = (bf16_t)(wv.z & 0xffff); vp[5 * GP] = (bf16_t)(wv.z >> 16); vp[6 * GP] = (bf16_t)(wv.w & 0xffff); vp[7 * GP] = (bf16_t)(wv.w >> 16); }
}
__device__ __forceinline__ void gla_a1(const Ctx& X, KArgs a, float* kvt, float* decb) {
    const bf16_t* proj = (const bf16_t*)(a->ws + WS_BIG);
    LAS bf16_t* kdT = (LAS bf16_t*)X.lds; LAS bf16_t* vT = (LAS bf16_t*)(X.lds + 128 * GP * 2); LAS float* segtot = (LAS float*)(X.lds + 384 * GP * 2);
    const int fr = X.lane & 15, fq = X.lane >> 4, w = X.wave;
    for (int unit = blockIdx.x; unit < 512; unit += gridDim.x) {
        const int bh = unit >> 5, n = unit & 31, b = bh >> 2, h = bh & 3, t0 = b * SEQ + n * 128;
        __syncthreads();
        float bc[32], tot; gla_bcum(a, X.tid, t0, h, segtot, (LAS float*)vT, bc, tot);
        { const int d = X.tid & 127, seg = X.tid >> 7;
#pragma unroll
          for (int r8 = 0; r8 < 4; ++r8) { float kd[8];
#pragma unroll
              for (int e = 0; e < 8; ++e) { const int r = r8 * 8 + e; kd[e] = bf2f(proj[(size_t)(t0 + seg * 32 + r) * NMAIN + C_GK + h * 128 + d]) * __expf(tot - bc[r]); }
              *(LAS u32x4*)(kdT + d * GP + seg * 32 + r8 * 8) = pack8(kd); }
          if (seg == 0) decb[unit * 128 + d] = __expf(tot); }
        gla_stage_vT(proj, X.tid, t0, h, vT);
        __syncthreads();
        f32x4 acc[8][2];
#pragma unroll
        for (int mt = 0; mt < 8; ++mt) { acc[mt][0] = (f32x4){0.f, 0.f, 0.f, 0.f}; acc[mt][1] = (f32x4){0.f, 0.f, 0.f, 0.f}; }
#pragma unroll
        for (int ks = 0; ks < 4; ++ks) {
            bf16x8 bfr[2];
#pragma unroll
            for (int nt = 0; nt < 2; ++nt) bfr[nt] = *(const LAS bf16x8*)(vT + (32 * w + 16 * nt + fr) * GP + 32 * ks + 8 * fq);
#pragma unroll
            for (int mt = 0; mt < 8; ++mt) { const bf16x8 af = *(const LAS bf16x8*)(kdT + (16 * mt + fr) * GP + 32 * ks + 8 * fq);
#pragma unroll
                for (int nt = 0; nt < 2; ++nt) acc[mt][nt] = __builtin_amdgcn_mfma_f32_16x16x32_bf16(af, bfr[nt], acc[mt][nt], 0, 0, 0); }
        }
        bf16_t* ko = (bf16_t*)kvt + (size_t)unit * 32768;
#pragma unroll
        for (int mt = 0; mt < 8; ++mt)
#pragma unroll
            for (int nt = 0; nt < 2; ++nt) { u32x2 wv; wv.x = pk2(acc[mt][nt][0], acc[mt][nt][1]); wv.y = pk2(acc[mt][nt][2], acc[mt][nt][3]);
                *(u32x2*)(ko + (32 * w + 16 * nt + fr) * 128 + 16 * mt + 4 * fq) = wv; }
    }
}
__device__ __forceinline__ void gla_a2(const Ctx& X, KArgs a, float* kvt, const float* decb, int dry = 0) {
    u32x2* kb = (u32x2*)kvt;
    for (int gid = X.gtid; gid < 131072; gid += X.nthr) {
        const int bh = gid >> 13, e4 = gid & 8191, d4 = (e4 & 31) * 4;
        f32x4 S = {0.f, 0.f, 0.f, 0.f};
        u32x2 kv[32];
#pragma unroll
        for (int j = 0; j < 32; ++j) kv[j] = kb[(size_t)(bh * 32 + j) * 8192 + e4];
#pragma unroll
        for (int hb = 0; hb < 2; ++hb) {
            f32x4 dc[16];
#pragma unroll
            for (int j = 0; j < 16; ++j) dc[j] = *(const f32x4*)(decb + (bh * 32 + hb * 16 + j) * 128 + d4);
#pragma unroll
            for (int j = 0; j < 16; ++j) { const int jj = hb * 16 + j, unit = bh * 32 + jj; u32x2 wv; wv.x = pk2(S[0], S[1]); wv.y = pk2(S[2], S[3]);
                if (dry) *((u32x2*)(a->ws + WS_BIG + (size_t)NT * NMAIN * 2) + gid) = wv; else kb[(size_t)unit * 8192 + e4] = wv;
                const f32x4 kf = {lo16(kv[jj].x), hi16(kv[jj].x), lo16(kv[jj].y), hi16(kv[jj].y)}; S = dc[j] * S + kf; }
        }
    }
}
__device__ __forceinline__ void gla_a3(const Ctx& X, KArgs a, const float* kvt, int dry = 0) {
    bf16_t* proj = (bf16_t*)(a->ws + WS_BIG);
    LAS bf16_t* qgs = (LAS bf16_t*)X.lds; LAS bf16_t* kgs = (LAS bf16_t*)(X.lds + 128 * GP * 2); LAS bf16_t* vT = (LAS bf16_t*)(X.lds + 256 * GP * 2); LAS float* segtot = (LAS float*)(X.lds + 512 * GP * 2);
    const int fr = X.lane & 15, fq = X.lane >> 4, w = X.wave, i0 = 16 * w;
    for (int unit = blockIdx.x; unit < 512; unit += gridDim.x) {
        const int bh = unit >> 5, n = unit & 31, b = bh >> 2, h = bh & 3, t0 = b * SEQ + n * 128;
        __syncthreads();
        { float bc[32], tot; gla_bcum(a, X.tid, t0, h, segtot, (LAS float*)vT, bc, tot);
          const int d = X.tid & 127, seg = X.tid >> 7;
#pragma unroll
          for (int r = 0; r < 32; ++r) { const int i = seg * 32 + r; const bf16_t* row = proj + (size_t)(t0 + i) * NMAIN + h * 128 + d;
              const float qv = bf2f(row[C_GQ]), kv = bf2f(row[C_GK]);
              qgs[i * GP + d] = (bf16_t)f2bf(qv * 0.08838834764831845f * __expf(bc[r])); kgs[i * GP + d] = (bf16_t)f2bf(kv * __expf(-bc[r])); } }
        gla_stage_vT(proj, X.tid, t0, h, vT);
        __syncthreads();
        bf16x8 afr[4];
#pragma unroll
        for (int ks = 0; ks < 4; ++ks) afr[ks] = *(const LAS bf16x8*)(qgs + (i0 + fr) * GP + 32 * ks + 8 * fq);
        f32x4 acc[16];
#pragma unroll
        for (int nt = 0; nt < 16; ++nt) acc[nt] = (f32x4){0.f, 0.f, 0.f, 0.f};
        for (int jt = 0; jt <= (w | 1); ++jt) {
            f32x4 att = {0.f, 0.f, 0.f, 0.f};
            if (jt <= w) {
#pragma unroll
                for (int ks = 0; ks < 4; ++ks) { const bf16x8 bf = *(const LAS bf16x8*)(kgs + (16 * jt + fr) * GP + 32 * ks + 8 * fq); att = __builtin_amdgcn_mfma_f32_16x16x32_bf16(afr[ks], bf, att, 0, 0, 0); }
            }
#pragma unroll
            for (int e = 0; e < 4; ++e) { const int i = i0 + 4 * fq + e, j = 16 * jt + fr; qgs[i * GP + j] = (bf16_t)f2bf(j <= i ? att[e] : 0.f); }
        }
        asm volatile("s_waitcnt lgkmcnt(0)" ::: "memory");
        for (int ks = 0; ks <= (w >> 1); ++ks) { const bf16x8 af = *(const LAS bf16x8*)(qgs + (i0 + fr) * GP + 32 * ks + 8 * fq);
#pragma unroll
            for (int nt = 0; nt < 16; ++nt) { const bf16x8 bf = *(const LAS bf16x8*)(vT + (16 * nt + fr) * GP + 32 * ks + 8 * fq); acc[nt] = __builtin_amdgcn_mfma_f32_16x16x32_bf16(af, bf, acc[nt], 0, 0, 0); } }
        if (n > 0) {
            __syncthreads();
            const bf16_t* sb = (const bf16_t*)kvt + (size_t)unit * 32768;
#pragma unroll
            for (int q = 0; q < 8; ++q) { const int sidx = X.tid + 512 * q; const u32x4 wv = *(const u32x4*)(sb + (size_t)sidx * 8);
                *(LAS u32x4*)(vT + (sidx >> 4) * GP + (sidx & 15) * 8) = wv; }
            __syncthreads();
#pragma unroll
            for (int ks = 0; ks < 4; ++ks)
#pragma unroll
                for (int nt = 0; nt < 16; ++nt) { const bf16x8 bf = *(const LAS bf16x8*)(vT + (16 * nt + fr) * GP + 32 * ks + 8 * fq); acc[nt] = __builtin_amdgcn_mfma_f32_16x16x32_bf16(afr[ks], bf, acc[nt], 0, 0, 0); }
        }
        float rs[4];
#pragma unroll
        for (int e = 0; e < 4; ++e) { float s2 = 0.f;
#pragma unroll
            for (int nt = 0; nt < 16; ++nt) s2 += acc[nt][e] * acc[nt][e];
            s2 += __shfl_xor(s2, 1); s2 += __shfl_xor(s2, 2); s2 += __shfl_xor(s2, 4); s2 += __shfl_xor(s2, 8);
            rs[e] = 1.0f / sqrtf(s2 * (1.0f / 256.0f) + EPS); }
        __syncthreads();
        { LAS bf16_t* ost = (LAS bf16_t*)(X.lds + w * 8704);
#pragma unroll
          for (int nt = 0; nt < 16; ++nt) { const float nw = a->gla_norm_w[16 * nt + fr];
#pragma unroll
              for (int e = 0; e < 4; ++e) ost[(4 * fq + e) * 272 + 16 * nt + fr] = (bf16_t)f2bf(acc[nt][e] * rs[e] * nw); }
          asm volatile("s_waitcnt lgkmcnt(0)" ::: "memory");
          const int r = X.lane >> 2, cgp = X.lane & 3;
          bf16_t* orow = proj + (size_t)(t0 + i0 + r) * NMAIN + C_GR + h * 256;
          bf16_t* drow = dry ? proj + (size_t)NT * NMAIN + (size_t)((t0 + i0 + r) & 63) * NMAIN + C_GR + h * 256 : orow;
          u32x4 gv[8];
#pragma unroll
          for (int q = 0; q < 8; ++q) gv[q] = *(const u32x4*)(orow + 8 * (cgp + 4 * q));
#pragma unroll
          for (int q = 0; q < 8; ++q) { const int c = cgp + 4 * q; float v[8], gr[8]; unpack8(*(const LAS u32x4*)(ost + r * 272 + 8 * c), v); unpack8(gv[q], gr);
#pragma unroll
              for (int e = 0; e < 8; ++e) v[e] *= gr[e] * sigmoidf_(gr[e]);
              *(u32x4*)(drow + 8 * c) = pack8(v); } }
    }
}

__global__ void __launch_bounds__(512, 2) fwd_megakernel(Args a_kernarg) {
    extern __shared__ __attribute__((aligned(16))) unsigned char lds_raw[];
    cg::grid_group grid = cg::this_grid();
#define X make_ctx(lds_raw)
    { volatile LAS unsigned* st0 = (volatile LAS unsigned*)((LAS unsigned char*)lds_raw + LDS_BYTES - 64); if (threadIdx.x < 2) st0[threadIdx.x] = 0u; }
    __syncthreads();
    const XcdBarrier xbar = xcd_barrier_post((unsigned*)(kargs()->ws), (volatile LAS unsigned*)((LAS unsigned char*)lds_raw + LDS_BYTES - 64));
#define WSP(T, off) ((T*)(a->ws + (off)))

    phase0(X, kargs());
    if (gridDim.x == 0x7fffffffu) grid.sync();
    xcd_barrier(xbar);
    { KArgs a = kargs(); norm_pass<0>(X, a, a->x, WSP(bf16_t, WS_HBUF), nullptr); }
    __syncthreads();
    phase0_transposes(X, kargs(), 0, 16 * 96 + 16 * 72 + 16 * 64, X.gw, X.ngw);
    xcd_barrier(xbar);
    { KArgs a = kargs(); pg8::Gemm g{WSP(bf16_t, WS_HBUF), WSP(bf16_t, WS_WMAIN), NT, NMAIN, DM, DM, DM}; run_gemm<0>(X, g, FStoreProj{WSP(bf16_t, WS_BIG), WSP(f32x2, WS_ROPE)}); }
    { const int nfull = (gridDim.x > 64) ? 64 : 0;
      if ((int)blockIdx.x >= nfull) phase0_transposes(X, kargs(), 16 * 96 + 16 * 72 + 16 * 64, -1, ((int)blockIdx.x - nfull) * 8 + X.wave, ((int)gridDim.x - nfull) * 8); }
    xcd_barrier(xbar);
#pragma unroll 1
    for (int step = 0; step < 2; ++step) {
        if (((step ^ (int)blockIdx.x) & 1) == 0) { KArgs a = kargs(); gla_a1(X, a, a->out, WSP(float, WS_SSQ)); }
        else attn_mfma(X, kargs());
        __syncthreads();
    }
    xcd_barrier(xbar);
    { KArgs a = kargs(); gla_a2(X, a, a->out, WSP(float, WS_SSQ)); }
    xcd_barrier(xbar);
    if ((blockIdx.x & 1) == 0) { KArgs a = kargs(); pg8::Gemm g{WSP(bf16_t, WS_HBUF), WSP(bf16_t, WS_WMAB), NT, NGATE, DM, DM, DM};
        run_gemm<1>(X, g, FSigmoidSplit{(bf16_t*)a->out + (size_t)NT * DM, WSP(bf16_t, WS_BIG) + C_AK}); }
    __syncthreads();
    { KArgs a = kargs(); gla_a3(X, a, a->out); }
    attn_combine(X, kargs());
    __syncthreads();
    if ((blockIdx.x & 1) != 0) { KArgs a = kargs(); pg8::Gemm g{WSP(bf16_t, WS_HBUF), WSP(bf16_t, WS_WMAB), NT, NGATE, DM, DM, DM};
        run_gemm<1>(X, g, FSigmoidSplit{(bf16_t*)a->out + (size_t)NT * DM, WSP(bf16_t, WS_BIG) + C_AK}); }
    xcd_barrier(xbar);
    { KArgs a = kargs(); pg8::Gemm g{WSP(bf16_t, WS_BIG) + C_GR, WSP(bf16_t, WS_WG), NT, DM, 1280, NMAIN, 1280};
      pg8::StaticOrder S; S.init(NT, DM, (int)gridDim.x, (int)blockIdx.x);
      EpiMixed2 E{(const bf16_t*)a->out + (size_t)NT * DM, WSP(bf16_t, WS_BIG) + C_AK, WSP(bf16_t, WS_HBUF)};
      pg8::gemm_phase<EpiMixed2, true, false, 1>(X.lds, g, S, E); }
    xcd_barrier(xbar);
    { KArgs a = kargs(); pg8::Gemm g{WSP(bf16_t, WS_HBUF), WSP(bf16_t, WS_WOUT), NT, DM, DM, DM, DM};
      pg8::StaticOrder S; S.init(NT, DM, (int)gridDim.x, (int)blockIdx.x);
      EpiResNorm E{a->x, WSP(bf16_t, WS_BIG) + (size_t)48 * 1024 * 1024, WSP(bf16_t, WS_HBUF), WSP(float, WS_MOD), a->norm2_w, RmsPanel{WSP(float, WS_GLR), (unsigned*)(a->ws + 16384)}};
      pg8::gemm_phase<EpiResNorm, false>(X.lds, g, S, E); }
    xcd_barrier(xbar);
    { KArgs a = kargs(); pg8::Gemm g{WSP(bf16_t, WS_HBUF) - 2 * DM, WSP(bf16_t, WS_WUP), NT, NUP, DM, DM, DM};
      pg8::StaticOrder S; S.init_tiles(66, NUP / 256, (int)gridDim.x, (int)blockIdx.x);
      EpiConvGeglu E{WSP(bf16_t, WS_BIG), a->conv_w, a->conv_b};
      pg8::gemm_phase<EpiConvGeglu, true, true>(X.lds, g, S, E); }
    xcd_barrier(xbar);
    { KArgs a = kargs(); pg8::Gemm g{WSP(bf16_t, WS_BIG), WSP(bf16_t, WS_WDOWN), NT, DM, DFF, DFF, DFF};
      pg8::StaticOrder S; S.init(NT, DM, (int)gridDim.x, (int)blockIdx.x);
      EpiResFinal E{WSP(bf16_t, WS_BIG) + (size_t)48 * 1024 * 1024, a->out, WSP(float, WS_MOD), a->final_w, RmsPanel{WSP(float, WS_GLR) + 65536, (unsigned*)(a->ws + 32768)}};
      pg8::gemm_phase<EpiResFinal, false>(X.lds, g, S, E); }
#undef WSP
#undef X
}

extern "C" void kernel_launch(void* const* d_in, const int* in_sizes, int n_in, void* d_out, int out_size, void* d_ws, size_t ws_size, hipStream_t stream) {
    static int grid_blocks = 0;
    if (grid_blocks == 0) {
        if (n_in != 19 || out_size != NT * DM || ws_size < WS_END) { fprintf(stderr, "kernel_launch: unexpected sizes (n_in %d out %d ws %zu)\n", n_in, out_size, ws_size); grid_blocks = -1; return; }
        int dev = 0, cus = 0, per_cu = 0;
        hipGetDevice(&dev); hipDeviceGetAttribute(&cus, hipDeviceAttributeMultiprocessorCount, dev);
        hipFuncSetAttribute((const void*)fwd_megakernel, hipFuncAttributeMaxDynamicSharedMemorySize, LDS_BYTES);
        hipOccupancyMaxActiveBlocksPerMultiprocessor(&per_cu, (const void*)fwd_megakernel, 512, LDS_BYTES);
        if (per_cu < 1) { fprintf(stderr, "kernel_launch: occupancy query says %d blocks per CU\n", per_cu); per_cu = 1; }
        if (per_cu > 1) per_cu = 1;
        grid_blocks = cus * per_cu;
        (void)hipGetLastError();
    }
    if (grid_blocks < 0) return;
    Args a{};
    a.x = (const float*)d_in[0]; a.c = (const float*)d_in[1]; a.positions = (const int*)d_in[2]; a.ada_w = (const float*)d_in[3]; a.ada_b = (const float*)d_in[4];
    a.norm1_w = (const float*)d_in[5]; a.w_in = (const float*)d_in[6]; a.gate_w2 = (const float*)d_in[7]; a.gate_b = (const float*)d_in[8]; a.gla_norm_w = (const float*)d_in[9];
    a.w_gla = (const float*)d_in[10]; a.w_attn = (const float*)d_in[11]; a.w_out = (const float*)d_in[12]; a.norm2_w = (const float*)d_in[13]; a.w_up = (const float*)d_in[14];
    a.conv_w = (const float*)d_in[15]; a.conv_b = (const float*)d_in[16]; a.w_down = (const float*)d_in[17]; a.final_w = (const float*)d_in[18];
    a.out = (float*)d_out; a.ws = (unsigned char*)d_ws;
    (void)hipMemsetAsync(d_ws, 0, 65536, stream);
    void* args[] = {&a};
    hipError_t e = hipLaunchCooperativeKernel((const void*)fwd_megakernel, dim3(grid_blocks), dim3(512), args, LDS_BYTES, stream);
    if (e != hipSuccess) fprintf(stderr, "cooperative launch failed: %s (grid %d)\n", hipGetErrorString(e), grid_blocks);
}
```

```cpp
#include <hip/hip_runtime.h>
#include <hip/hip_cooperative_groups.h>
#include <cstdio>
#include <cstdint>
namespace cg = cooperative_groups;


#define LAS __attribute__((address_space(3)))
typedef unsigned short bf16_t;
typedef short bf16x8 __attribute__((ext_vector_type(8)));
typedef float f32x4 __attribute__((ext_vector_type(4)));
typedef float f32x2 __attribute__((ext_vector_type(2)));
typedef unsigned u32x4 __attribute__((ext_vector_type(4)));
typedef unsigned u32x2 __attribute__((ext_vector_type(2)));

constexpr int NB = 4, SEQ = 4096, DM = 1024, NT = NB * SEQ;
constexpr int DIN = 7440, NMAIN = 5376, NGATE = 2048;
constexpr int C_GQ = 0, C_GK = 512, C_GV = 1024, C_GR = 2048, C_AQ = 3072, C_AK = 3840, C_AV = 4608;
constexpr int DFF = 2816, NUP = 5632;
constexpr float EPS = 1e-6f;

constexpr size_t KiB = 1024, MiB = 1024 * 1024;
constexpr size_t WS_MOD = 256 * KiB;
constexpr size_t WS_WLR = 512 * KiB;
constexpr size_t WS_SSQ = 768 * KiB;
constexpr size_t WS_GLR = 1 * MiB;
constexpr size_t WS_LSE = 2 * MiB;
constexpr size_t WS_MODP = 3 * MiB;
constexpr size_t WS_ROPE = 6 * MiB;
constexpr size_t WS_WMAIN = 10 * MiB;
constexpr size_t WS_WMAB = WS_WMAIN + (size_t)NMAIN * DM * 2;
constexpr size_t WS_WG = WS_WMAB + (size_t)NGATE * DM * 2;
constexpr size_t WS_WA = WS_WG + (size_t)DM * DM * 2;
constexpr size_t WS_WOUT = WS_WA + (size_t)DM * 256 * 2;
constexpr size_t WS_WUP = WS_WOUT + (size_t)DM * DM * 2;
constexpr size_t WS_WDOWN = WS_WUP + (size_t)NUP * DM * 2;
constexpr size_t WS_WEND = WS_WDOWN + (size_t)DM * DFF * 2;
constexpr size_t WS_HBUF = 47 * MiB;
constexpr size_t WS_BIG = 79 * MiB;
constexpr size_t WS_END = 255 * MiB;
static_assert(WS_WEND <= WS_HBUF, "weights overflow");

constexpr int LDS_BYTES = 147456;

__device__ const double INVF_REV[32] = {
1.59154943091895346e-01, 1.19349370211248862e-01, 8.94994016088910133e-02, 6.71150830052272551e-02, 5.03292121044870353e-02, 3.77415847174197711e-02, 2.83021958306233987e-02, 2.12236527647776604e-02,
1.59154943091895339e-02, 1.19349370211248862e-02, 8.94994016088910237e-03, 6.71150830052272534e-03, 5.03292121044870370e-03, 3.77415847174197719e-03, 2.83021958306233987e-03, 2.12236527647776622e-03,
1.59154943091895356e-03, 1.19349370211248849e-03, 8.94994016088910237e-04, 6.71150830052272599e-04, 5.03292121044870326e-04, 3.77415847174197741e-04, 2.83021958306233954e-04, 2.12236527647776605e-04,
1.59154943091895351e-04, 1.19349370211248862e-04, 8.94994016088910182e-05, 6.71150830052272545e-05, 5.03292121044870354e-05, 3.77415847174197768e-05, 2.83021958306233961e-05, 2.12236527647776592e-05};

__device__ __forceinline__ float bf2f(bf16_t v) { return __uint_as_float((unsigned)v << 16); }

typedef __bf16 bf16x2_hw __attribute__((ext_vector_type(2)));
__device__ __forceinline__ unsigned f2bf(float f) { return (unsigned)__builtin_bit_cast(unsigned short, (__bf16)f); }
__device__ __forceinline__ unsigned pk2(float lo, float hi) { const f32x2 v = {lo, hi}; return __builtin_bit_cast(unsigned, __builtin_convertvector(v, bf16x2_hw)); }
__device__ __forceinline__ float lo16(unsigned w) { return __uint_as_float(w << 16); }
__device__ __forceinline__ float hi16(unsigned w) { return __uint_as_float(w & 0xffff0000u); }
__device__ __forceinline__ void unpack8(u32x4 w, float* f) { f[0] = lo16(w.x); f[1] = hi16(w.x); f[2] = lo16(w.y); f[3] = hi16(w.y); f[4] = lo16(w.z); f[5] = hi16(w.z); f[6] = lo16(w.w); f[7] = hi16(w.w); }
__device__ __forceinline__ u32x4 pack8(const float* f) { u32x4 w; w.x = pk2(f[0], f[1]); w.y = pk2(f[2], f[3]); w.z = pk2(f[4], f[5]); w.w = pk2(f[6], f[7]); return w; }
__device__ __forceinline__ float wave_sum(float v) {
#pragma unroll
    for (int o = 1; o < 64; o <<= 1) v += __shfl_xor(v, o);
    return v;
}
__device__ __forceinline__ float sigmoidf_(float x) { return __builtin_amdgcn_rcpf(1.0f + __expf(-x)); }

namespace pg8 {
constexpr int BM = 256, BK = 64, HALF = 128, HTB = HALF * BK * 2, STAGE_BYTES = 8 * HTB, NXCD = 8, WGM = 8;
__host__ __device__ __forceinline__ int lds_byte(int r, int c) { const int st = (r >> 4) * 2 + (c >> 5), rr = r & 15, cc = c & 31, ob = rr * 64 + cc * 2; return st * 1024 + (ob ^ (((ob >> 9) & 1) << 5)); }
__host__ __device__ __forceinline__ void stage_rc(int b, int& R, int& C) { const int st = b / 1024, sb = b % 1024, swz = sb ^ (((sb >> 9) & 1) << 5); R = (st >> 1) * 16 + swz / 64; C = (st & 1) * 32 + (swz % 64) / 2; }
__host__ __device__ __forceinline__ int perm32(int rho) { const int n = rho >> 4, i = rho & 15; return 8 * (i >> 2) + 4 * n + (i & 3); }

struct Unit { int pm, pn; };
struct Gemm { const bf16_t* A; const bf16_t* Bt; int M, N, K, lda, ldb; };

struct StaticOrder {
    int nM, nN, nwg, G, c;
    __host__ __device__ void init(int M, int N, int G_, int c_) { nM = M / BM; nN = N / BM; nwg = nM * nN; G = G_; c = c_; }
    __host__ __device__ void init_tiles(int nM_, int nN_, int G_, int c_) { nM = nM_; nN = nN_; nwg = nM * nN; G = G_; c = c_; }
    __host__ __device__ bool next(int i, Unit& u) const {
        const long L = (long)i * G + c; if (L >= nwg) return false;
        int wgid = (int)L; { const int q = nwg / NXCD, r = nwg % NXCD, xcd = wgid % NXCD, off = wgid / NXCD; wgid = (xcd < r ? xcd * (q + 1) : r * (q + 1) + (xcd - r) * q) + off; }
        const int nig = WGM * nN, gid = wgid / nig, fm = gid * WGM, gsz = (nM - fm) < WGM ? (nM - fm) : WGM;
        u.pm = fm + ((wgid % nig) % gsz); u.pn = (wgid % nig) / gsz; return true;
    }
};

template <class F> struct EpiRow8 {
    static constexpr bool PERM = true, AFTER_DRAIN = false, MIDHOOK = false;
    F f;
    __device__ __forceinline__ void operator()(const f32x4 (&acc)[2][2][4][2], const Unit& u, int wr, int wc, int fr, int fq) const {
        const int row0 = u.pm * BM + wr * 64 + fr, col0 = u.pn * BM + wc * 32 + 8 * fq;
#pragma unroll
        for (int ai = 0; ai < 2; ++ai)
#pragma unroll
            for (int m = 0; m < 4; ++m) {
#pragma unroll
                for (int bj = 0; bj < 2; ++bj) f(row0 + ai * HALF + m * 16, col0 + bj * HALF, acc[ai][bj][m][0], acc[ai][bj][m][1]);
                if (m == 3) asm volatile("" ::: "memory");
            }
    }
};

template <class Epi, bool ALIGN_EPI = true, bool CONVMAP = false, int AKSPLIT = 0>
__device__ __forceinline__ void gemm_phase(LAS unsigned char* lds, const Gemm g, const StaticOrder& S, const Epi& E) {
    int tid_ = threadIdx.x; asm volatile("" : "+v"(tid_));
    const int tid = tid_, wid = __builtin_amdgcn_readfirstlane(tid >> 6), lane = tid & 63, wr = wid >> 2, wc = wid & 3, fr = lane & 15, fq = lane >> 4;
    const int K = g.K, nt = K / BK;
    unsigned voffA[2], voffB[2];
#pragma unroll
    for (int i = 0; i < 2; ++i) { int R, C; stage_rc(tid * 16 + i * 8192, R, C); const int Rb = Epi::PERM ? ((R & ~31) + perm32(R & 31)) : R;
        const int Ra = CONVMAP ? (126 * (R >> 6) + 8 * (R & 15) + ((R >> 4) & 3)) : R;
        voffA[i] = (unsigned)(Ra * g.lda + C) * 2u; voffB[i] = (unsigned)(Rb * g.ldb + C) * 2u; }
    const unsigned kstep = (unsigned)(BK * 2);
    const unsigned hstepA = (unsigned)(CONVMAP ? 4 : HALF) * g.lda * 2, hstepB = (unsigned)HALF * g.ldb * 2;
    const unsigned tstepA = CONVMAP ? 252u * g.lda * 2 : 2 * hstepA, tstepB = 2 * hstepB;
    const char* const baseA = (const char*)g.A; const char* const baseB = (const char*)g.Bt;
    const unsigned ldsw = (unsigned)wid * 1024u;
    const int aoff = lds_byte(wr * 64 + fr, fq * 8), boff = lds_byte(wc * 32 + fr, fq * 8);
#define PG8_SA(b, h) (((b) * 2 + (h)) * HTB)
#define PG8_SB(b, h) ((4 + (b) * 2 + (h)) * HTB)
#define PG8_STAGE(bufoff, goff, voff) do { _Pragma("unroll") for (int _i = 0; _i < 2; ++_i) { unsigned _vo = (voff)[_i] + (goff); asm volatile("" : "+v"(_vo)); \
        __builtin_amdgcn_global_load_lds((const unsigned*)(base_##voff + _vo), (LAS unsigned*)(lds + (bufoff) + ldsw + _i * 8192), 16, 0, 0); } } while (0)
#define base_voffA baseA
#define base_voffB baseB
#define PG8_LDA(dst, b, h) do { _Pragma("unroll") for (int m = 0; m < 4; ++m) _Pragma("unroll") for (int k = 0; k < 2; ++k) dst[m][k] = *(const LAS bf16x8*)(lds + PG8_SA(b, h) + aoff + m * 2048 + k * 1024); } while (0)
#define PG8_LDB(dst, b, h) do { _Pragma("unroll") for (int n = 0; n < 2; ++n) _Pragma("unroll") for (int k = 0; k < 2; ++k) dst[n][k] = *(const LAS bf16x8*)(lds + PG8_SB(b, h) + boff + n * 2048 + k * 1024); } while (0)
#define PG8_MMA(ai, bj, At, Bt) do { __builtin_amdgcn_s_setprio(1); _Pragma("unroll") for (int m = 0; m < 4; ++m) _Pragma("unroll") for (int n = 0; n < 2; ++n) _Pragma("unroll") for (int k = 0; k < 2; ++k) \
        acc[ai][bj][m][n] = __builtin_amdgcn_mfma_f32_16x16x32_bf16(Bt[n][k], At[m][k], acc[ai][bj][m][n], 0, 0, 0); __builtin_amdgcn_s_setprio(0); } while (0)
#define PG8_KOFFA(x) ((unsigned)(x) * kstep + (AKSPLIT ? ((x) < 4 ? 2048u : 0xFFFFFE00u) : 0u))
#define PG8_WAIT_V(n) asm volatile("s_waitcnt vmcnt(" #n ")" ::: "memory")
#define PG8_WAIT_L(n) asm volatile("s_waitcnt lgkmcnt(" #n ")" ::: "memory")
#define PG8_BAR __builtin_amdgcn_s_barrier()
#define PG8_SCHED __builtin_amdgcn_sched_barrier(0)
    Unit cur, nxt; int ui = 0;
    if (!S.next(0, cur)) return;
    f32x4 acc[2][2][4][2];
#pragma unroll
    for (int a = 0; a < 2; ++a)
#pragma unroll
        for (int b = 0; b < 2; ++b)
#pragma unroll
            for (int m = 0; m < 4; ++m)
#pragma unroll
                for (int n = 0; n < 2; ++n) acc[a][b][m][n] = (f32x4){0.f, 0.f, 0.f, 0.f};
    bf16x8 At[4][2], B0[2][2], B1[2][2];
    unsigned cA = (unsigned)cur.pm * tstepA, cB = (unsigned)cur.pn * tstepB;
    PG8_STAGE(PG8_SB(0, 0), cB, voffB); PG8_STAGE(PG8_SB(0, 1), cB + hstepB, voffB); PG8_STAGE(PG8_SA(0, 0), cA + PG8_KOFFA(0), voffA); PG8_STAGE(PG8_SA(0, 1), cA + hstepA + PG8_KOFFA(0), voffA);
    if (wr == 1) PG8_BAR;
    PG8_WAIT_V(2); PG8_BAR;
    PG8_STAGE(PG8_SB(1, 0), cB + kstep, voffB); PG8_STAGE(PG8_SA(1, 0), cA + PG8_KOFFA(1), voffA); PG8_STAGE(PG8_SB(1, 1), cB + hstepB + kstep, voffB);
    PG8_WAIT_V(6); PG8_BAR;
    for (;;) {
        const bool has_next = S.next(ui + 1, nxt);
        const unsigned nA = has_next ? (unsigned)nxt.pm * tstepA : cA, nB = has_next ? (unsigned)nxt.pn * tstepB : cB;
#define PG8_ITER(t) do { \
            const bool last = (t == nt - 2); \
            const unsigned a1 = cA + PG8_KOFFA(t + 1); \
            const unsigned a2 = last ? nA + PG8_KOFFA(0) : cA + PG8_KOFFA(t + 2), b2 = last ? nB : cB + (unsigned)(t + 2) * kstep; \
            const unsigned a3 = a2 + kstep, b3 = b2 + kstep; \
            PG8_LDB(B0, 0, 0); PG8_LDB(B1, 0, 1); PG8_SCHED; PG8_LDA(At, 0, 0); PG8_STAGE(PG8_SA(1, 1), a1 + hstepA, voffA); \
            PG8_WAIT_V(8); PG8_WAIT_L(0); PG8_BAR; PG8_MMA(0, 0, At, B0); PG8_MMA(0, 1, At, B1); PG8_BAR; PG8_SCHED; \
            PG8_LDA(At, 0, 1); PG8_STAGE(PG8_SB(0, 0), b2, voffB); PG8_STAGE(PG8_SB(0, 1), b2 + hstepB, voffB); PG8_STAGE(PG8_SA(0, 0), a2, voffA); \
            PG8_WAIT_V(8); PG8_WAIT_L(0); PG8_BAR; PG8_MMA(1, 0, At, B0); PG8_MMA(1, 1, At, B1); PG8_BAR; PG8_SCHED; \
            PG8_LDB(B0, 1, 0); PG8_LDB(B1, 1, 1); PG8_SCHED; PG8_LDA(At, 1, 0); PG8_STAGE(PG8_SA(0, 1), a2 + hstepA, voffA); \
            PG8_WAIT_V(8); PG8_WAIT_L(0); PG8_BAR; PG8_MMA(0, 0, At, B0); PG8_MMA(0, 1, At, B1); PG8_BAR; PG8_SCHED; \
            PG8_LDA(At, 1, 1); PG8_STAGE(PG8_SB(1, 0), b3, voffB); PG8_STAGE(PG8_SB(1, 1), b3 + hstepB, voffB); PG8_STAGE(PG8_SA(1, 0), a3, voffA); \
            PG8_WAIT_V(8); PG8_WAIT_L(0); PG8_BAR; PG8_MMA(1, 0, At, B0); PG8_MMA(1, 1, At, B1); PG8_BAR; PG8_SCHED; \
        } while (0)
        if constexpr (Epi::MIDHOOK) {
            for (int t = 0; t < 4; t += 2) PG8_ITER(t);
            E.mid(acc, cur, wr, wc, fr, fq);
            for (int t = 4; t < nt; t += 2) PG8_ITER(t);
        } else {
            for (int t = 0; t < nt; t += 2) PG8_ITER(t);
        }
#undef PG8_ITER
        if constexpr (ALIGN_EPI) { if (wr == 0) PG8_BAR; }
        if constexpr (!Epi::AFTER_DRAIN) { E(acc, cur, wr, wc, fr, fq); }
        if (!has_next) break;
#pragma unroll
        for (int a = 0; a < 2; ++a)
#pragma unroll
            for (int b = 0; b < 2; ++b)
#pragma unroll
                for (int m = 0; m < 4; ++m)
#pragma unroll
                    for (int n = 0; n < 2; ++n) acc[a][b][m][n] = (f32x4){0.f, 0.f, 0.f, 0.f};
        cur = nxt; cA = nA; cB = nB; ++ui;
        if constexpr (ALIGN_EPI) { if (wr == 1) PG8_BAR; }
    }
    PG8_WAIT_V(0);
    if constexpr (!ALIGN_EPI) { if (wr == 0) PG8_BAR; }
    PG8_BAR;
    if constexpr (Epi::AFTER_DRAIN) { E.fused(acc, cur, wr, wc, fr, fq, lds, wid, lane); }
#undef PG8_SA
#undef PG8_SB
#undef PG8_STAGE
#undef base_voffA
#undef base_voffB
#undef PG8_LDA
#undef PG8_LDB
#undef PG8_MMA
#undef PG8_WAIT_V
#undef PG8_KOFFA
#undef PG8_WAIT_L
#undef PG8_BAR
#undef PG8_SCHED
}
}


#define XB_TMO      128
#define XB_XCNT(j)  (256  + 64 * (j))
#define XB_XSUB(j)  (1280 + 64 * (j))
#define XB_XGEN(j)  (2304 + 64 * (j))
#define XB_TOP      3328
#define XB_TOPGEN   3392
#define XCD_BAR_WORDS 3456
#define XB_SPIN_CAP (1u << 18)
__device__ __forceinline__ unsigned xb_ld(unsigned* p)              { return __hip_atomic_load(p, __ATOMIC_RELAXED, __HIP_MEMORY_SCOPE_AGENT); }
__device__ __forceinline__ unsigned xb_add(unsigned* p, unsigned v) { return __hip_atomic_fetch_add(p, v, __ATOMIC_RELAXED, __HIP_MEMORY_SCOPE_AGENT); }
__device__ __forceinline__ unsigned xb_xcc_id() { return (unsigned)__builtin_amdgcn_s_getreg((3 << 11) | 20) & 0xFu; }
#define XB_SPIN(cond, bar) do { unsigned _sp = 0; while (cond) { __builtin_amdgcn_s_sleep(1); \
    if ((++_sp & 255u) == 0u) { if (xb_ld(&(bar)[XB_TMO])) break; if (_sp > XB_SPIN_CAP) { atomicAdd(&(bar)[XB_TMO], 1u); break; } } } } while (0)
struct XcdBarrier { unsigned* bar; unsigned x; volatile LAS unsigned* st; };
__device__ __forceinline__ XcdBarrier xcd_barrier_post(unsigned* bar, volatile LAS unsigned* st) {
    XcdBarrier b; b.bar = bar; b.x = xb_xcc_id(); b.st = st;
    if (threadIdx.x == 0) (void)xb_add(&bar[XB_XCNT(b.x)], 1u);
    return b;
}
__device__ __forceinline__ void xcd_barrier_complete(unsigned* bar, unsigned x, unsigned& nloc, unsigned& nx) {
    const unsigned G = gridDim.x * gridDim.y * gridDim.z;
    unsigned sum, cnt, mine, sp = 0u;
    for (;;) {
        sum = 0u; cnt = 0u; mine = 0u;
#pragma unroll
        for (unsigned j = 0; j < 16; ++j) { const unsigned c = xb_ld(&bar[XB_XCNT(j)]); sum += c; cnt += (c > 0u) ? 1u : 0u; mine = (j == x) ? c : mine; }
        if (sum == G) break;
        __builtin_amdgcn_s_sleep(1);
        if ((++sp & 255u) == 0u) { if (xb_ld(&bar[XB_TMO])) break; if (sp > XB_SPIN_CAP) { atomicAdd(&bar[XB_TMO], 1u); break; } }
    }
    nloc = mine > 0u ? mine : 1u; nx = cnt > 0u ? cnt : 1u;
}
__device__ __forceinline__ void xcd_barrier(const XcdBarrier& b) {
    asm volatile("s_waitcnt vmcnt(0)" ::: "memory");
    __syncthreads();
    if (threadIdx.x == 0) {
        unsigned* bar = b.bar;
        __builtin_amdgcn_s_waitcnt(0);
        unsigned nloc = b.st[0], nx = b.st[1];
        if (nloc == 0u) { xcd_barrier_complete(bar, b.x, nloc, nx); b.st[0] = nloc; b.st[1] = nx; }
        const unsigned old = xb_add(&bar[XB_XSUB(b.x)], 1u);
        const unsigned gen = old / nloc;
        if (old + 1u == (gen + 1u) * nloc) {
            __builtin_amdgcn_fence(__ATOMIC_RELEASE, "agent");
            asm volatile("s_waitcnt vmcnt(0)" ::: "memory");
            const unsigned og = xb_add(&bar[XB_TOP], 1u);
            const unsigned tg = og / nx;
            if (og + 1u == (tg + 1u) * nx) xb_add(&bar[XB_TOPGEN], 1u);
            else XB_SPIN(xb_ld(&bar[XB_TOPGEN]) == tg, bar);
            __builtin_amdgcn_fence(__ATOMIC_ACQUIRE, "agent");
            xb_add(&bar[XB_XGEN(b.x)], 1u);
            asm volatile("s_waitcnt vmcnt(0)" ::: "memory");
        } else {
            XB_SPIN(xb_ld(&bar[XB_XGEN(b.x)]) == gen, bar);
            __builtin_amdgcn_fence(__ATOMIC_ACQUIRE, "agent");
            asm volatile("s_waitcnt vmcnt(0)" ::: "memory");
        }
    }
    __syncthreads();
}

struct Args {
    const float* x; const float* c; const int* positions; const float* ada_w; const float* ada_b; const float* norm1_w; const float* w_in;
    const float* gate_w2; const float* gate_b; const float* gla_norm_w; const float* w_gla; const float* w_attn; const float* w_out; const float* norm2_w;
    const float* w_up; const float* conv_w; const float* conv_b; const float* w_down; const float* final_w;
    float* out; unsigned char* ws;
};

typedef const __attribute__((address_space(4))) Args* KArgs;
__device__ __forceinline__ KArgs kargs() { KArgs p = (KArgs)__builtin_amdgcn_kernarg_segment_ptr(); asm volatile("" : "+s"(p)); return p; }

struct Ctx { int tid, lane, wave, gtid, nthr, gw, ngw; LAS unsigned char* lds; };

__device__ __forceinline__ Ctx make_ctx(unsigned char* lds_raw) {
    Ctx X; int t = threadIdx.x; asm volatile("" : "+v"(t)); X.tid = t; X.lane = X.tid & 63; X.wave = __builtin_amdgcn_readfirstlane(X.tid >> 6);
    X.gtid = blockIdx.x * 512 + X.tid; X.nthr = gridDim.x * 512; X.gw = blockIdx.x * 8 + X.wave; X.ngw = gridDim.x * 8; X.lds = (LAS unsigned char*)lds_raw; return X; }

template <int ID, class F> __device__ __forceinline__ void run_gemm(const Ctx& X, const pg8::Gemm g, const F& f) {
    pg8::StaticOrder S; S.init(g.M, g.N, (int)gridDim.x, (int)blockIdx.x);
    pg8::EpiRow8<F> E{f};
    pg8::gemm_phase<pg8::EpiRow8<F>, true>(X.lds, g, S, E);
}

struct FStoreProj { bf16_t* O; const f32x2* rope;
    __device__ __forceinline__ void operator()(int row, int col, f32x4 v0, f32x4 v1) const {
        if (col >= C_AQ && col < C_AV) { const int g8 = ((col - C_AQ) & 63) >> 3; const f32x4* rp = (const f32x4*)(rope + (size_t)row * 32 + 4 * g8); const f32x4 r0 = rp[0], r1 = rp[1];
            const f32x4 cs = {r0[0], r0[2], r1[0], r1[2]}, sn = {r0[1], r0[3], r1[1], r1[3]}; const float sc = col < C_AK ? 0.125f * 1.44269504088896f : 1.0f;
            const f32x4 a0 = (v0 * cs - v1 * sn) * sc, a1 = (v1 * cs + v0 * sn) * sc; v0 = a0; v1 = a1; }
        u32x4 w; w.x = pk2(v0[0], v0[1]); w.y = pk2(v0[2], v0[3]); w.z = pk2(v1[0], v1[1]); w.w = pk2(v1[2], v1[3]);
        *(u32x4*)((char*)O + (unsigned)(row * NMAIN + col) * 2u) = w; } };
struct FSigmoidSplit { bf16_t* GA; bf16_t* GB;
    __device__ __forceinline__ void operator()(int row, int col, f32x4 v0, f32x4 v1) const {
        u32x4 w; w.x = pk2(sigmoidf_(v0[0]), sigmoidf_(v0[1])); w.y = pk2(sigmoidf_(v0[2]), sigmoidf_(v0[3])); w.z = pk2(sigmoidf_(v1[0]), sigmoidf_(v1[1])); w.w = pk2(sigmoidf_(v1[2]), sigmoidf_(v1[3]));
        if (col < 1024) *(u32x4*)((char*)GA + (unsigned)(row * DM + col) * 2u) = w; else *(u32x4*)((char*)GB + (unsigned)(row * NMAIN + (col - 1024)) * 2u) = w; } };
__device__ __forceinline__ f32x2 gelu_pk(f32x2 v) {
    const f32x2 av = __builtin_elementwise_abs(v), d = av * 0.2316418882f + 1.0f;
    f32x2 t; t.x = __builtin_amdgcn_rcpf(d.x); t.y = __builtin_amdgcn_rcpf(d.y);
    f32x2 q = t * 0.5307027145f + (-0.7265760135f); q = q * t + 0.7107068705f; q = q * t + (-0.142248368f); q = q * t + 0.127414796f; q = q * t;
    const f32x2 s = (v * v) * (-0.72134752044f);
    f32x2 e; e.x = __builtin_amdgcn_exp2f(s.x); e.y = __builtin_amdgcn_exp2f(s.y);
    const f32x2 m = av * (q * e);
    f32x2 o; o.x = fmaxf(v.x, 0.f) - m.x; o.y = fmaxf(v.y, 0.f) - m.y; return o;
}
__device__ __forceinline__ f32x4 dpp_shr1(f32x4 x) {
    f32x4 r;
#pragma unroll
    for (int j = 0; j < 4; ++j) r[j] = __int_as_float(__builtin_amdgcn_update_dpp(0, __float_as_int(x[j]), 0x111, 0xf, 0xf, false));
    return r;
}
struct EpiConvGeglu {
    static constexpr bool PERM = true, AFTER_DRAIN = false, MIDHOOK = false;
    bf16_t* hidden; const float* conv_w; const float* conv_b;
    template <bool EDGE> __device__ __forceinline__ void body(const f32x4 (&acc)[2][2][4][2], const pg8::Unit& u, int wr, int wc, int fr, int fq) const {
        const int tw0 = 252 * u.pm - 2 + 126 * wr;
        const int chb = 128 * u.pn + 32 * wc + 8 * fq;
#pragma unroll
        for (int n = 0; n < 2; ++n) {
            const int ch = chb + 4 * n;
            const f32x4 wv0 = *(const f32x4*)(conv_w + ch), wv1 = *(const f32x4*)(conv_w + NUP + ch), wv2 = *(const f32x4*)(conv_w + 2 * NUP + ch), bv = *(const f32x4*)(conv_b + ch);
            const f32x4 wg0 = *(const f32x4*)(conv_w + DFF + ch), wg1 = *(const f32x4*)(conv_w + NUP + DFF + ch), wg2 = *(const f32x4*)(conv_w + 2 * NUP + DFF + ch), bg = *(const f32x4*)(conv_b + DFF + ch);
            const f32x4 v7 = dpp_shr1(acc[1][0][3][n]), v6 = dpp_shr1(acc[1][0][2][n]), g7 = dpp_shr1(acc[1][1][3][n]), g6 = dpp_shr1(acc[1][1][2][n]);
#pragma unroll
            for (int k = 0; k < 8; ++k) {
                const int ai = k >> 2, m = k & 3, lr = 8 * fr + k, tau = tw0 + lr, sp = tau & 4095;
                const f32x4 cv = acc[ai][0][m][n], cg = acc[ai][1][m][n];
                const f32x4 p1v = k >= 1 ? acc[(k >= 1 ? k - 1 : 0) >> 2][0][(k >= 1 ? k - 1 : 0) & 3][n] : v7;
                const f32x4 p1g = k >= 1 ? acc[(k >= 1 ? k - 1 : 0) >> 2][1][(k >= 1 ? k - 1 : 0) & 3][n] : g7;
                const f32x4 p2v = k >= 2 ? acc[(k >= 2 ? k - 2 : 0) >> 2][0][(k >= 2 ? k - 2 : 0) & 3][n] : (k == 1 ? v7 : v6);
                const f32x4 p2g = k >= 2 ? acc[(k >= 2 ? k - 2 : 0) >> 2][1][(k >= 2 ? k - 2 : 0) & 3][n] : (k == 1 ? g7 : g6);
                f32x4 val, gat;
                if (EDGE) { const float m1 = sp >= 1 ? 1.f : 0.f, m2 = sp >= 2 ? 1.f : 0.f;
                    val = bv + wv2 * cv + (wv1 * m1) * p1v + (wv0 * m2) * p2v; gat = bg + wg2 * cg + (wg1 * m1) * p1g + (wg0 * m2) * p2g; }
                else { val = bv + wv2 * cv + wv1 * p1v + wv0 * p2v; gat = bg + wg2 * cg + wg1 * p1g + wg0 * p2g; }
                const f32x2 g01 = gelu_pk((f32x2){gat[0], gat[1]}), g23 = gelu_pk((f32x2){gat[2], gat[3]});
                u32x2 w; w.x = pk2(g01.x * val[0], g01.y * val[1]); w.y = pk2(g23.x * val[2], g23.y * val[3]);
                if (lr >= 2 && tau < NT) *(u32x2*)((char*)hidden + (unsigned)(tau * DFF + ch) * 2u) = w;
            }
            asm volatile("" ::: "memory");
        }
    }
    __device__ __forceinline__ void operator()(const f32x4 (&acc)[2][2][4][2], const pg8::Unit& u, int wr, int wc, int fr, int fq) const {
        const int tw0 = 252 * u.pm - 2 + 126 * wr;
        const bool edge = (tw0 <= 1) || ((tw0 & 4095) < 2) || (((tw0 + 127) >> 12) != (tw0 >> 12));
        if (edge) body<true>(acc, u, wr, wc, fr, fq); else body<false>(acc, u, wr, wc, fr, fq);
    }
};

struct EpiMixed2 {
    static constexpr bool PERM = true, AFTER_DRAIN = false, MIDHOOK = true;
    const bf16_t* gA; const bf16_t* gB; bf16_t* O;
    __device__ __forceinline__ void mid(f32x4 (&acc)[2][2][4][2], const pg8::Unit& u, int wr, int wc, int fr, int fq) const {
        const int row0 = u.pm * 256 + wr * 64 + fr, col0 = u.pn * 256 + wc * 32 + 8 * fq;
#pragma unroll
        for (int ai = 0; ai < 2; ++ai)
#pragma unroll
            for (int m = 0; m < 4; ++m) { const int row = row0 + ai * 128 + m * 16;
#pragma unroll
                for (int bj = 0; bj < 2; ++bj) { const int col = col0 + bj * 128;
                    const u32x4 aw = *(const u32x4*)((const char*)gA + (unsigned)(row * DM + col) * 2u), bw = *(const u32x4*)((const char*)gB + (unsigned)(row * NMAIN + col) * 2u);
                    f32x4 r0, r1;
                    r0[0] = lo16(bw.x) * __builtin_amdgcn_rcpf(fmaxf(lo16(aw.x), 1e-20f)); r0[1] = hi16(bw.x) * __builtin_amdgcn_rcpf(fmaxf(hi16(aw.x), 1e-20f));
                    r0[2] = lo16(bw.y) * __builtin_amdgcn_rcpf(fmaxf(lo16(aw.y), 1e-20f)); r0[3] = hi16(bw.y) * __builtin_amdgcn_rcpf(fmaxf(hi16(aw.y), 1e-20f));
                    r1[0] = lo16(bw.z) * __builtin_amdgcn_rcpf(fmaxf(lo16(aw.z), 1e-20f)); r1[1] = hi16(bw.z) * __builtin_amdgcn_rcpf(fmaxf(hi16(aw.z), 1e-20f));
                    r1[2] = lo16(bw.w) * __builtin_amdgcn_rcpf(fmaxf(lo16(aw.w), 1e-20f)); r1[3] = hi16(bw.w) * __builtin_amdgcn_rcpf(fmaxf(hi16(aw.w), 1e-20f));
                    acc[ai][bj][m][0] *= r0; acc[ai][bj][m][1] *= r1;
                    asm volatile("" ::: "memory"); } }
    }
    __device__ __forceinline__ void operator()(const f32x4 (&acc)[2][2][4][2], const pg8::Unit& u, int wr, int wc, int fr, int fq) const {
        const int row0 = u.pm * 256 + wr * 64 + fr, col0 = u.pn * 256 + wc * 32 + 8 * fq;
#pragma unroll
        for (int ai = 0; ai < 2; ++ai) {
#pragma unroll
            for (int m = 0; m < 4; ++m) { const int row = row0 + ai * 128 + m * 16;
#pragma unroll
                for (int bj = 0; bj < 2; ++bj) { const int col = col0 + bj * 128; float a8[8]; unpack8(*(const u32x4*)(gA + (size_t)row * DM + col), a8);
                    const f32x4 v0 = acc[ai][bj][m][0], v1 = acc[ai][bj][m][1];
                    float o[8] = {v0[0] * a8[0], v0[1] * a8[1], v0[2] * a8[2], v0[3] * a8[3], v1[0] * a8[4], v1[1] * a8[5], v1[2] * a8[6], v1[3] * a8[7]};
                    *(u32x4*)(O + (size_t)row * DM + col) = pack8(o); } }
            asm volatile("" ::: "memory");
        }
    }
};

struct RmsPanel {
    float* xbuf;
    unsigned* cnt;
    __device__ __forceinline__ void run(const pg8::Unit& u, LAS unsigned char* lds, int wid, int lane) const {
        LAS float* P = (LAS float*)lds; LAS float* S = (LAS float*)(lds + 4096);
        asm volatile("s_waitcnt lgkmcnt(0)" ::: "memory"); __builtin_amdgcn_s_barrier(); asm volatile("" ::: "memory");
        const int row = wid * 32 + (lane & 31);
        if (lane < 32) { const float tot = (P[row * 4 + 0] + P[row * 4 + 1]) + (P[row * 4 + 2] + P[row * 4 + 3]);
            __hip_atomic_store(xbuf + (size_t)(u.pm * 256 + row) * 4 + u.pn, tot, __ATOMIC_RELAXED, __HIP_MEMORY_SCOPE_AGENT); }
        asm volatile("s_waitcnt vmcnt(0)" ::: "memory");
        if (lane == 0) __hip_atomic_fetch_add(cnt + 64 * u.pm, 1u, __ATOMIC_RELAXED, __HIP_MEMORY_SCOPE_AGENT);
        if (wid == 0) { unsigned sp = 0;
            for (;;) { if ((unsigned)__builtin_amdgcn_readfirstlane(__hip_atomic_load(cnt + 64 * u.pm, __ATOMIC_RELAXED, __HIP_MEMORY_SCOPE_AGENT)) >= 32u) break;
                if (++sp > (1u << 22)) break; __builtin_amdgcn_s_sleep(2); }
            __builtin_amdgcn_fence(__ATOMIC_ACQUIRE, "agent"); }
        asm volatile("s_waitcnt vmcnt(0) lgkmcnt(0)" ::: "memory"); __builtin_amdgcn_s_barrier(); asm volatile("" ::: "memory");
        if (lane < 32) { const float* slot = xbuf + (size_t)(u.pm * 256 + row) * 4; float q = 0.f;
#pragma unroll
            for (int t = 0; t < 4; ++t) q += __hip_atomic_load(slot + t, __ATOMIC_RELAXED, __HIP_MEMORY_SCOPE_AGENT);
            S[row] = 1.0f / sqrtf(q * (1.0f / 1024.0f) + EPS); }
        asm volatile("s_waitcnt lgkmcnt(0)" ::: "memory"); __builtin_amdgcn_s_barrier(); asm volatile("" ::: "memory");
    }
};
struct EpiResNorm {
    static constexpr bool PERM = true, AFTER_DRAIN = true, MIDHOOK = false;
    const float* base; bf16_t* x1b; bf16_t* hn; const float* mod; const float* nw; RmsPanel st;
    __device__ __forceinline__ void fused(f32x4 (&acc)[2][2][4][2], const pg8::Unit& u, int wr, int wc, int fr, int fq, LAS unsigned char* lds, int wid, int lane) const {
        const int col0 = u.pn * 256 + wc * 32 + 8 * fq, b = (u.pm * 256) >> 12; const float* mb = mod + (size_t)b * 6144;
        { LAS float* P = (LAS float*)lds;
          f32x4 gg[2][2];
#pragma unroll
          for (int bj = 0; bj < 2; ++bj) { gg[bj][0] = *(const f32x4*)(mb + 2048 + col0 + bj * 128); gg[bj][1] = *(const f32x4*)(mb + 2048 + col0 + bj * 128 + 4); }
          f32x4 nb[2][2];
          { const float* bp = base + (size_t)(u.pm * 256 + wr * 64 + fr) * DM + col0;
#pragma unroll
            for (int bj = 0; bj < 2; ++bj) { nb[bj][0] = __builtin_nontemporal_load((const f32x4*)(bp + bj * 128)); nb[bj][1] = __builtin_nontemporal_load((const f32x4*)(bp + bj * 128 + 4)); } }
#pragma unroll
          for (int k = 0; k < 8; ++k) { const int ai = k >> 2, m = k & 3, r = ai * 128 + wr * 64 + m * 16 + fr; float s = 0.f;
              f32x4 cb[2][2];
#pragma unroll
              for (int bj = 0; bj < 2; ++bj) { cb[bj][0] = nb[bj][0]; cb[bj][1] = nb[bj][1]; }
              if (k < 7) { const int k2 = k + 1; const float* bp = base + (size_t)(u.pm * 256 + (k2 >> 2) * 128 + wr * 64 + (k2 & 3) * 16 + fr) * DM + col0;
#pragma unroll
                  for (int bj = 0; bj < 2; ++bj) { nb[bj][0] = __builtin_nontemporal_load((const f32x4*)(bp + bj * 128)); nb[bj][1] = __builtin_nontemporal_load((const f32x4*)(bp + bj * 128 + 4)); } }
#pragma unroll
              for (int bj = 0; bj < 2; ++bj) { const f32x4 x0 = cb[bj][0] + gg[bj][0] * acc[ai][bj][m][0], x1 = cb[bj][1] + gg[bj][1] * acc[ai][bj][m][1];
                  acc[ai][bj][m][0] = x0; acc[ai][bj][m][1] = x1;
                  s += ((x0[0] * x0[0] + x0[1] * x0[1]) + (x0[2] * x0[2] + x0[3] * x0[3])) + ((x1[0] * x1[0] + x1[1] * x1[1]) + (x1[2] * x1[2] + x1[3] * x1[3])); }
              s += __shfl_xor(s, 16); s += __shfl_xor(s, 32);
              if (fq == 0) P[r * 4 + wc] = s;
              asm volatile("" ::: "memory"); } }
        st.run(u, lds, wid, lane);
        const LAS float* S = (const LAS float*)(lds + 4096);
#pragma unroll
        for (int bj = 0; bj < 2; ++bj) { const int col = col0 + bj * 128;
            f32x4 g2[2], s2[2];
#pragma unroll
            for (int n = 0; n < 2; ++n) { g2[n] = *(const f32x4*)(nw + col + 4 * n) * (*(const f32x4*)(mb + 4096 + col + 4 * n) + 1.0f); s2[n] = *(const f32x4*)(mb + 3072 + col + 4 * n); }
#pragma unroll
            for (int ai = 0; ai < 2; ++ai)
#pragma unroll
                for (int m = 0; m < 4; ++m) { const int r = ai * 128 + wr * 64 + m * 16 + fr; const float rstd = S[r]; const size_t off = (size_t)(u.pm * 256 + r) * DM + col;
                    { u32x4 xw; xw.x = pk2(acc[ai][bj][m][0][0], acc[ai][bj][m][0][1]); xw.y = pk2(acc[ai][bj][m][0][2], acc[ai][bj][m][0][3]); xw.z = pk2(acc[ai][bj][m][1][0], acc[ai][bj][m][1][1]); xw.w = pk2(acc[ai][bj][m][1][2], acc[ai][bj][m][1][3]);
                      *(u32x4*)(x1b + off) = xw; }
                    const f32x4 y0 = acc[ai][bj][m][0] * rstd * g2[0] + s2[0], y1 = acc[ai][bj][m][1] * rstd * g2[1] + s2[1];
                    u32x4 w; w.x = pk2(y0[0], y0[1]); w.y = pk2(y0[2], y0[3]); w.z = pk2(y1[0], y1[1]); w.w = pk2(y1[2], y1[3]);
                    *(u32x4*)(hn + off) = w; } }
    }
};
struct EpiResFinal {
    static constexpr bool PERM = true, AFTER_DRAIN = true, MIDHOOK = false;
    const bf16_t* x1b; float* out; const float* mod; const float* fw; RmsPanel st;
    __device__ __forceinline__ void fused(f32x4 (&acc)[2][2][4][2], const pg8::Unit& u, int wr, int wc, int fr, int fq, LAS unsigned char* lds, int wid, int lane) const {
        const int col0 = u.pn * 256 + wc * 32 + 8 * fq, b = (u.pm * 256) >> 12; const float* mb = mod + (size_t)b * 6144;
        { LAS float* P = (LAS float*)lds;
          f32x4 gg[2][2];
#pragma unroll
          for (int bj = 0; bj < 2; ++bj) { gg[bj][0] = *(const f32x4*)(mb + 5120 + col0 + bj * 128); gg[bj][1] = *(const f32x4*)(mb + 5120 + col0 + bj * 128 + 4); }
          u32x4 nb[2];
          { const bf16_t* bp = x1b + (size_t)(u.pm * 256 + wr * 64 + fr) * DM + col0;
#pragma unroll
            for (int bj = 0; bj < 2; ++bj) nb[bj] = __builtin_nontemporal_load((const u32x4*)(bp + bj * 128)); }
#pragma unroll
          for (int k = 0; k < 8; ++k) { const int ai = k >> 2, m = k & 3, r = ai * 128 + wr * 64 + m * 16 + fr; float s = 0.f;
              f32x4 cb[2][2];
#pragma unroll
              for (int bj = 0; bj < 2; ++bj) { cb[bj][0] = (f32x4){lo16(nb[bj].x), hi16(nb[bj].x), lo16(nb[bj].y), hi16(nb[bj].y)}; cb[bj][1] = (f32x4){lo16(nb[bj].z), hi16(nb[bj].z), lo16(nb[bj].w), hi16(nb[bj].w)}; }
              if (k < 7) { const int k2 = k + 1; const bf16_t* bp = x1b + (size_t)(u.pm * 256 + (k2 >> 2) * 128 + wr * 64 + (k2 & 3) * 16 + fr) * DM + col0;
#pragma unroll
                  for (int bj = 0; bj < 2; ++bj) nb[bj] = __builtin_nontemporal_load((const u32x4*)(bp + bj * 128)); }
#pragma unroll
              for (int bj = 0; bj < 2; ++bj) { const f32x4 x0 = cb[bj][0] + gg[bj][0] * acc[ai][bj][m][0], x1 = cb[bj][1] + gg[bj][1] * acc[ai][bj][m][1];
                  acc[ai][bj][m][0] = x0; acc[ai][bj][m][1] = x1;
                  s += ((x0[0] * x0[0] + x0[1] * x0[1]) + (x0[2] * x0[2] + x0[3] * x0[3])) + ((x1[0] * x1[0] + x1[1] * x1[1]) + (x1[2] * x1[2] + x1[3] * x1[3])); }
              s += __shfl_xor(s, 16); s += __shfl_xor(s, 32);
              if (fq == 0) P[r * 4 + wc] = s;
              asm volatile("" ::: "memory"); } }
        st.run(u, lds, wid, lane);
        const LAS float* S = (const LAS float*)(lds + 4096);
#pragma unroll
        for (int bj = 0; bj < 2; ++bj) { const int col = col0 + bj * 128; const f32x4 w0 = *(const f32x4*)(fw + col), w1 = *(const f32x4*)(fw + col + 4);
#pragma unroll
            for (int ai = 0; ai < 2; ++ai)
#pragma unroll
                for (int m = 0; m < 4; ++m) { const int r = ai * 128 + wr * 64 + m * 16 + fr; const float rstd = S[r]; const size_t off = (size_t)(u.pm * 256 + r) * DM + col;
                    __builtin_nontemporal_store(acc[ai][bj][m][0] * rstd * w0, (f32x4*)(out + off)); __builtin_nontemporal_store(acc[ai][bj][m][1] * rstd * w1, (f32x4*)(out + off + 4)); } }
    }
};

__device__ __forceinline__ void transpose_item(const float* W, int ldw, int col0, int K, bf16_t* WT, int drow0, int k0, int n0, LAS float* scr, int lane, int perm = 0, int d0 = 0) {
#pragma unroll 8
    for (int i = 0; i < 32; ++i) { const int kk = 2 * i + (lane >> 5); scr[kk * 33 + (lane & 31)] = __builtin_nontemporal_load(&W[(size_t)(k0 + kk) * ldw + col0 + n0 + (lane & 31)]); }
    asm volatile("s_waitcnt lgkmcnt(0)" ::: "memory");
    const int c = lane & 7;
#pragma unroll
    for (int j = 0; j < 4; ++j) { const int n = (lane >> 3) + 8 * j; const LAS float* s = scr + (8 * c) * 33 + n;
        u32x4 o; o.x = pk2(s[0 * 33], s[1 * 33]); o.y = pk2(s[2 * 33], s[3 * 33]); o.z = pk2(s[4 * 33], s[5 * 33]); o.w = pk2(s[6 * 33], s[7 * 33]);
        const int drow = perm ? (drow0 + 8 * (n >> 2) + (n & 3) + (d0 ? 4 : 0)) : (drow0 + n);
        *(u32x4*)(WT + (size_t)drow * K + k0 + 8 * c) = o; }
    asm volatile("s_waitcnt lgkmcnt(0)" ::: "memory");
}

__device__ __forceinline__ void phase0_transposes(const Ctx& X, KArgs a, int it0, int it1, int gw, int ngw) {
    unsigned char* ws = a->ws;
    LAS float* scr = (LAS float*)(X.lds + X.wave * 16384);
    constexpr int I1 = 16 * 96, I2 = 16 * 72, I3 = 16 * 64, I4 = 16 * 32, I5 = 4 * 32, I6 = 16 * 32, I7 = 16 * 176, I8 = 44 * 32;
    constexpr int NITEMS = I1 + I2 + I3 + I4 + I5 + I6 + I7 + I8;
    for (int it = it0 + gw; it < (it1 < 0 ? NITEMS : it1); it += ngw) {
        int r = it;
        if (r < I1) { const int nb = r % 96, kb = r / 96; transpose_item(a->w_in, DIN, 0, DM, (bf16_t*)(ws + WS_WMAIN), nb * 32, kb * 64, nb * 32, scr, X.lane); continue; } r -= I1;
        if (r < I2) { const int nb = r % 72, kb = r / 72; const bool rot = nb < 48;
            transpose_item(a->w_in, DIN, 3088, DM, (bf16_t*)(ws + WS_WMAIN), rot ? 3072 + (nb >> 1) * 64 : 3072 + nb * 32, kb * 64, nb * 32, scr, X.lane, rot ? 1 : 0, (nb & 1) * 32); continue; } r -= I2;
        if (r < I3) { const int nb = r % 64, kb = r / 64; transpose_item(a->w_in, DIN, 5392, DM, (bf16_t*)(ws + WS_WMAB), nb * 32, kb * 64, nb * 32, scr, X.lane); continue; } r -= I3;
        if (r < I4) { const int nb = r % 32, kb = r / 32; transpose_item(a->w_gla, DM, 0, 1280, (bf16_t*)(ws + WS_WG) + 256, nb * 32, kb * 64, nb * 32, scr, X.lane); continue; } r -= I4;
        if (r < I5) { const int nb = r % 32, kb = r / 32; transpose_item(a->w_attn, DM, 0, 1280, (bf16_t*)(ws + WS_WG), nb * 32, kb * 64, nb * 32, scr, X.lane); continue; } r -= I5;
        if (r < I6) { const int nb = r % 32, kb = r / 32; transpose_item(a->w_out, DM, 0, DM, (bf16_t*)(ws + WS_WOUT), nb * 32, kb * 64, nb * 32, scr, X.lane); continue; } r -= I6;
        if (r < I7) { const int nb = r % 176, kb = r / 176; const int n0 = nb * 32; const int ch = n0 % DFF; const int drow = (ch / 128) * 256 + (n0 >= DFF ? 128 : 0) + (ch % 128);
            transpose_item(a->w_up, NUP, 0, DM, (bf16_t*)(ws + WS_WUP), drow, kb * 64, n0, scr, X.lane); continue; } r -= I7;
        { const int nb = r % 32, kb = r / 32; transpose_item(a->w_down, DM, 0, DFF, (bf16_t*)(ws + WS_WDOWN), nb * 32, kb * 64, nb * 32, scr, X.lane); }
    }
}

__device__ __forceinline__ void phase0(const Ctx& X, KArgs a) {
    unsigned char* ws = a->ws;
    { bf16_t* wlr = (bf16_t*)(ws + WS_WLR);
      for (int idx = X.gtid; idx < 16 * DM; idx += X.nthr) { const int j = idx >> 10, k = idx & 1023; wlr[idx] = (bf16_t)f2bf(a->w_in[(size_t)k * DIN + 3072 + j]); } }
    { float* modp = (float*)(ws + WS_MODP);
      for (int u = X.gw; u < 96 * 32; u += X.ngw) { const int cgp = u % 96, kc = u / 96, j = cgp * 64 + X.lane;
          float w[32];
#pragma unroll
          for (int kk = 0; kk < 32; ++kk) w[kk] = __builtin_nontemporal_load(&a->ada_w[(size_t)(kc * 32 + kk) * 6144 + j]);
          const float cA = a->c[(X.lane >> 5) * DM + kc * 32 + (X.lane & 31)], cB = a->c[((X.lane >> 5) + 2) * DM + kc * 32 + (X.lane & 31)];
          const int sA = __float_as_int(cA / (1.0f + __expf(-cA))), sB = __float_as_int(cB / (1.0f + __expf(-cB)));
          float acc[4] = {0.f, 0.f, 0.f, 0.f};
#pragma unroll
          for (int kk = 0; kk < 32; ++kk) {
              acc[0] += __int_as_float(__builtin_amdgcn_readlane(sA, kk)) * w[kk]; acc[1] += __int_as_float(__builtin_amdgcn_readlane(sA, 32 + kk)) * w[kk];
              acc[2] += __int_as_float(__builtin_amdgcn_readlane(sB, kk)) * w[kk]; acc[3] += __int_as_float(__builtin_amdgcn_readlane(sB, 32 + kk)) * w[kk]; }
#pragma unroll
          for (int b = 0; b < 4; ++b) modp[(size_t)(kc * 4 + b) * 6144 + j] = acc[b]; } }
    { f32x2* rope = (f32x2*)(ws + WS_ROPE);
      for (int idx = X.gtid; idx < NT * 32; idx += X.nthr) { const int t = idx >> 5, i = idx & 31;
          const double rev = (double)a->positions[t] * INVF_REV[i]; const float fr = (float)(rev - floor(rev));
          rope[idx] = (f32x2){__builtin_amdgcn_cosf(fr), __builtin_amdgcn_sinf(fr)}; } }
}

template <int MODE> __device__ __forceinline__ void norm_pass(const Ctx& X, KArgs a, const float* xin, bf16_t* hout, float* fout) {
    unsigned char* ws = a->ws;
    const float* modp = (const float*)(ws + WS_MODP); float* mod = (float*)(ws + WS_MOD);
    if (MODE == 0) { for (int idx = X.gtid; idx < 4 * 6144; idx += X.nthr) { const int b = idx / 6144, j = idx % 6144; float s = a->ada_b[j];
            float pv[32];
#pragma unroll
            for (int kc = 0; kc < 32; ++kc) pv[kc] = modp[(size_t)(kc * 4 + b) * 6144 + j];
#pragma unroll
            for (int kc = 0; kc < 32; ++kc) s += pv[kc];
            mod[idx] = s; } }
    LAS float* gs = (LAS float*)X.lds;
    LAS bf16_t* hs = (LAS bf16_t*)(X.lds + 8192);
    for (int rt = blockIdx.x; rt < NT / 64; rt += gridDim.x) {
        const int row0 = rt * 64, b = row0 >> 12;
        __syncthreads();
        for (int idx = X.tid; idx < DM; idx += 512) {
            float g, s;
            if (MODE == 0) { float sc = a->ada_b[1024 + idx], sh = a->ada_b[idx];
                float pa[32], pb[32];
#pragma unroll
                for (int kc = 0; kc < 32; ++kc) { pa[kc] = modp[(size_t)(kc * 4 + b) * 6144 + 1024 + idx]; pb[kc] = modp[(size_t)(kc * 4 + b) * 6144 + idx]; }
#pragma unroll
                for (int kc = 0; kc < 32; ++kc) { sc += pa[kc]; sh += pb[kc]; }
                g = a->norm1_w[idx] * (1.0f + sc); s = sh; }
            else if (MODE == 1) { g = a->norm2_w[idx] * (1.0f + mod[b * 6144 + 4096 + idx]); s = mod[b * 6144 + 3072 + idx]; }
            else { g = a->final_w[idx]; s = 0.f; }
            gs[idx] = g; gs[1024 + idx] = s;
        }
        __syncthreads();
#pragma unroll 1
        for (int rb = 0; rb < 8; rb += 4) {
            f32x4 v[4][4];
#pragma unroll
            for (int r = 0; r < 4; ++r) { const f32x4* xr = (const f32x4*)(xin + (size_t)(row0 + X.wave * 8 + rb + r) * DM) + X.lane;
#pragma unroll
                for (int j = 0; j < 4; ++j) v[r][j] = __builtin_nontemporal_load(xr + 64 * j); }
#pragma unroll
            for (int r = 0; r < 4; ++r) {
                const int lr = X.wave * 8 + rb + r, row = row0 + lr;
                float ss = 0.f;
#pragma unroll
                for (int j = 0; j < 4; ++j) ss += (v[r][j][0] * v[r][j][0] + v[r][j][1] * v[r][j][1]) + (v[r][j][2] * v[r][j][2] + v[r][j][3] * v[r][j][3]);
                const float rstd = 1.0f / sqrtf(wave_sum(ss) * (1.0f / DM) + EPS);
#pragma unroll
                for (int j = 0; j < 4; ++j) { const int k = 4 * X.lane + 256 * j;
                    const f32x4 g = *(const LAS f32x4*)(gs + k), sft = *(const LAS f32x4*)(gs + 1024 + k);
                    const f32x4 y = v[r][j] * rstd * g + sft;
                    if (MODE == 2) { *((f32x4*)(fout + (size_t)row * DM) + X.lane + 64 * j) = y; }
                    else { u32x2 w; w.x = pk2(y[0], y[1]); w.y = pk2(y[2], y[3]);
                        *(u32x2*)(hout + (size_t)row * DM + k) = w;
                        if (MODE == 0) *(LAS u32x2*)(hs + lr * 1032 + k) = w; } }
            }
        }
        if (MODE == 0) {
            __syncthreads();
            const bf16_t* wlr = (const bf16_t*)(ws + WS_WLR);
            const int mt = X.wave & 3, kh = X.wave >> 2, fr = X.lane & 15, fq = X.lane >> 4;
            f32x4 acc = {0.f, 0.f, 0.f, 0.f};
#pragma unroll 4
            for (int ks = 0; ks < 16; ++ks) { const int k0 = kh * 512 + ks * 32 + 8 * fq;
                const bf16x8 av = *(const LAS bf16x8*)(hs + (16 * mt + fr) * 1032 + k0);
                const bf16x8 bv = *(const bf16x8*)(wlr + fr * 1024 + k0);
                acc = __builtin_amdgcn_mfma_f32_16x16x32_bf16(av, bv, acc, 0, 0, 0); }
            LAS f32x4* red = (LAS f32x4*)X.lds;
            if (kh == 1) red[mt * 64 + X.lane] = acc;
            __syncthreads();
            if (kh == 0) { const f32x4 o = acc + red[mt * 64 + X.lane]; float* glr = (float*)(ws + WS_GLR);
#pragma unroll
                for (int e = 0; e < 4; ++e) glr[(size_t)(row0 + 16 * mt + 4 * fq + e) * 16 + fr] = o[e]; }
        }
    }
}

constexpr int QP = 72, VP = 264;
__device__ __forceinline__ void attn_mfma(const Ctx& X, KArgs a, int dry = 0) {
    bf16_t* proj = (bf16_t*)(a->ws + WS_BIG); const f32x2* rope = (const f32x2*)(a->ws + WS_ROPE); float* lse = (float*)(a->ws + WS_LSE);
    LAS bf16_t* Qs = (LAS bf16_t*)X.lds; LAS bf16_t* Ks = (LAS bf16_t*)(X.lds + 128 * QP * 2); LAS bf16_t* Vt = (LAS bf16_t*)(X.lds + 384 * QP * 2);
    const int fr = X.lane & 15, fq = X.lane >> 4, w = X.wave, i0 = 16 * w;
    const int per = (1536 + (int)gridDim.x - 1) / (int)gridDim.x, u0 = (int)blockIdx.x * per, u1 = (u0 + per < 1536) ? u0 + per : 1536;
    int cur_half = 1;
    for (int unit = u0; unit < u1; ++unit) {
        const int b = unit / 384, rem = unit % 384, h = rem >> 5, pn = rem & 31, g = h >> 2, hg = h & 3;
        const int r = (g == 0) ? 1 : (g == 1 ? 4 : 16), nblk = 32 / r, p = pn / nblk, n = pn % nblk;
        const int tb = b * SEQ + p;
        const bool reuse = (unit > u0) && (n >= 1);
        if (reuse) cur_half ^= 1;
        const int prev_half = cur_half ^ 1;
        __syncthreads();
        { const int i = X.tid >> 2, c = X.tid & 3; const int t = tb + (128 * n + i) * r; const bf16_t* src = proj + (size_t)t * NMAIN + C_AQ + h * 64 + 16 * c;
          *(LAS u32x4*)(Qs + i * QP + 16 * c) = *(const u32x4*)src; *(LAS u32x4*)(Qs + i * QP + 16 * c + 8) = *(const u32x4*)(src + 8); }
        for (int blk = reuse ? 1 : 0; blk < 2; ++blk) {
            const int half = blk ? cur_half : prev_half;
            { const int j = X.tid >> 2, c = X.tid & 3; int m = 128 * (n - 1 + blk) + j; m = m < 0 ? 0 : m; const int t = tb + m * r;
              const bf16_t* src = proj + (size_t)t * NMAIN + C_AK + h * 64 + 16 * c;
              *(LAS u32x4*)(Ks + (half * 128 + j) * QP + 16 * c) = *(const u32x4*)src; *(LAS u32x4*)(Ks + (half * 128 + j) * QP + 16 * c + 8) = *(const u32x4*)(src + 8); }
#pragma unroll
            for (int q = 0; q < 2; ++q) { const int idx = X.tid + 512 * q, j = idx & 127, c = idx >> 7; int m = 128 * (n - 1 + blk) + j; m = m < 0 ? 0 : m; const int t = tb + m * r;
                const u32x4 wv = *(const u32x4*)(proj + (size_t)t * NMAIN + C_AV + h * 64 + 8 * c);
                LAS bf16_t* vp = Vt + (8 * c) * VP + half * 128 + j;
                vp[0 * VP] = (bf16_t)(wv.x & 0xffff); vp[1 * VP] = (bf16_t)(wv.x >> 16); vp[2 * VP] = (bf16_t)(wv.y & 0xffff); vp[3 * VP] = (bf16_t)(wv.y >> 16);
                vp[4 * VP] = (bf16_t)(wv.z & 0xffff); vp[5 * VP] = (bf16_t)(wv.z >> 16); vp[6 * VP] = (bf16_t)(wv.w & 0xffff); vp[7 * VP] = (bf16_t)(wv.w >> 16); }
        }
        __syncthreads();
#define KOFF(t_) ((((t_) >> 3) ? cur_half : prev_half) * 128 + 16 * ((t_) & 7))
        bf16x8 bq[2];
#pragma unroll
        for (int ks = 0; ks < 2; ++ks) bq[ks] = *(const LAS bf16x8*)(Qs + (i0 + fr) * QP + 32 * ks + 8 * fq);
        f32x4 sc[9];
#pragma unroll
        for (int q = 0; q < 9; ++q) { sc[q] = (f32x4){0.f, 0.f, 0.f, 0.f};
#pragma unroll
            for (int ks = 0; ks < 2; ++ks) { const bf16x8 ak = *(const LAS bf16x8*)(Ks + (KOFF(w + q) + fr) * QP + 32 * ks + 8 * fq); sc[q] = __builtin_amdgcn_mfma_f32_16x16x32_bf16(ak, bq[ks], sc[q], 0, 0, 0); } }
        const int iq = i0 + fr;
        float mx = -INFINITY;
#pragma unroll
        for (int q = 0; q < 9; ++q) { const bool tile_ok = (n > 0) || (w + q >= 8);
#pragma unroll
            for (int e = 0; e < 4; ++e) { bool valid = tile_ok;
                if (q == 0) valid = valid && (4 * fq + e >= fr);
                if (q == 8) valid = valid && (4 * fq + e <= fr);
                sc[q][e] = valid ? sc[q][e] : -INFINITY; mx = fmaxf(mx, sc[q][e]); } }
        mx = fmaxf(mx, __shfl_xor(mx, 16)); mx = fmaxf(mx, __shfl_xor(mx, 32));
        float l = 0.f;
#pragma unroll
        for (int q = 0; q < 9; ++q)
#pragma unroll
            for (int e = 0; e < 4; ++e) { sc[q][e] = __builtin_amdgcn_exp2f(sc[q][e] - mx); l += sc[q][e]; }
        l += __shfl_xor(l, 16); l += __shfl_xor(l, 32);
        f32x4 o[4];
#pragma unroll
        for (int dt = 0; dt < 4; ++dt) o[dt] = (f32x4){0.f, 0.f, 0.f, 0.f};
#pragma unroll
        for (int c = 0; c < 5; ++c) { const int jtA = w + 2 * c; int jtB = w + 2 * c + 1; jtB = jtB > 15 ? 15 : jtB;
            const f32x4 pa = sc[2 * c]; const f32x4 pb = (2 * c + 1 <= 8) ? sc[(2 * c + 1 <= 8) ? 2 * c + 1 : 8] : (f32x4){0.f, 0.f, 0.f, 0.f};
            u32x4 pw; pw.x = pk2(pa[0], pa[1]); pw.y = pk2(pa[2], pa[3]); pw.z = pk2(pb[0], pb[1]); pw.w = pk2(pb[2], pb[3]);
            const bf16x8 bfrag = __builtin_bit_cast(bf16x8, pw);
#pragma unroll
            for (int dt = 0; dt < 4; ++dt) { const LAS bf16_t* vr = Vt + (16 * dt + fr) * VP + 4 * fq;
                const u32x2 lo = *(const LAS u32x2*)(vr + KOFF(jtA)), hi = *(const LAS u32x2*)(vr + KOFF(jtB)); const u32x4 av = {lo.x, lo.y, hi.x, hi.y};
                o[dt] = __builtin_amdgcn_mfma_f32_16x16x32_bf16(__builtin_bit_cast(bf16x8, av), bfrag, o[dt], 0, 0, 0); } }
        const float il = 1.0f / l; const int tq = tb + (128 * n + iq) * r;
        bf16_t* op = (dry ? proj + (size_t)NT * NMAIN + (size_t)(tq & 63) * NMAIN : proj + (size_t)tq * NMAIN) + C_AQ + h * 64 + 4 * fq;
#pragma unroll
        for (int dt = 0; dt < 4; ++dt) { u32x2 wv; wv.x = pk2(o[dt][0] * il, o[dt][1] * il); wv.y = pk2(o[dt][2] * il, o[dt][3] * il); *(u32x2*)(op + 16 * dt) = wv; }
        if (fq == 0) lse[((size_t)g * NT + tq) * 4 + hg] = mx * 0.6931471805599453f + __logf(l);
    }
}
#undef KOFF

__device__ __forceinline__ void attn_combine(const Ctx& X, KArgs a) {
    bf16_t* proj = (bf16_t*)(a->ws + WS_BIG); const float* lse = (const float*)(a->ws + WS_LSE);
    for (int base = X.gtid; base < NT * 32; base += 4 * X.nthr) {
        u32x4 o0[4], o1[4], o2[4]; float l0[4], l1[4], l2[4];
#pragma unroll
        for (int q = 0; q < 4; ++q) { const int idx = base + q * X.nthr; if (idx < NT * 32) { const int t = idx >> 5, c8 = (idx & 31) * 8, hg = c8 >> 6;
            l0[q] = lse[((size_t)0 * NT + t) * 4 + hg]; l1[q] = lse[((size_t)1 * NT + t) * 4 + hg]; l2[q] = lse[((size_t)2 * NT + t) * 4 + hg];
            const bf16_t* p = proj + (size_t)t * NMAIN + C_AQ + c8; o0[q] = *(const u32x4*)p; o1[q] = *(const u32x4*)(p + 256); o2[q] = *(const u32x4*)(p + 512); } }
#pragma unroll
        for (int q = 0; q < 4; ++q) { const int idx = base + q * X.nthr; if (idx < NT * 32) { const int t = idx >> 5, c8 = (idx & 31) * 8;
            const float mx = fmaxf(l0[q], fmaxf(l1[q], l2[q])); float w0 = __expf(l0[q] - mx), w1 = __expf(l1[q] - mx), w2 = __expf(l2[q] - mx); const float inv = 1.0f / (w0 + w1 + w2); w0 *= inv; w1 *= inv; w2 *= inv;
            float f0[8], f1[8], f2[8], o[8]; unpack8(o0[q], f0); unpack8(o1[q], f1); unpack8(o2[q], f2);
#pragma unroll
            for (int e = 0; e < 8; ++e) o[e] = w0 * f0[e] + w1 * f1[e] + w2 * f2[e];
            *(u32x4*)(proj + (size_t)t * NMAIN + C_AQ + c8) = pack8(o); } }
    }
}

constexpr int GP = 136;
__device__ __forceinline__ void gla_bcum(KArgs a, int tid, int t0, int h, LAS float* segtot, LAS float* glrs, float (&bc)[32], float& tot) {
    const int d = tid & 127, seg = __builtin_amdgcn_readfirstlane(tid >> 7), col = h * 128 + d;
    const float* glr = (const float*)(a->ws + WS_GLR);
    float w2r[16];
#pragma unroll
    for (int j = 0; j < 16; ++j) w2r[j] = a->gate_w2[j * 512 + col];
    const float bias = a->gate_b[col];
    *(LAS f32x4*)(glrs + tid * 4) = *(const f32x4*)(glr + (size_t)t0 * 16 + tid * 4);
    __syncthreads();
    float run = 0.f;
#pragma unroll
    for (int r = 0; r < 32; ++r) { const LAS f32x4* gp = (const LAS f32x4*)(glrs + (seg * 32 + r) * 16);
        float z = bias;
#pragma unroll
        for (int q = 0; q < 4; ++q) { const f32x4 g = gp[q]; z += g[0] * w2r[4 * q] + g[1] * w2r[4 * q + 1] + g[2] * w2r[4 * q + 2] + g[3] * w2r[4 * q + 3]; }
        const float la = (fminf(z, 0.f) - __logf(1.0f + __expf(-fabsf(z)))) * (1.0f / 16.0f);
        run += la; bc[r] = run; }
    segtot[seg * 128 + d] = run;
    __syncthreads();
    float off = 0.f; tot = 0.f;
#pragma unroll
    for (int s2 = 0; s2 < 4; ++s2) { const float v = segtot[s2 * 128 + d]; tot += v; if (s2 < seg) off += v; }
#pragma unroll
    for (int r = 0; r < 32; ++r) bc[r] += off;
}
__device__ __forceinline__ void gla_stage_vT(const bf16_t* proj, int tid, int t0, int h, LAS bf16_t* vT) {
#pragma unroll
    for (int q = 0; q < 8; ++q) { const int i = tid >> 2, c = (tid & 3) + 4 * q;
        const u32x4 wv = *(const u32x4*)(proj + (size_t)(t0 + i) * NMAIN + C_GV + h * 256 + 8 * c);
        LAS bf16_t* vp = vT + (8 * c) * GP + i;
        vp[0 * GP] = (bf16_t)(wv.x & 0xffff); vp[1 * GP] = (bf16_t)(wv.x >> 16); vp[2 * GP] = (bf16_t)(wv.y & 0xffff); vp[3 * GP] = (bf16_t)(wv.y >> 16);
        vp[4 * GP] = (bf16_t)(wv.z & 0xffff); vp[5 * GP] = (bf16_t)(wv.z >> 16); vp[6 * GP] = (bf16_t)(wv.w & 0xffff); vp[7 * GP] = (bf16_t)(wv.w >> 16); }
}
__device__ __forceinline__ void gla_a1(const Ctx& X, KArgs a, float* kvt, float* decb) {
    const bf16_t* proj = (const bf16_t*)(a->ws + WS_BIG);
    LAS bf16_t* kdT = (LAS bf16_t*)X.lds; LAS bf16_t* vT = (LAS bf16_t*)(X.lds + 128 * GP * 2); LAS float* segtot = (LAS float*)(X.lds + 384 * GP * 2);
    const int fr = X.lane & 15, fq = X.lane >> 4, w = X.wave;
    for (int unit = blockIdx.x; unit < 512; unit += gridDim.x) {
        const int bh = unit >> 5, n = unit & 31, b = bh >> 2, h = bh & 3, t0 = b * SEQ + n * 128;
        __syncthreads();
        float bc[32], tot; gla_bcum(a, X.tid, t0, h, segtot, (LAS float*)vT, bc, tot);
        { const int d = X.tid & 127, seg = X.tid >> 7;
#pragma unroll
          for (int r8 = 0; r8 < 4; ++r8) { float kd[8];
#pragma unroll
              for (int e = 0; e < 8; ++e) { const int r = r8 * 8 + e; kd[e] = bf2f(proj[(size_t)(t0 + seg * 32 + r) * NMAIN + C_GK + h * 128 + d]) * __expf(tot - bc[r]); }
              *(LAS u32x4*)(kdT + d * GP + seg * 32 + r8 * 8) = pack8(kd); }
          if (seg == 0) decb[unit * 128 + d] = __expf(tot); }
        gla_stage_vT(proj, X.tid, t0, h, vT);
        __syncthreads();
        f32x4 acc[8][2];
#pragma unroll
        for (int mt = 0; mt < 8; ++mt) { acc[mt][0] = (f32x4){0.f, 0.f, 0.f, 0.f}; acc[mt][1] = (f32x4){0.f, 0.f, 0.f, 0.f}; }
#pragma unroll
        for (int ks = 0; ks < 4; ++ks) {
            bf16x8 bfr[2];
#pragma unroll
            for (int nt = 0; nt < 2; ++nt) bfr[nt] = *(const LAS bf16x8*)(vT + (32 * w + 16 * nt + fr) * GP + 32 * ks + 8 * fq);
#pragma unroll
            for (int mt = 0; mt < 8; ++mt) { const bf16x8 af = *(const LAS bf16x8*)(kdT + (16 * mt + fr) * GP + 32 * ks + 8 * fq);
#pragma unroll
                for (int nt = 0; nt < 2; ++nt) acc[mt][nt] = __builtin_amdgcn_mfma_f32_16x16x32_bf16(af, bfr[nt], acc[mt][nt], 0, 0, 0); }
        }
        bf16_t* ko = (bf16_t*)kvt + (size_t)unit * 32768;
#pragma unroll
        for (int mt = 0; mt < 8; ++mt)
#pragma unroll
            for (int nt = 0; nt < 2; ++nt) { u32x2 wv; wv.x = pk2(acc[mt][nt][0], acc[mt][nt][1]); wv.y = pk2(acc[mt][nt][2], acc[mt][nt][3]);
                *(u32x2*)(ko + (32 * w + 16 * nt + fr) * 128 + 16 * mt + 4 * fq) = wv; }
    }
}
__device__ __forceinline__ void gla_a2(const Ctx& X, KArgs a, float* kvt, const float* decb, int dry = 0) {
    u32x2* kb = (u32x2*)kvt;
    for (int gid = X.gtid; gid < 131072; gid += X.nthr) {
        const int bh = gid >> 13, e4 = gid & 8191, d4 = (e4 & 31) * 4;
        f32x4 S = {0.f, 0.f, 0.f, 0.f};
        u32x2 kv[32];
#pragma unroll
        for (int j = 0; j < 32; ++j) kv[j] = kb[(size_t)(bh * 32 + j) * 8192 + e4];
#pragma unroll
        for (int hb = 0; hb < 2; ++hb) {
            f32x4 dc[16];
#pragma unroll
            for (int j = 0; j < 16; ++j) dc[j] = *(const f32x4*)(decb + (bh * 32 + hb * 16 + j) * 128 + d4);
#pragma unroll
            for (int j = 0; j < 16; ++j) { const int jj = hb * 16 + j, unit = bh * 32 + jj; u32x2 wv; wv.x = pk2(S[0], S[1]); wv.y = pk2(S[2], S[3]);
                if (dry) *((u32x2*)(a->ws + WS_BIG + (size_t)NT * NMAIN * 2) + gid) = wv; else kb[(size_t)unit * 8192 + e4] = wv;
                const f32x4 kf = {lo16(kv[jj].x), hi16(kv[jj].x), lo16(kv[jj].y), hi16(kv[jj].y)}; S = dc[j] * S + kf; }
        }
    }
}
__device__ __forceinline__ void gla_a3(const Ctx& X, KArgs a, const float* kvt, int dry = 0) {
    bf16_t* proj = (bf16_t*)(a->ws + WS_BIG);
    LAS bf16_t* qgs = (LAS bf16_t*)X.lds; LAS bf16_t* kgs = (LAS bf16_t*)(X.lds + 128 * GP * 2); LAS bf16_t* vT = (LAS bf16_t*)(X.lds + 256 * GP * 2); LAS float* segtot = (LAS float*)(X.lds + 512 * GP * 2);
    const int fr = X.lane & 15, fq = X.lane >> 4, w = X.wave, i0 = 16 * w;
    for (int unit = blockIdx.x; unit < 512; unit += gridDim.x) {
        const int bh = unit >> 5, n = unit & 31, b = bh >> 2, h = bh & 3, t0 = b * SEQ + n * 128;
        __syncthreads();
        { float bc[32], tot; gla_bcum(a, X.tid, t0, h, segtot, (LAS float*)vT, bc, tot);
          const int d = X.tid & 127, seg = X.tid >> 7;
#pragma unroll
          for (int r = 0; r < 32; ++r) { const int i = seg * 32 + r; const bf16_t* row = proj + (size_t)(t0 + i) * NMAIN + h * 128 + d;
              const float qv = bf2f(row[C_GQ]), kv = bf2f(row[C_GK]);
              qgs[i * GP + d] = (bf16_t)f2bf(qv * 0.08838834764831845f * __expf(bc[r])); kgs[i * GP + d] = (bf16_t)f2bf(kv * __expf(-bc[r])); } }
        gla_stage_vT(proj, X.tid, t0, h, vT);
        __syncthreads();
        bf16x8 afr[4];
#pragma unroll
        for (int ks = 0; ks < 4; ++ks) afr[ks] = *(const LAS bf16x8*)(qgs + (i0 + fr) * GP + 32 * ks + 8 * fq);
        f32x4 acc[16];
#pragma unroll
        for (int nt = 0; nt < 16; ++nt) acc[nt] = (f32x4){0.f, 0.f, 0.f, 0.f};
        for (int jt = 0; jt <= (w | 1); ++jt) {
            f32x4 att = {0.f, 0.f, 0.f, 0.f};
            if (jt <= w) {
#pragma unroll
                for (int ks = 0; ks < 4; ++ks) { const bf16x8 bf = *(const LAS bf16x8*)(kgs + (16 * jt + fr) * GP + 32 * ks + 8 * fq); att = __builtin_amdgcn_mfma_f32_16x16x32_bf16(afr[ks], bf, att, 0, 0, 0); }
            }
#pragma unroll
            for (int e = 0; e < 4; ++e) { const int i = i0 + 4 * fq + e, j = 16 * jt + fr; qgs[i * GP + j] = (bf16_t)f2bf(j <= i ? att[e] : 0.f); }
        }
        asm volatile("s_waitcnt lgkmcnt(0)" ::: "memory");
        for (int ks = 0; ks <= (w >> 1); ++ks) { const bf16x8 af = *(const LAS bf16x8*)(qgs + (i0 + fr) * GP + 32 * ks + 8 * fq);
#pragma unroll
            for (int nt = 0; nt < 16; ++nt) { const bf16x8 bf = *(const LAS bf16x8*)(vT + (16 * nt + fr) * GP + 32 * ks + 8 * fq); acc[nt] = __builtin_amdgcn_mfma_f32_16x16x32_bf16(af, bf, acc[nt], 0, 0, 0); } }
        if (n > 0) {
            __syncthreads();
            const bf16_t* sb = (const bf16_t*)kvt + (size_t)unit * 32768;
#pragma unroll
            for (int q = 0; q < 8; ++q) { const int sidx = X.tid + 512 * q; const u32x4 wv = *(const u32x4*)(sb + (size_t)sidx * 8);
                *(LAS u32x4*)(vT + (sidx >> 4) * GP + (sidx & 15) * 8) = wv; }
            __syncthreads();
#pragma unroll
            for (int ks = 0; ks < 4; ++ks)
#pragma unroll
                for (int nt = 0; nt < 16; ++nt) { const bf16x8 bf = *(const LAS bf16x8*)(vT + (16 * nt + fr) * GP + 32 * ks + 8 * fq); acc[nt] = __builtin_amdgcn_mfma_f32_16x16x32_bf16(afr[ks], bf, acc[nt], 0, 0, 0); }
        }
        float rs[4];
#pragma unroll
        for (int e = 0; e < 4; ++e) { float s2 = 0.f;
#pragma unroll
            for (int nt = 0; nt < 16; ++nt) s2 += acc[nt][e] * acc[nt][e];
            s2 += __shfl_xor(s2, 1); s2 += __shfl_xor(s2, 2); s2 += __shfl_xor(s2, 4); s2 += __shfl_xor(s2, 8);
            rs[e] = 1.0f / sqrtf(s2 * (1.0f / 256.0f) + EPS); }
        __syncthreads();
        { LAS bf16_t* ost = (LAS bf16_t*)(X.lds + w * 8704);
#pragma unroll
          for (int nt = 0; nt < 16; ++nt) { const float nw = a->gla_norm_w[16 * nt + fr];
#pragma unroll
              for (int e = 0; e < 4; ++e) ost[(4 * fq + e) * 272 + 16 * nt + fr] = (bf16_t)f2bf(acc[nt][e] * rs[e] * nw); }
          asm volatile("s_waitcnt lgkmcnt(0)" ::: "memory");
          const int r = X.lane >> 2, cgp = X.lane & 3;
          bf16_t* orow = proj + (size_t)(t0 + i0 + r) * NMAIN + C_GR + h * 256;
          bf16_t* drow = dry ? proj + (size_t)NT * NMAIN + (size_t)((t0 + i0 + r) & 63) * NMAIN + C_GR + h * 256 : orow;
          u32x4 gv[8];
#pragma unroll
          for (int q = 0; q < 8; ++q) gv[q] = *(const u32x4*)(orow + 8 * (cgp + 4 * q));
#pragma unroll
          for (int q = 0; q < 8; ++q) { const int c = cgp + 4 * q; float v[8], gr[8]; unpack8(*(const LAS u32x4*)(ost + r * 272 + 8 * c), v); unpack8(gv[q], gr);
#pragma unroll
              for (int e = 0; e < 8; ++e) v[e] *= gr[e] * sigmoidf_(gr[e]);
              *(u32x4*)(drow + 8 * c) = pack8(v); } }
    }
}

__global__ void __launch_bounds__(512, 2) fwd_megakernel(Args a_kernarg) {
    extern __shared__ __attribute__((aligned(16))) unsigned char lds_raw[];
    cg::grid_group grid = cg::this_grid();
#define X make_ctx(lds_raw)
    { volatile LAS unsigned* st0 = (volatile LAS unsigned*)((LAS unsigned char*)lds_raw + LDS_BYTES - 64); if (threadIdx.x < 2) st0[threadIdx.x] = 0u; }
    __syncthreads();
    const XcdBarrier xbar = xcd_barrier_post((unsigned*)(kargs()->ws), (volatile LAS unsigned*)((LAS unsigned char*)lds_raw + LDS_BYTES - 64));
#define WSP(T, off) ((T*)(a->ws + (off)))

    phase0(X, kargs());
    if (gridDim.x == 0x7fffffffu) grid.sync();
    xcd_barrier(xbar);
    { KArgs a = kargs(); norm_pass<0>(X, a, a->x, WSP(bf16_t, WS_HBUF), nullptr); }
    __syncthreads();
    phase0_transposes(X, kargs(), 0, 16 * 96 + 16 * 72 + 16 * 64, X.gw, X.ngw);
    xcd_barrier(xbar);
    { KArgs a = kargs(); pg8::Gemm g{WSP(bf16_t, WS_HBUF), WSP(bf16_t, WS_WMAIN), NT, NMAIN, DM, DM, DM}; run_gemm<0>(X, g, FStoreProj{WSP(bf16_t, WS_BIG), WSP(f32x2, WS_ROPE)}); }
    { const int nfull = (gridDim.x > 64) ? 64 : 0;
      if ((int)blockIdx.x >= nfull) phase0_transposes(X, kargs(), 16 * 96 + 16 * 72 + 16 * 64, -1, ((int)blockIdx.x - nfull) * 8 + X.wave, ((int)gridDim.x - nfull) * 8); }
    xcd_barrier(xbar);
#pragma unroll 1
    for (int step = 0; step < 2; ++step) {
        if (((step ^ (int)blockIdx.x) & 1) == 0) { KArgs a = kargs(); gla_a1(X, a, a->out, WSP(float, WS_SSQ)); }
        else attn_mfma(X, kargs());
        __syncthreads();
    }
    xcd_barrier(xbar);
    { KArgs a = kargs(); gla_a2(X, a, a->out, WSP(float, WS_SSQ)); }
    xcd_barrier(xbar);
    if ((blockIdx.x & 1) == 0) { KArgs a = kargs(); pg8::Gemm g{WSP(bf16_t, WS_HBUF), WSP(bf16_t, WS_WMAB), NT, NGATE, DM, DM, DM};
        run_gemm<1>(X, g, FSigmoidSplit{(bf16_t*)a->out + (size_t)NT * DM, WSP(bf16_t, WS_BIG) + C_AK}); }
    __syncthreads();
    { KArgs a = kargs(); gla_a3(X, a, a->out); }
    attn_combine(X, kargs());
    __syncthreads();
    if ((blockIdx.x & 1) != 0) { KArgs a = kargs(); pg8::Gemm g{WSP(bf16_t, WS_HBUF), WSP(bf16_t, WS_WMAB), NT, NGATE, DM, DM, DM};
        run_gemm<1>(X, g, FSigmoidSplit{(bf16_t*)a->out + (size_t)NT * DM, WSP(bf16_t, WS_BIG) + C_AK}); }
    xcd_barrier(xbar);
    { KArgs a = kargs(); pg8::Gemm g{WSP(bf16_t, WS_BIG) + C_GR, WSP(bf16_t, WS_WG), NT, DM, 1280, NMAIN, 1280};
      pg8::StaticOrder S; S.init(NT, DM, (int)gridDim.x, (int)blockIdx.x);
      EpiMixed2 E{(const bf16_t*)a->out + (size_t)NT * DM, WSP(bf16_t, WS_BIG) + C_AK, WSP(bf16_t, WS_HBUF)};
      pg8::gemm_phase<EpiMixed2, true, false, 1>(X.lds, g, S, E); }
    xcd_barrier(xbar);
    { KArgs a = kargs(); pg8::Gemm g{WSP(bf16_t, WS_HBUF), WSP(bf16_t, WS_WOUT), NT, DM, DM, DM, DM};
      pg8::StaticOrder S; S.init(NT, DM, (int)gridDim.x, (int)blockIdx.x);
      EpiResNorm E{a->x, WSP(bf16_t, WS_BIG) + (size_t)48 * 1024 * 1024, WSP(bf16_t, WS_HBUF), WSP(float, WS_MOD), a->norm2_w, RmsPanel{WSP(float, WS_GLR), (unsigned*)(a->ws + 16384)}};
      pg8::gemm_phase<EpiResNorm, false>(X.lds, g, S, E); }
    xcd_barrier(xbar);
    { KArgs a = kargs(); pg8::Gemm g{WSP(bf16_t, WS_HBUF) - 2 * DM, WSP(bf16_t, WS_WUP), NT, NUP, DM, DM, DM};
      pg8::StaticOrder S; S.init_tiles(66, NUP / 256, (int)gridDim.x, (int)blockIdx.x);
      EpiConvGeglu E{WSP(bf16_t, WS_BIG), a->conv_w, a->conv_b};
      pg8::gemm_phase<EpiConvGeglu, true, true>(X.lds, g, S, E); }
    xcd_barrier(xbar);
    { KArgs a = kargs(); pg8::Gemm g{WSP(bf16_t, WS_BIG), WSP(bf16_t, WS_WDOWN), NT, DM, DFF, DFF, DFF};
      pg8::StaticOrder S; S.init(NT, DM, (int)gridDim.x, (int)blockIdx.x);
      EpiResFinal E{WSP(bf16_t, WS_BIG) + (size_t)48 * 1024 * 1024, a->out, WSP(float, WS_MOD), a->final_w, RmsPanel{WSP(float, WS_GLR) + 65536, (unsigned*)(a->ws + 32768)}};
      pg8::gemm_phase<EpiResFinal, false>(X.lds, g, S, E); }
#undef WSP
#undef X
}

extern "C" void kernel_launch(void* const* d_in, const int* in_sizes, int n_in, void* d_out, int out_size, void* d_ws, size_t ws_size, hipStream_t stream) {
    static int grid_blocks = 0;
    if (grid_blocks == 0) {
        if (n_in != 19 || out_size != NT * DM || ws_size < WS_END) { fprintf(stderr, "kernel_launch: unexpected sizes (n_in %d out %d ws %zu)\n", n_in, out_size, ws_size); grid_blocks = -1; return; }
        int dev = 0, cus = 0, per_cu = 0;
        hipGetDevice(&dev); hipDeviceGetAttribute(&cus, hipDeviceAttributeMultiprocessorCount, dev);
        hipFuncSetAttribute((const void*)fwd_megakernel, hipFuncAttributeMaxDynamicSharedMemorySize, LDS_BYTES);
        hipOccupancyMaxActiveBlocksPerMultiprocessor(&per_cu, (const void*)fwd_megakernel, 512, LDS_BYTES);
        if (per_cu < 1) { fprintf(stderr, "kernel_launch: occupancy query says %d blocks per CU\n", per_cu); per_cu = 1; }
        if (per_cu > 1) per_cu = 1;
        grid_blocks = cus * per_cu;
        (void)hipGetLastError();
    }
    if (grid_blocks < 0) return;
    Args a{};
    a.x = (const float*)d_in[0]; a.c = (const float*)d_in[1]; a.positions = (const int*)d_in[2]; a.ada_w = (const float*)d_in[3]; a.ada_b = (const float*)d_in[4];
    a.norm1_w = (const float*)d_in[5]; a.w_in = (const float*)d_in[6]; a.gate_w2 = (const float*)d_in[7]; a.gate_b = (const float*)d_in[8]; a.gla_norm_w = (const float*)d_in[9];
    a.w_gla = (const float*)d_in[10]; a.w_attn = (const float*)d_in[11]; a.w_out = (const float*)d_in[12]; a.norm2_w = (const float*)d_in[13]; a.w_up = (const float*)d_in[14];
    a.conv_w = (const float*)d_in[15]; a.conv_b = (const float*)d_in[16]; a.w_down = (const float*)d_in[17]; a.final_w = (const float*)d_in[18];
    a.out = (float*)d_out; a.ws = (unsigned char*)d_ws;
    (void)hipMemsetAsync(d_ws, 0, 65536, stream);
    void* args[] = {&a};
    hipError_t e = hipLaunchCooperativeKernel((const void*)fwd_megakernel, dim3(grid_blocks), dim3(512), args, LDS_BYTES, stream);
    if (e != hipSuccess) fprintf(stderr, "cooperative launch failed: %s (grid %d)\n", hipGetErrorString(e), grid_blocks);
}
```

```cpp
#include <hip/hip_runtime.h>
#include <hip/hip_cooperative_groups.h>
#include <cstdio>
#include <cstdint>
namespace cg = cooperative_groups;


#define LAS __attribute__((address_space(3)))
typedef unsigned short bf16_t;
typedef short bf16x8 __attribute__((ext_vector_type(8)));
typedef float f32x4 __attribute__((ext_vector_type(4)));
typedef float f32x2 __attribute__((ext_vector_type(2)));
typedef unsigned u32x4 __attribute__((ext_vector_type(4)));
typedef unsigned u32x2 __attribute__((ext_vector_type(2)));

constexpr int NB = 4, SEQ = 4096, DM = 1024, NT = NB * SEQ;
constexpr int DIN = 7440, NMAIN = 5376, NGATE = 2048;
constexpr int C_GQ = 0, C_GK = 512, C_GV = 1024, C_GR = 2048, C_AQ = 3072, C_AK = 3840, C_AV = 4608;
constexpr int DFF = 2816, NUP = 5632;
constexpr float EPS = 1e-6f;

constexpr size_t KiB = 1024, MiB = 1024 * 1024;
constexpr size_t WS_MOD = 256 * KiB;
constexpr size_t WS_WLR = 512 * KiB;
constexpr size_t WS_SSQ = 768 * KiB;
constexpr size_t WS_GLR = 1 * MiB;
constexpr size_t WS_LSE = 2 * MiB;
constexpr size_t WS_MODP = 3 * MiB;
constexpr size_t WS_ROPE = 6 * MiB;
constexpr size_t WS_WMAIN = 10 * MiB;
constexpr size_t WS_WMAB = WS_WMAIN + (size_t)NMAIN * DM * 2;
constexpr size_t WS_WG = WS_WMAB + (size_t)NGATE * DM * 2;
constexpr size_t WS_WA = WS_WG + (size_t)DM * DM * 2;
constexpr size_t WS_WOUT = WS_WA + (size_t)DM * 256 * 2;
constexpr size_t WS_WUP = WS_WOUT + (size_t)DM * DM * 2;
constexpr size_t WS_WDOWN = WS_WUP + (size_t)NUP * DM * 2;
constexpr size_t WS_WEND = WS_WDOWN + (size_t)DM * DFF * 2;
constexpr size_t WS_HBUF = 47 * MiB;
constexpr size_t WS_BIG = 79 * MiB;
constexpr size_t WS_END = 255 * MiB;
static_assert(WS_WEND <= WS_HBUF, "weights overflow");

constexpr int LDS_BYTES = 147456;

__device__ const double INVF_REV[32] = {
1.59154943091895346e-01, 1.19349370211248862e-01, 8.94994016088910133e-02, 6.71150830052272551e-02, 5.03292121044870353e-02, 3.77415847174197711e-02, 2.83021958306233987e-02, 2.12236527647776604e-02,
1.59154943091895339e-02, 1.19349370211248862e-02, 8.94994016088910237e-03, 6.71150830052272534e-03, 5.03292121044870370e-03, 3.77415847174197719e-03, 2.83021958306233987e-03, 2.12236527647776622e-03,
1.59154943091895356e-03, 1.19349370211248849e-03, 8.94994016088910237e-04, 6.71150830052272599e-04, 5.03292121044870326e-04, 3.77415847174197741e-04, 2.83021958306233954e-04, 2.12236527647776605e-04,
1.59154943091895351e-04, 1.19349370211248862e-04, 8.94994016088910182e-05, 6.71150830052272545e-05, 5.03292121044870354e-05, 3.77415847174197768e-05, 2.83021958306233961e-05, 2.12236527647776592e-05};

__device__ __forceinline__ float bf2f(bf16_t v) { return __uint_as_float((unsigned)v << 16); }

typedef __bf16 bf16x2_hw __attribute__((ext_vector_type(2)));
__device__ __forceinline__ unsigned f2bf(float f) { return (unsigned)__builtin_bit_cast(unsigned short, (__bf16)f); }
__device__ __forceinline__ unsigned pk2(float lo, float hi) { const f32x2 v = {lo, hi}; return __builtin_bit_cast(unsigned, __builtin_convertvector(v, bf16x2_hw)); }
__device__ __forceinline__ float lo16(unsigned w) { return __uint_as_float(w << 16); }
__device__ __forceinline__ float hi16(unsigned w) { return __uint_as_float(w & 0xffff0000u); }
__device__ __forceinline__ void unpack8(u32x4 w, float* f) { f[0] = lo16(w.x); f[1] = hi16(w.x); f[2] = lo16(w.y); f[3] = hi16(w.y); f[4] = lo16(w.z); f[5] = hi16(w.z); f[6] = lo16(w.w); f[7] = hi16(w.w); }
__device__ __forceinline__ u32x4 pack8(const float* f) { u32x4 w; w.x = pk2(f[0], f[1]); w.y = pk2(f[2], f[3]); w.z = pk2(f[4], f[5]); w.w = pk2(f[6], f[7]); return w; }
__device__ __forceinline__ float wave_sum(float v) {
#pragma unroll
    for (int o = 1; o < 64; o <<= 1) v += __shfl_xor(v, o);
    return v;
}
__device__ __forceinline__ float sigmoidf_(float x) { return __builtin_amdgcn_rcpf(1.0f + __expf(-x)); }

namespace pg8 {
constexpr int BM = 256, BK = 64, HALF = 128, HTB = HALF * BK * 2, STAGE_BYTES = 8 * HTB, NXCD = 8, WGM = 8;
__host__ __device__ __forceinline__ int lds_byte(int r, int c) { const int st = (r >> 4) * 2 + (c >> 5), rr = r & 15, cc = c & 31, ob = rr * 64 + cc * 2; return st * 1024 + (ob ^ (((ob >> 9) & 1) << 5)); }
__host__ __device__ __forceinline__ void stage_rc(int b, int& R, int& C) { const int st = b / 1024, sb = b % 1024, swz = sb ^ (((sb >> 9) & 1) << 5); R = (st >> 1) * 16 + swz / 64; C = (st & 1) * 32 + (swz % 64) / 2; }
__host__ __device__ __forceinline__ int perm32(int rho) { const int n = rho >> 4, i = rho & 15; return 8 * (i >> 2) + 4 * n + (i & 3); }

struct Unit { int pm, pn; };
struct Gemm { const bf16_t* A; const bf16_t* Bt; int M, N, K, lda, ldb; };

struct StaticOrder {
    int nM, nN, nwg, G, c;
    __host__ __device__ void init(int M, int N, int G_, int c_) { nM = M / BM; nN = N / BM; nwg = nM * nN; G = G_; c = c_; }
    __host__ __device__ void init_tiles(int nM_, int nN_, int G_, int c_) { nM = nM_; nN = nN_; nwg = nM * nN; G = G_; c = c_; }
    __host__ __device__ bool next(int i, Unit& u) const {
        const long L = (long)i * G + c; if (L >= nwg) return false;
        int wgid = (int)L; { const int q = nwg / NXCD, r = nwg % NXCD, xcd = wgid % NXCD, off = wgid / NXCD; wgid = (xcd < r ? xcd * (q + 1) : r * (q + 1) + (xcd - r) * q) + off; }
        const int nig = WGM * nN, gid = wgid / nig, fm = gid * WGM, gsz = (nM - fm) < WGM ? (nM - fm) : WGM;
        u.pm = fm + ((wgid % nig) % gsz); u.pn = (wgid % nig) / gsz; return true;
    }
};

template <class F> struct EpiRow8 {
    static constexpr bool PERM = true, AFTER_DRAIN = false, MIDHOOK = false;
    F f;
    __device__ __forceinline__ void operator()(const f32x4 (&acc)[2][2][4][2], const Unit& u, int wr, int wc, int fr, int fq) const {
        const int row0 = u.pm * BM + wr * 64 + fr, col0 = u.pn * BM + wc * 32 + 8 * fq;
#pragma unroll
        for (int ai = 0; ai < 2; ++ai)
#pragma unroll
            for (int m = 0; m < 4; ++m) {
#pragma unroll
                for (int bj = 0; bj < 2; ++bj) f(row0 + ai * HALF + m * 16, col0 + bj * HALF, acc[ai][bj][m][0], acc[ai][bj][m][1]);
                if (m == 3) asm volatile("" ::: "memory");
            }
    }
};

template <class Epi, bool ALIGN_EPI = true, bool CONVMAP = false, int AKSPLIT = 0>
__device__ __forceinline__ void gemm_phase(LAS unsigned char* lds, const Gemm g, const StaticOrder& S, const Epi& E) {
    int tid_ = threadIdx.x; asm volatile("" : "+v"(tid_));
    const int tid = tid_, wid = __builtin_amdgcn_readfirstlane(tid >> 6), lane = tid & 63, wr = wid >> 2, wc = wid & 3, fr = lane & 15, fq = lane >> 4;
    const int K = g.K, nt = K / BK;
    unsigned voffA[2], voffB[2];
#pragma unroll
    for (int i = 0; i < 2; ++i) { int R, C; stage_rc(tid * 16 + i * 8192, R, C); const int Rb = Epi::PERM ? ((R & ~31) + perm32(R & 31)) : R;
        const int Ra = CONVMAP ? (126 * (R >> 6) + 8 * (R & 15) + ((R >> 4) & 3)) : R;
        voffA[i] = (unsigned)(Ra * g.lda + C) * 2u; voffB[i] = (unsigned)(Rb * g.ldb + C) * 2u; }
    const unsigned kstep = (unsigned)(BK * 2);
    const unsigned hstepA = (unsigned)(CONVMAP ? 4 : HALF) * g.lda * 2, hstepB = (unsigned)HALF * g.ldb * 2;
    const unsigned tstepA = CONVMAP ? 252u * g.lda * 2 : 2 * hstepA, tstepB = 2 * hstepB;
    const char* const baseA = (const char*)g.A; const char* const baseB = (const char*)g.Bt;
    const unsigned ldsw = (unsigned)wid * 1024u;
    const int aoff = lds_byte(wr * 64 + fr, fq * 8), boff = lds_byte(wc * 32 + fr, fq * 8);
#define PG8_SA(b, h) (((b) * 2 + (h)) * HTB)
#define PG8_SB(b, h) ((4 + (b) * 2 + (h)) * HTB)
#define PG8_STAGE(bufoff, goff, voff) do { _Pragma("unroll") for (int _i = 0; _i < 2; ++_i) { unsigned _vo = (voff)[_i] + (goff); asm volatile("" : "+v"(_vo)); \
        __builtin_amdgcn_global_load_lds((const unsigned*)(base_##voff + _vo), (LAS unsigned*)(lds + (bufoff) + ldsw + _i * 8192), 16, 0, 0); } } while (0)
#define base_voffA baseA
#define base_voffB baseB
#define PG8_LDA(dst, b, h) do { _Pragma("unroll") for (int m = 0; m < 4; ++m) _Pragma("unroll") for (int k = 0; k < 2; ++k) dst[m][k] = *(const LAS bf16x8*)(lds + PG8_SA(b, h) + aoff + m * 2048 + k * 1024); } while (0)
#define PG8_LDB(dst, b, h) do { _Pragma("unroll") for (int n = 0; n < 2; ++n) _Pragma("unroll") for (int k = 0; k < 2; ++k) dst[n][k] = *(const LAS bf16x8*)(lds + PG8_SB(b, h) + boff + n * 2048 + k * 1024); } while (0)
#define PG8_MMA(ai, bj, At, Bt) do { __builtin_amdgcn_s_setprio(1); _Pragma("unroll") for (int m = 0; m < 4; ++m) _Pragma("unroll") for (int n = 0; n < 2; ++n) _Pragma("unroll") for (int k = 0; k < 2; ++k) \
        acc[ai][bj][m][n] = __builtin_amdgcn_mfma_f32_16x16x32_bf16(Bt[n][k], At[m][k], acc[ai][bj][m][n], 0, 0, 0); __builtin_amdgcn_s_setprio(0); } while (0)
#define PG8_KOFFA(x) ((unsigned)(x) * kstep + (AKSPLIT ? ((x) < 4 ? 2048u : 0xFFFFFE00u) : 0u))
#define PG8_WAIT_V(n) asm volatile("s_waitcnt vmcnt(" #n ")" ::: "memory")
#define PG8_WAIT_L(n) asm volatile("s_waitcnt lgkmcnt(" #n ")" ::: "memory")
#define PG8_BAR __builtin_amdgcn_s_barrier()
#define PG8_SCHED __builtin_amdgcn_sched_barrier(0)
    Unit cur, nxt; int ui = 0;
    if (!S.next(0, cur)) return;
    f32x4 acc[2][2][4][2];
#pragma unroll
    for (int a = 0; a < 2; ++a)
#pragma unroll
        for (int b = 0; b < 2; ++b)
#pragma unroll
            for (int m = 0; m < 4; ++m)
#pragma unroll
                for (int n = 0; n < 2; ++n) acc[a][b][m][n] = (f32x4){0.f, 0.f, 0.f, 0.f};
    bf16x8 At[4][2], B0[2][2], B1[2][2];
    unsigned cA = (unsigned)cur.pm * tstepA, cB = (unsigned)cur.pn * tstepB;
    PG8_STAGE(PG8_SB(0, 0), cB, voffB); PG8_STAGE(PG8_SB(0, 1), cB + hstepB, voffB); PG8_STAGE(PG8_SA(0, 0), cA + PG8_KOFFA(0), voffA); PG8_STAGE(PG8_SA(0, 1), cA + hstepA + PG8_KOFFA(0), voffA);
    if (wr == 1) PG8_BAR;
    PG8_WAIT_V(2); PG8_BAR;
    PG8_STAGE(PG8_SB(1, 0), cB + kstep, voffB); PG8_STAGE(PG8_SA(1, 0), cA + PG8_KOFFA(1), voffA); PG8_STAGE(PG8_SB(1, 1), cB + hstepB + kstep, voffB);
    PG8_WAIT_V(6); PG8_BAR;
    for (;;) {
        const bool has_next = S.next(ui + 1, nxt);
        const unsigned nA = has_next ? (unsigned)nxt.pm * tstepA : cA, nB = has_next ? (unsigned)nxt.pn * tstepB : cB;
#define PG8_ITER(t) do { \
            const bool last = (t == nt - 2); \
            const unsigned a1 = cA + PG8_KOFFA(t + 1); \
            const unsigned a2 = last ? nA + PG8_KOFFA(0) : cA + PG8_KOFFA(t + 2), b2 = last ? nB : cB + (unsigned)(t + 2) * kstep; \
            const unsigned a3 = a2 + kstep, b3 = b2 + kstep; \
            PG8_LDB(B0, 0, 0); PG8_LDB(B1, 0, 1); PG8_SCHED; PG8_LDA(At, 0, 0); PG8_STAGE(PG8_SA(1, 1), a1 + hstepA, voffA); \
            PG8_WAIT_V(8); PG8_WAIT_L(0); PG8_BAR; PG8_MMA(0, 0, At, B0); PG8_MMA(0, 1, At, B1); PG8_BAR; PG8_SCHED; \
            PG8_LDA(At, 0, 1); PG8_STAGE(PG8_SB(0, 0), b2, voffB); PG8_STAGE(PG8_SB(0, 1), b2 + hstepB, voffB); PG8_STAGE(PG8_SA(0, 0), a2, voffA); \
            PG8_WAIT_V(8); PG8_WAIT_L(0); PG8_BAR; PG8_MMA(1, 0, At, B0); PG8_MMA(1, 1, At, B1); PG8_BAR; PG8_SCHED; \
            PG8_LDB(B0, 1, 0); PG8_LDB(B1, 1, 1); PG8_SCHED; PG8_LDA(At, 1, 0); PG8_STAGE(PG8_SA(0, 1), a2 + hstepA, voffA); \
            PG8_WAIT_V(8); PG8_WAIT_L(0); PG8_BAR; PG8_MMA(0, 0, At, B0); PG8_MMA(0, 1, At, B1); PG8_BAR; PG8_SCHED; \
            PG8_LDA(At, 1, 1); PG8_STAGE(PG8_SB(1, 0), b3, voffB); PG8_STAGE(PG8_SB(1, 1), b3 + hstepB, voffB); PG8_STAGE(PG8_SA(1, 0), a3, voffA); \
            PG8_WAIT_V(8); PG8_WAIT_L(0); PG8_BAR; PG8_MMA(1, 0, At, B0); PG8_MMA(1, 1, At, B1); PG8_BAR; PG8_SCHED; \
        } while (0)
        if constexpr (Epi::MIDHOOK) {
            for (int t = 0; t < 4; t += 2) PG8_ITER(t);
            E.mid(acc, cur, wr, wc, fr, fq);
            for (int t = 4; t < nt; t += 2) PG8_ITER(t);
        } else {
            for (int t = 0; t < nt; t += 2) PG8_ITER(t);
        }
#undef PG8_ITER
        if constexpr (ALIGN_EPI) { if (wr == 0) PG8_BAR; }
        if constexpr (!Epi::AFTER_DRAIN) { E(acc, cur, wr, wc, fr, fq); }
        if (!has_next) break;
#pragma unroll
        for (int a = 0; a < 2; ++a)
#pragma unroll
            for (int b = 0; b < 2; ++b)
#pragma unroll
                for (int m = 0; m < 4; ++m)
#pragma unroll
                    for (int n = 0; n < 2; ++n) acc[a][b][m][n] = (f32x4){0.f, 0.f, 0.f, 0.f};
        cur = nxt; cA = nA; cB = nB; ++ui;
        if constexpr (ALIGN_EPI) { if (wr == 1) PG8_BAR; }
    }
    PG8_WAIT_V(0);
    if constexpr (!ALIGN_EPI) { if (wr == 0) PG8_BAR; }
    PG8_BAR;
    if constexpr (Epi::AFTER_DRAIN) { E.fused(acc, cur, wr, wc, fr, fq, lds, wid, lane); }
#undef PG8_SA
#undef PG8_SB
#undef PG8_STAGE
#undef base_voffA
#undef base_voffB
#undef PG8_LDA
#undef PG8_LDB
#undef PG8_MMA
#undef PG8_WAIT_V
#undef PG8_KOFFA
#undef PG8_WAIT_L
#undef PG8_BAR
#undef PG8_SCHED
}
}


#define XB_TMO      128
#define XB_XCNT(j)  (256  + 64 * (j))
#define XB_XSUB(j)  (1280 + 64 * (j))
#define XB_XGEN(j)  (2304 + 64 * (j))
#define XB_TOP      3328
#define XB_TOPGEN   3392
#define XCD_BAR_WORDS 3456
#define XB_SPIN_CAP (1u << 18)
__device__ __forceinline__ unsigned xb_ld(unsigned* p)              { return __hip_atomic_load(p, __ATOMIC_RELAXED, __HIP_MEMORY_SCOPE_AGENT); }
__device__ __forceinline__ unsigned xb_add(unsigned* p, unsigned v) { return __hip_atomic_fetch_add(p, v, __ATOMIC_RELAXED, __HIP_MEMORY_SCOPE_AGENT); }
__device__ __forceinline__ unsigned xb_xcc_id() { return (unsigned)__builtin_amdgcn_s_getreg((3 << 11) | 20) & 0xFu; }
#define XB_SPIN(cond, bar) do { unsigned _sp = 0; while (cond) { __builtin_amdgcn_s_sleep(1); \
    if ((++_sp & 255u) == 0u) { if (xb_ld(&(bar)[XB_TMO])) break; if (_sp > XB_SPIN_CAP) { atomicAdd(&(bar)[XB_TMO], 1u); break; } } } } while (0)
struct XcdBarrier { unsigned* bar; unsigned x; volatile LAS unsigned* st; };
__device__ __forceinline__ XcdBarrier xcd_barrier_post(unsigned* bar, volatile LAS unsigned* st) {
    XcdBarrier b; b.bar = bar; b.x = xb_xcc_id(); b.st = st;
    if (threadIdx.x == 0) (void)xb_add(&bar[XB_XCNT(b.x)], 1u);
    return b;
}
__device__ __forceinline__ void xcd_barrier_complete(unsigned* bar, unsigned x, unsigned& nloc, unsigned& nx) {
    const unsigned G = gridDim.x * gridDim.y * gridDim.z;
    unsigned sum, cnt, mine, sp = 0u;
    for (;;) {
        sum = 0u; cnt = 0u; mine = 0u;
#pragma unroll
        for (unsigned j = 0; j < 16; ++j) { const unsigned c = xb_ld(&bar[XB_XCNT(j)]); sum += c; cnt += (c > 0u) ? 1u : 0u; mine = (j == x) ? c : mine; }
        if (sum == G) break;
        __builtin_amdgcn_s_sleep(1);
        if ((++sp & 255u) == 0u) { if (xb_ld(&bar[XB_TMO])) break; if (sp > XB_SPIN_CAP) { atomicAdd(&bar[XB_TMO], 1u); break; } }
    }
    nloc = mine > 0u ? mine : 1u; nx = cnt > 0u ? cnt : 1u;
}
__device__ __forceinline__ void xcd_barrier(const XcdBarrier& b) {
    asm volatile("s_waitcnt vmcnt(0)" ::: "memory");
    __syncthreads();
    if (threadIdx.x == 0) {
        unsigned* bar = b.bar;
        __builtin_amdgcn_s_waitcnt(0);
        unsigned nloc = b.st[0], nx = b.st[1];
        if (nloc == 0u) { xcd_barrier_complete(bar, b.x, nloc, nx); b.st[0] = nloc; b.st[1] = nx; }
        const unsigned old = xb_add(&bar[XB_XSUB(b.x)], 1u);
        const unsigned gen = old / nloc;
        if (old + 1u == (gen + 1u) * nloc) {
            __builtin_amdgcn_fence(__ATOMIC_RELEASE, "agent");
            asm volatile("s_waitcnt vmcnt(0)" ::: "memory");
            const unsigned og = xb_add(&bar[XB_TOP], 1u);
            const unsigned tg = og / nx;
            if (og + 1u == (tg + 1u) * nx) xb_add(&bar[XB_TOPGEN], 1u);
            else XB_SPIN(xb_ld(&bar[XB_TOPGEN]) == tg, bar);
            __builtin_amdgcn_fence(__ATOMIC_ACQUIRE, "agent");
            xb_add(&bar[XB_XGEN(b.x)], 1u);
            asm volatile("s_waitcnt vmcnt(0)" ::: "memory");
        } else {
            XB_SPIN(xb_ld(&bar[XB_XGEN(b.x)]) == gen, bar);
            __builtin_amdgcn_fence(__ATOMIC_ACQUIRE, "agent");
            asm volatile("s_waitcnt vmcnt(0)" ::: "memory");
        }
    }
    __syncthreads();
}

struct Args {
    const float* x; const float* c; const int* positions; const float* ada_w; const float* ada_b; const float* norm1_w; const float* w_in;
    const float* gate_w2; const float* gate_b; const float* gla_norm_w; const float* w_gla; const float* w_attn; const float* w_out; const float* norm2_w;
    const float* w_up; const float* conv_w; const float* conv_b; const float* w_down; const float* final_w;
    float* out; unsigned char* ws;
};

typedef const __attribute__((address_space(4))) Args* KArgs;
__device__ __forceinline__ KArgs kargs() { KArgs p = (KArgs)__builtin_amdgcn_kernarg_segment_ptr(); asm volatile("" : "+s"(p)); return p; }

struct Ctx { int tid, lane, wave, gtid, nthr, gw, ngw; LAS unsigned char* lds; };

__device__ __forceinline__ Ctx make_ctx(unsigned char* lds_raw) {
    Ctx X; int t = threadIdx.x; asm volatile("" : "+v"(t)); X.tid = t; X.lane = X.tid & 63; X.wave = __builtin_amdgcn_readfirstlane(X.tid >> 6);
    X.gtid = blockIdx.x * 512 + X.tid; X.nthr = gridDim.x * 512; X.gw = blockIdx.x * 8 + X.wave; X.ngw = gridDim.x * 8; X.lds = (LAS unsigned char*)lds_raw; return X; }

template <int ID, class F> __device__ __forceinline__ void run_gemm(const Ctx& X, const pg8::Gemm g, const F& f) {
    pg8::StaticOrder S; S.init(g.M, g.N, (int)gridDim.x, (int)blockIdx.x);
    pg8::EpiRow8<F> E{f};
    pg8::gemm_phase<pg8::EpiRow8<F>, true>(X.lds, g, S, E);
}

struct FStoreProj { bf16_t* O; const f32x2* rope;
    __device__ __forceinline__ void operator()(int row, int col, f32x4 v0, f32x4 v1) const {
        if (col >= C_AQ && col < C_AV) { const int g8 = ((col - C_AQ) & 63) >> 3; const f32x4* rp = (const f32x4*)(rope + (size_t)row * 32 + 4 * g8); const f32x4 r0 = rp[0], r1 = rp[1];
            const f32x4 cs = {r0[0], r0[2], r1[0], r1[2]}, sn = {r0[1], r0[3], r1[1], r1[3]}; const float sc = col < C_AK ? 0.125f * 1.44269504088896f : 1.0f;
            const f32x4 a0 = (v0 * cs - v1 * sn) * sc, a1 = (v1 * cs + v0 * sn) * sc; v0 = a0; v1 = a1; }
        u32x4 w; w.x = pk2(v0[0], v0[1]); w.y = pk2(v0[2], v0[3]); w.z = pk2(v1[0], v1[1]); w.w = pk2(v1[2], v1[3]);
        *(u32x4*)((char*)O + (unsigned)(row * NMAIN + col) * 2u) = w; } };
struct FSigmoidSplit { bf16_t* GA; bf16_t* GB;
    __device__ __forceinline__ void operator()(int row, int col, f32x4 v0, f32x4 v1) const {
        u32x4 w; w.x = pk2(sigmoidf_(v0[0]), sigmoidf_(v0[1])); w.y = pk2(sigmoidf_(v0[2]), sigmoidf_(v0[3])); w.z = pk2(sigmoidf_(v1[0]), sigmoidf_(v1[1])); w.w = pk2(sigmoidf_(v1[2]), sigmoidf_(v1[3]));
        if (col < 1024) *(u32x4*)((char*)GA + (unsigned)(row * DM + col) * 2u) = w; else *(u32x4*)((char*)GB + (unsigned)(row * NMAIN + (col - 1024)) * 2u) = w; } };
__device__ __forceinline__ f32x2 gelu_pk(f32x2 v) {
    const f32x2 av = __builtin_elementwise_abs(v), d = av * 0.2316418882f + 1.0f;
    f32x2 t; t.x = __builtin_amdgcn_rcpf(d.x); t.y = __builtin_amdgcn_rcpf(d.y);
    f32x2 q = t * 0.5307027145f + (-0.7265760135f); q = q * t + 0.7107068705f; q = q * t + (-0.142248368f); q = q * t + 0.127414796f; q = q * t;
    const f32x2 s = (v * v) * (-0.72134752044f);
    f32x2 e; e.x = __builtin_amdgcn_exp2f(s.x); e.y = __builtin_amdgcn_exp2f(s.y);
    const f32x2 m = av * (q * e);
    f32x2 o; o.x = fmaxf(v.x, 0.f) - m.x; o.y = fmaxf(v.y, 0.f) - m.y; return o;
}
__device__ __forceinline__ f32x4 dpp_shr1(f32x4 x) {
    f32x4 r;
#pragma unroll
    for (int j = 0; j < 4; ++j) r[j] = __int_as_float(__builtin_amdgcn_update_dpp(0, __float_as_int(x[j]), 0x111, 0xf, 0xf, false));
    return r;
}
struct EpiConvGeglu {
    static constexpr bool PERM = true, AFTER_DRAIN = false, MIDHOOK = false;
    bf16_t* hidden; const float* conv_w; const float* conv_b;
    template <bool EDGE> __device__ __forceinline__ void body(const f32x4 (&acc)[2][2][4][2], const pg8::Unit& u, int wr, int wc, int fr, int fq) const {
        const int tw0 = 252 * u.pm - 2 + 126 * wr;
        const int chb = 128 * u.pn + 32 * wc + 8 * fq;
#pragma unroll
        for (int n = 0; n < 2; ++n) {
            const int ch = chb + 4 * n;
            const f32x4 wv0 = *(const f32x4*)(conv_w + ch), wv1 = *(const f32x4*)(conv_w + NUP + ch), wv2 = *(const f32x4*)(conv_w + 2 * NUP + ch), bv = *(const f32x4*)(conv_b + ch);
            const f32x4 wg0 = *(const f32x4*)(conv_w + DFF + ch), wg1 = *(const f32x4*)(conv_w + NUP + DFF + ch), wg2 = *(const f32x4*)(conv_w + 2 * NUP + DFF + ch), bg = *(const f32x4*)(conv_b + DFF + ch);
            const f32x4 v7 = dpp_shr1(acc[1][0][3][n]), v6 = dpp_shr1(acc[1][0][2][n]), g7 = dpp_shr1(acc[1][1][3][n]), g6 = dpp_shr1(acc[1][1][2][n]);
#pragma unroll
            for (int k = 0; k < 8; ++k) {
                const int ai = k >> 2, m = k & 3, lr = 8 * fr + k, tau = tw0 + lr, sp = tau & 4095;
                const f32x4 cv = acc[ai][0][m][n], cg = acc[ai][1][m][n];
                const f32x4 p1v = k >= 1 ? acc[(k >= 1 ? k - 1 : 0) >> 2][0][(k >= 1 ? k - 1 : 0) & 3][n] : v7;
                const f32x4 p1g = k >= 1 ? acc[(k >= 1 ? k - 1 : 0) >> 2][1][(k >= 1 ? k - 1 : 0) & 3][n] : g7;
                const f32x4 p2v = k >= 2 ? acc[(k >= 2 ? k - 2 : 0) >> 2][0][(k >= 2 ? k - 2 : 0) & 3][n] : (k == 1 ? v7 : v6);
                const f32x4 p2g = k >= 2 ? acc[(k >= 2 ? k - 2 : 0) >> 2][1][(k >= 2 ? k - 2 : 0) & 3][n] : (k == 1 ? g7 : g6);
                f32x4 val, gat;
                if (EDGE) { const float m1 = sp >= 1 ? 1.f : 0.f, m2 = sp >= 2 ? 1.f : 0.f;
                    val = bv + wv2 * cv + (wv1 * m1) * p1v + (wv0 * m2) * p2v; gat = bg + wg2 * cg + (wg1 * m1) * p1g + (wg0 * m2) * p2g; }
                else { val = bv + wv2 * cv + wv1 * p1v + wv0 * p2v; gat = bg + wg2 * cg + wg1 * p1g + wg0 * p2g; }
                const f32x2 g01 = gelu_pk((f32x2){gat[0], gat[1]}), g23 = gelu_pk((f32x2){gat[2], gat[3]});
                u32x2 w; w.x = pk2(g01.x * val[0], g01.y * val[1]); w.y = pk2(g23.x * val[2], g23.y * val[3]);
                if (lr >= 2 && (!EDGE || tau < NT)) *(u32x2*)((char*)hidden + (unsigned)(tau * DFF + ch) * 2u) = w;
            }
            asm volatile("" ::: "memory");
        }
    }
    __device__ __forceinline__ void operator()(const f32x4 (&acc)[2][2][4][2], const pg8::Unit& u, int wr, int wc, int fr, int fq) const {
        const int tw0 = 252 * u.pm - 2 + 126 * wr;
        const bool edge = (tw0 <= 1) || ((tw0 & 4095) < 2) || (((tw0 + 127) >> 12) != (tw0 >> 12)) || (tw0 + 127 >= NT);
        if (edge) body<true>(acc, u, wr, wc, fr, fq); else body<false>(acc, u, wr, wc, fr, fq);
    }
};

struct EpiMixed2 {
    static constexpr bool PERM = true, AFTER_DRAIN = false, MIDHOOK = true;
    const bf16_t* gA; const bf16_t* gB; bf16_t* O;
    __device__ __forceinline__ void mid(f32x4 (&acc)[2][2][4][2], const pg8::Unit& u, int wr, int wc, int fr, int fq) const {
        const int row0 = u.pm * 256 + wr * 64 + fr, col0 = u.pn * 256 + wc * 32 + 8 * fq;
#pragma unroll
        for (int ai = 0; ai < 2; ++ai)
#pragma unroll
            for (int m = 0; m < 4; ++m) { const int row = row0 + ai * 128 + m * 16;
#pragma unroll
                for (int bj = 0; bj < 2; ++bj) { const int col = col0 + bj * 128;
                    const u32x4 aw = *(const u32x4*)((const char*)gA + (unsigned)(row * DM + col) * 2u), bw = *(const u32x4*)((const char*)gB + (unsigned)(row * NMAIN + col) * 2u);
                    f32x4 r0, r1;
                    r0[0] = lo16(bw.x) * __builtin_amdgcn_rcpf(fmaxf(lo16(aw.x), 1e-20f)); r0[1] = hi16(bw.x) * __builtin_amdgcn_rcpf(fmaxf(hi16(aw.x), 1e-20f));
                    r0[2] = lo16(bw.y) * __builtin_amdgcn_rcpf(fmaxf(lo16(aw.y), 1e-20f)); r0[3] = hi16(bw.y) * __builtin_amdgcn_rcpf(fmaxf(hi16(aw.y), 1e-20f));
                    r1[0] = lo16(bw.z) * __builtin_amdgcn_rcpf(fmaxf(lo16(aw.z), 1e-20f)); r1[1] = hi16(bw.z) * __builtin_amdgcn_rcpf(fmaxf(hi16(aw.z), 1e-20f));
                    r1[2] = lo16(bw.w) * __builtin_amdgcn_rcpf(fmaxf(lo16(aw.w), 1e-20f)); r1[3] = hi16(bw.w) * __builtin_amdgcn_rcpf(fmaxf(hi16(aw.w), 1e-20f));
                    acc[ai][bj][m][0] *= r0; acc[ai][bj][m][1] *= r1;
                    asm volatile("" ::: "memory"); } }
    }
    __device__ __forceinline__ void operator()(const f32x4 (&acc)[2][2][4][2], const pg8::Unit& u, int wr, int wc, int fr, int fq) const {
        const int row0 = u.pm * 256 + wr * 64 + fr, col0 = u.pn * 256 + wc * 32 + 8 * fq;
#pragma unroll
        for (int ai = 0; ai < 2; ++ai) {
#pragma unroll
            for (int m = 0; m < 4; ++m) { const int row = row0 + ai * 128 + m * 16;
#pragma unroll
                for (int bj = 0; bj < 2; ++bj) { const int col = col0 + bj * 128; float a8[8]; unpack8(*(const u32x4*)((const char*)gA + (unsigned)(row * DM + col) * 2u), a8);
                    const f32x4 v0 = acc[ai][bj][m][0], v1 = acc[ai][bj][m][1];
                    float o[8] = {v0[0] * a8[0], v0[1] * a8[1], v0[2] * a8[2], v0[3] * a8[3], v1[0] * a8[4], v1[1] * a8[5], v1[2] * a8[6], v1[3] * a8[7]};
                    *(u32x4*)((char*)O + (unsigned)(row * DM + col) * 2u) = pack8(o); } }
            asm volatile("" ::: "memory");
        }
    }
};

struct RmsPanel {
    float* xbuf;
    unsigned* cnt;
    __device__ __forceinline__ void run(const pg8::Unit& u, LAS unsigned char* lds, int wid, int lane) const {
        LAS float* P = (LAS float*)lds; LAS float* S = (LAS float*)(lds + 4096);
        asm volatile("s_waitcnt lgkmcnt(0)" ::: "memory"); __builtin_amdgcn_s_barrier(); asm volatile("" ::: "memory");
        const int row = wid * 32 + (lane & 31);
        if (lane < 32) { const float tot = (P[row * 4 + 0] + P[row * 4 + 1]) + (P[row * 4 + 2] + P[row * 4 + 3]);
            __hip_atomic_store(xbuf + (size_t)(u.pm * 256 + row) * 4 + u.pn, tot, __ATOMIC_RELAXED, __HIP_MEMORY_SCOPE_AGENT); }
        asm volatile("s_waitcnt vmcnt(0)" ::: "memory");
        if (lane == 0) __hip_atomic_fetch_add(cnt + 64 * u.pm, 1u, __ATOMIC_RELAXED, __HIP_MEMORY_SCOPE_AGENT);
        if (wid == 0) { unsigned sp = 0;
            for (;;) { if ((unsigned)__builtin_amdgcn_readfirstlane(__hip_atomic_load(cnt + 64 * u.pm, __ATOMIC_RELAXED, __HIP_MEMORY_SCOPE_AGENT)) >= 32u) break;
                if (++sp > (1u << 22)) break; __builtin_amdgcn_s_sleep(2); }
            __builtin_amdgcn_fence(__ATOMIC_ACQUIRE, "agent"); }
        asm volatile("s_waitcnt vmcnt(0) lgkmcnt(0)" ::: "memory"); __builtin_amdgcn_s_barrier(); asm volatile("" ::: "memory");
        if (lane < 32) { const float* slot = xbuf + (size_t)(u.pm * 256 + row) * 4; float q = 0.f;
#pragma unroll
            for (int t = 0; t < 4; ++t) q += __hip_atomic_load(slot + t, __ATOMIC_RELAXED, __HIP_MEMORY_SCOPE_AGENT);
            S[row] = 1.0f / sqrtf(q * (1.0f / 1024.0f) + EPS); }
        asm volatile("s_waitcnt lgkmcnt(0)" ::: "memory"); __builtin_amdgcn_s_barrier(); asm volatile("" ::: "memory");
    }
};
struct EpiResNorm {
    static constexpr bool PERM = true, AFTER_DRAIN = true, MIDHOOK = false;
    const float* base; bf16_t* x1b; bf16_t* hn; const float* mod; const float* nw; RmsPanel st;
    __device__ __forceinline__ void fused(f32x4 (&acc)[2][2][4][2], const pg8::Unit& u, int wr, int wc, int fr, int fq, LAS unsigned char* lds, int wid, int lane) const {
        const int col0 = u.pn * 256 + wc * 32 + 8 * fq, b = (u.pm * 256) >> 12; const float* mb = mod + (size_t)b * 6144;
        { LAS float* P = (LAS float*)lds;
          f32x4 gg[2][2];
#pragma unroll
          for (int bj = 0; bj < 2; ++bj) { gg[bj][0] = *(const f32x4*)(mb + 2048 + col0 + bj * 128); gg[bj][1] = *(const f32x4*)(mb + 2048 + col0 + bj * 128 + 4); }
          f32x4 nb[2][2];
          { const float* bp = base + (size_t)(u.pm * 256 + wr * 64 + fr) * DM + col0;
#pragma unroll
            for (int bj = 0; bj < 2; ++bj) { nb[bj][0] = __builtin_nontemporal_load((const f32x4*)(bp + bj * 128)); nb[bj][1] = __builtin_nontemporal_load((const f32x4*)(bp + bj * 128 + 4)); } }
#pragma unroll
          for (int k = 0; k < 8; ++k) { const int ai = k >> 2, m = k & 3, r = ai * 128 + wr * 64 + m * 16 + fr; float s = 0.f;
              f32x4 cb[2][2];
#pragma unroll
              for (int bj = 0; bj < 2; ++bj) { cb[bj][0] = nb[bj][0]; cb[bj][1] = nb[bj][1]; }
              if (k < 7) { const int k2 = k + 1; const float* bp = base + (size_t)(u.pm * 256 + (k2 >> 2) * 128 + wr * 64 + (k2 & 3) * 16 + fr) * DM + col0;
#pragma unroll
                  for (int bj = 0; bj < 2; ++bj) { nb[bj][0] = __builtin_nontemporal_load((const f32x4*)(bp + bj * 128)); nb[bj][1] = __builtin_nontemporal_load((const f32x4*)(bp + bj * 128 + 4)); } }
#pragma unroll
              for (int bj = 0; bj < 2; ++bj) { const f32x4 x0 = cb[bj][0] + gg[bj][0] * acc[ai][bj][m][0], x1 = cb[bj][1] + gg[bj][1] * acc[ai][bj][m][1];
                  acc[ai][bj][m][0] = x0; acc[ai][bj][m][1] = x1;
                  s += ((x0[0] * x0[0] + x0[1] * x0[1]) + (x0[2] * x0[2] + x0[3] * x0[3])) + ((x1[0] * x1[0] + x1[1] * x1[1]) + (x1[2] * x1[2] + x1[3] * x1[3])); }
              s += __shfl_xor(s, 16); s += __shfl_xor(s, 32);
              if (fq == 0) P[r * 4 + wc] = s;
              asm volatile("" ::: "memory"); } }
        st.run(u, lds, wid, lane);
        const LAS float* S = (const LAS float*)(lds + 4096);
#pragma unroll
        for (int bj = 0; bj < 2; ++bj) { const int col = col0 + bj * 128;
            f32x4 g2[2], s2[2];
#pragma unroll
            for (int n = 0; n < 2; ++n) { g2[n] = *(const f32x4*)(nw + col + 4 * n) * (*(const f32x4*)(mb + 4096 + col + 4 * n) + 1.0f); s2[n] = *(const f32x4*)(mb + 3072 + col + 4 * n); }
#pragma unroll
            for (int ai = 0; ai < 2; ++ai)
#pragma unroll
                for (int m = 0; m < 4; ++m) { const int r = ai * 128 + wr * 64 + m * 16 + fr; const float rstd = S[r]; const size_t off = (size_t)(u.pm * 256 + r) * DM + col;
                    { u32x4 xw; xw.x = pk2(acc[ai][bj][m][0][0], acc[ai][bj][m][0][1]); xw.y = pk2(acc[ai][bj][m][0][2], acc[ai][bj][m][0][3]); xw.z = pk2(acc[ai][bj][m][1][0], acc[ai][bj][m][1][1]); xw.w = pk2(acc[ai][bj][m][1][2], acc[ai][bj][m][1][3]);
                      *(u32x4*)(x1b + off) = xw; }
                    const f32x4 y0 = acc[ai][bj][m][0] * rstd * g2[0] + s2[0], y1 = acc[ai][bj][m][1] * rstd * g2[1] + s2[1];
                    u32x4 w; w.x = pk2(y0[0], y0[1]); w.y = pk2(y0[2], y0[3]); w.z = pk2(y1[0], y1[1]); w.w = pk2(y1[2], y1[3]);
                    *(u32x4*)(hn + off) = w; } }
    }
};
struct EpiResFinal {
    static constexpr bool PERM = true, AFTER_DRAIN = true, MIDHOOK = false;
    const bf16_t* x1b; float* out; const float* mod; const float* fw; RmsPanel st;
    __device__ __forceinline__ void fused(f32x4 (&acc)[2][2][4][2], const pg8::Unit& u, int wr, int wc, int fr, int fq, LAS unsigned char* lds, int wid, int lane) const {
        const int col0 = u.pn * 256 + wc * 32 + 8 * fq, b = (u.pm * 256) >> 12; const float* mb = mod + (size_t)b * 6144;
        { LAS float* P = (LAS float*)lds;
          f32x4 gg[2][2];
#pragma unroll
          for (int bj = 0; bj < 2; ++bj) { gg[bj][0] = *(const f32x4*)(mb + 5120 + col0 + bj * 128); gg[bj][1] = *(const f32x4*)(mb + 5120 + col0 + bj * 128 + 4); }
          u32x4 nb[2];
          { const bf16_t* bp = x1b + (size_t)(u.pm * 256 + wr * 64 + fr) * DM + col0;
#pragma unroll
            for (int bj = 0; bj < 2; ++bj) nb[bj] = __builtin_nontemporal_load((const u32x4*)(bp + bj * 128)); }
#pragma unroll
          for (int k = 0; k < 8; ++k) { const int ai = k >> 2, m = k & 3, r = ai * 128 + wr * 64 + m * 16 + fr; float s = 0.f;
              f32x4 cb[2][2];
#pragma unroll
              for (int bj = 0; bj < 2; ++bj) { cb[bj][0] = (f32x4){lo16(nb[bj].x), hi16(nb[bj].x), lo16(nb[bj].y), hi16(nb[bj].y)}; cb[bj][1] = (f32x4){lo16(nb[bj].z), hi16(nb[bj].z), lo16(nb[bj].w), hi16(nb[bj].w)}; }
              if (k < 7) { const int k2 = k + 1; const bf16_t* bp = x1b + (size_t)(u.pm * 256 + (k2 >> 2) * 128 + wr * 64 + (k2 & 3) * 16 + fr) * DM + col0;
#pragma unroll
                  for (int bj = 0; bj < 2; ++bj) nb[bj] = __builtin_nontemporal_load((const u32x4*)(bp + bj * 128)); }
#pragma unroll
              for (int bj = 0; bj < 2; ++bj) { const f32x4 x0 = cb[bj][0] + gg[bj][0] * acc[ai][bj][m][0], x1 = cb[bj][1] + gg[bj][1] * acc[ai][bj][m][1];
                  acc[ai][bj][m][0] = x0; acc[ai][bj][m][1] = x1;
                  s += ((x0[0] * x0[0] + x0[1] * x0[1]) + (x0[2] * x0[2] + x0[3] * x0[3])) + ((x1[0] * x1[0] + x1[1] * x1[1]) + (x1[2] * x1[2] + x1[3] * x1[3])); }
              s += __shfl_xor(s, 16); s += __shfl_xor(s, 32);
              if (fq == 0) P[r * 4 + wc] = s;
              asm volatile("" ::: "memory"); } }
        st.run(u, lds, wid, lane);
        const LAS float* S = (const LAS float*)(lds + 4096);
#pragma unroll
        for (int bj = 0; bj < 2; ++bj) { const int col = col0 + bj * 128; const f32x4 w0 = *(const f32x4*)(fw + col), w1 = *(const f32x4*)(fw + col + 4);
#pragma unroll
            for (int ai = 0; ai < 2; ++ai)
#pragma unroll
                for (int m = 0; m < 4; ++m) { const int r = ai * 128 + wr * 64 + m * 16 + fr; const float rstd = S[r]; const size_t off = (size_t)(u.pm * 256 + r) * DM + col;
                    __builtin_nontemporal_store(acc[ai][bj][m][0] * rstd * w0, (f32x4*)(out + off)); __builtin_nontemporal_store(acc[ai][bj][m][1] * rstd * w1, (f32x4*)(out + off + 4)); } }
    }
};

__device__ __forceinline__ void transpose_item(const float* W, int ldw, int col0, int K, bf16_t* WT, int drow0, int k0, int n0, LAS float* scr, int lane, int perm = 0, int d0 = 0) {
#pragma unroll 8
    for (int i = 0; i < 32; ++i) { const int kk = 2 * i + (lane >> 5); scr[kk * 33 + (lane & 31)] = __builtin_nontemporal_load(&W[(size_t)(k0 + kk) * ldw + col0 + n0 + (lane & 31)]); }
    asm volatile("s_waitcnt lgkmcnt(0)" ::: "memory");
    const int c = lane & 7;
#pragma unroll
    for (int j = 0; j < 4; ++j) { const int n = (lane >> 3) + 8 * j; const LAS float* s = scr + (8 * c) * 33 + n;
        u32x4 o; o.x = pk2(s[0 * 33], s[1 * 33]); o.y = pk2(s[2 * 33], s[3 * 33]); o.z = pk2(s[4 * 33], s[5 * 33]); o.w = pk2(s[6 * 33], s[7 * 33]);
        const int drow = perm ? (drow0 + 8 * (n >> 2) + (n & 3) + (d0 ? 4 : 0)) : (drow0 + n);
        *(u32x4*)(WT + (size_t)drow * K + k0 + 8 * c) = o; }
    asm volatile("s_waitcnt lgkmcnt(0)" ::: "memory");
}

__device__ __forceinline__ void phase0_transposes(const Ctx& X, KArgs a, int it0, int it1, int gw, int ngw) {
    unsigned char* ws = a->ws;
    LAS float* scr = (LAS float*)(X.lds + X.wave * 16384);
    constexpr int I1 = 16 * 96, I2 = 16 * 72, I3 = 16 * 64, I4 = 16 * 32, I5 = 4 * 32, I6 = 16 * 32, I7 = 16 * 176, I8 = 44 * 32;
    constexpr int NITEMS = I1 + I2 + I3 + I4 + I5 + I6 + I7 + I8;
    for (int it = it0 + gw; it < (it1 < 0 ? NITEMS : it1); it += ngw) {
        int r = it;
        if (r < I1) { const int nb = r % 96, kb = r / 96; transpose_item(a->w_in, DIN, 0, DM, (bf16_t*)(ws + WS_WMAIN), nb * 32, kb * 64, nb * 32, scr, X.lane); continue; } r -= I1;
        if (r < I2) { const int nb = r % 72, kb = r / 72; const bool rot = nb < 48;
            transpose_item(a->w_in, DIN, 3088, DM, (bf16_t*)(ws + WS_WMAIN), rot ? 3072 + (nb >> 1) * 64 : 3072 + nb * 32, kb * 64, nb * 32, scr, X.lane, rot ? 1 : 0, (nb & 1) * 32); continue; } r -= I2;
        if (r < I3) { const int nb = r % 64, kb = r / 64; transpose_item(a->w_in, DIN, 5392, DM, (bf16_t*)(ws + WS_WMAB), nb * 32, kb * 64, nb * 32, scr, X.lane); continue; } r -= I3;
        if (r < I4) { const int nb = r % 32, kb = r / 32; transpose_item(a->w_gla, DM, 0, 1280, (bf16_t*)(ws + WS_WG) + 256, nb * 32, kb * 64, nb * 32, scr, X.lane); continue; } r -= I4;
        if (r < I5) { const int nb = r % 32, kb = r / 32; transpose_item(a->w_attn, DM, 0, 1280, (bf16_t*)(ws + WS_WG), nb * 32, kb * 64, nb * 32, scr, X.lane); continue; } r -= I5;
        if (r < I6) { const int nb = r % 32, kb = r / 32; transpose_item(a->w_out, DM, 0, DM, (bf16_t*)(ws + WS_WOUT), nb * 32, kb * 64, nb * 32, scr, X.lane); continue; } r -= I6;
        if (r < I7) { const int nb = r % 176, kb = r / 176; const int n0 = nb * 32; const int ch = n0 % DFF; const int drow = (ch / 128) * 256 + (n0 >= DFF ? 128 : 0) + (ch % 128);
            transpose_item(a->w_up, NUP, 0, DM, (bf16_t*)(ws + WS_WUP), drow, kb * 64, n0, scr, X.lane); continue; } r -= I7;
        { const int nb = r % 32, kb = r / 32; transpose_item(a->w_down, DM, 0, DFF, (bf16_t*)(ws + WS_WDOWN), nb * 32, kb * 64, nb * 32, scr, X.lane); }
    }
}

__device__ __forceinline__ void phase0(const Ctx& X, KArgs a) {
    unsigned char* ws = a->ws;
    { bf16_t* wlr = (bf16_t*)(ws + WS_WLR);
      for (int idx = X.gtid; idx < 16 * DM; idx += X.nthr) { const int j = idx >> 10, k = idx & 1023; wlr[idx] = (bf16_t)f2bf(a->w_in[(size_t)k * DIN + 3072 + j]); } }
    { float* modp = (float*)(ws + WS_MODP);
      for (int u = X.gw; u < 96 * 32; u += X.ngw) { const int cgp = u % 96, kc = u / 96, j = cgp * 64 + X.lane;
          float w[32];
#pragma unroll
          for (int kk = 0; kk < 32; ++kk) w[kk] = __builtin_nontemporal_load(&a->ada_w[(size_t)(kc * 32 + kk) * 6144 + j]);
          const float cA = a->c[(X.lane >> 5) * DM + kc * 32 + (X.lane & 31)], cB = a->c[((X.lane >> 5) + 2) * DM + kc * 32 + (X.lane & 31)];
          const int sA = __float_as_int(cA / (1.0f + __expf(-cA))), sB = __float_as_int(cB / (1.0f + __expf(-cB)));
          float acc[4] = {0.f, 0.f, 0.f, 0.f};
#pragma unroll
          for (int kk = 0; kk < 32; ++kk) {
              acc[0] += __int_as_float(__builtin_amdgcn_readlane(sA, kk)) * w[kk]; acc[1] += __int_as_float(__builtin_amdgcn_readlane(sA, 32 + kk)) * w[kk];
              acc[2] += __int_as_float(__builtin_amdgcn_readlane(sB, kk)) * w[kk]; acc[3] += __int_as_float(__builtin_amdgcn_readlane(sB, 32 + kk)) * w[kk]; }
#pragma unroll
          for (int b = 0; b < 4; ++b) modp[(size_t)(kc * 4 + b) * 6144 + j] = acc[b]; } }
    { f32x2* rope = (f32x2*)(ws + WS_ROPE);
      for (int idx = X.gtid; idx < NT * 32; idx += X.nthr) { const int t = idx >> 5, i = idx & 31;
          const double rev = (double)a->positions[t] * INVF_REV[i]; const float fr = (float)(rev - floor(rev));
          rope[idx] = (f32x2){__builtin_amdgcn_cosf(fr), __builtin_amdgcn_sinf(fr)}; } }
}

template <int MODE> __device__ __forceinline__ void norm_pass(const Ctx& X, KArgs a, const float* xin, bf16_t* hout, float* fout) {
    unsigned char* ws = a->ws;
    const float* modp = (const float*)(ws + WS_MODP); float* mod = (float*)(ws + WS_MOD);
    if (MODE == 0) { for (int idx = X.gtid; idx < 4 * 6144; idx += X.nthr) { const int b = idx / 6144, j = idx % 6144; float s = a->ada_b[j];
            float pv[32];
#pragma unroll
            for (int kc = 0; kc < 32; ++kc) pv[kc] = modp[(size_t)(kc * 4 + b) * 6144 + j];
#pragma unroll
            for (int kc = 0; kc < 32; ++kc) s += pv[kc];
            mod[idx] = s; } }
    LAS float* gs = (LAS float*)X.lds;
    LAS bf16_t* hs = (LAS bf16_t*)(X.lds + 8192);
    for (int rt = blockIdx.x; rt < NT / 64; rt += gridDim.x) {
        const int row0 = rt * 64, b = row0 >> 12;
        __syncthreads();
        for (int idx = X.tid; idx < DM; idx += 512) {
            float g, s;
            if (MODE == 0) { float sc = a->ada_b[1024 + idx], sh = a->ada_b[idx];
                float pa[32], pb[32];
#pragma unroll
                for (int kc = 0; kc < 32; ++kc) { pa[kc] = modp[(size_t)(kc * 4 + b) * 6144 + 1024 + idx]; pb[kc] = modp[(size_t)(kc * 4 + b) * 6144 + idx]; }
#pragma unroll
                for (int kc = 0; kc < 32; ++kc) { sc += pa[kc]; sh += pb[kc]; }
                g = a->norm1_w[idx] * (1.0f + sc); s = sh; }
            else if (MODE == 1) { g = a->norm2_w[idx] * (1.0f + mod[b * 6144 + 4096 + idx]); s = mod[b * 6144 + 3072 + idx]; }
            else { g = a->final_w[idx]; s = 0.f; }
            gs[idx] = g; gs[1024 + idx] = s;
        }
        __syncthreads();
#pragma unroll 1
        for (int rb = 0; rb < 8; rb += 4) {
            f32x4 v[4][4];
#pragma unroll
            for (int r = 0; r < 4; ++r) { const f32x4* xr = (const f32x4*)(xin + (size_t)(row0 + X.wave * 8 + rb + r) * DM) + X.lane;
#pragma unroll
                for (int j = 0; j < 4; ++j) v[r][j] = __builtin_nontemporal_load(xr + 64 * j); }
#pragma unroll
            for (int r = 0; r < 4; ++r) {
                const int lr = X.wave * 8 + rb + r, row = row0 + lr;
                float ss = 0.f;
#pragma unroll
                for (int j = 0; j < 4; ++j) ss += (v[r][j][0] * v[r][j][0] + v[r][j][1] * v[r][j][1]) + (v[r][j][2] * v[r][j][2] + v[r][j][3] * v[r][j][3]);
                const float rstd = 1.0f / sqrtf(wave_sum(ss) * (1.0f / DM) + EPS);
#pragma unroll
                for (int j = 0; j < 4; ++j) { const int k = 4 * X.lane + 256 * j;
                    const f32x4 g = *(const LAS f32x4*)(gs + k), sft = *(const LAS f32x4*)(gs + 1024 + k);
                    const f32x4 y = v[r][j] * rstd * g + sft;
                    if (MODE == 2) { *((f32x4*)(fout + (size_t)row * DM) + X.lane + 64 * j) = y; }
                    else { u32x2 w; w.x = pk2(y[0], y[1]); w.y = pk2(y[2], y[3]);
                        *(u32x2*)(hout + (size_t)row * DM + k) = w;
                        if (MODE == 0) *(LAS u32x2*)(hs + lr * 1032 + k) = w; } }
            }
        }
        if (MODE == 0) {
            __syncthreads();
            const bf16_t* wlr = (const bf16_t*)(ws + WS_WLR);
            const int mt = X.wave & 3, kh = X.wave >> 2, fr = X.lane & 15, fq = X.lane >> 4;
            f32x4 acc = {0.f, 0.f, 0.f, 0.f};
#pragma unroll 4
            for (int ks = 0; ks < 16; ++ks) { const int k0 = kh * 512 + ks * 32 + 8 * fq;
                const bf16x8 av = *(const LAS bf16x8*)(hs + (16 * mt + fr) * 1032 + k0);
                const bf16x8 bv = *(const bf16x8*)(wlr + fr * 1024 + k0);
                acc = __builtin_amdgcn_mfma_f32_16x16x32_bf16(av, bv, acc, 0, 0, 0); }
            LAS f32x4* red = (LAS f32x4*)X.lds;
            if (kh == 1) red[mt * 64 + X.lane] = acc;
            __syncthreads();
            if (kh == 0) { const f32x4 o = acc + red[mt * 64 + X.lane]; float* glr = (float*)(ws + WS_GLR);
#pragma unroll
                for (int e = 0; e < 4; ++e) glr[(size_t)(row0 + 16 * mt + 4 * fq + e) * 16 + fr] = o[e]; }
        }
    }
}

constexpr int QP = 72, VP = 264;
__device__ __forceinline__ void attn_mfma(const Ctx& X, KArgs a, int dry = 0) {
    bf16_t* proj = (bf16_t*)(a->ws + WS_BIG); const f32x2* rope = (const f32x2*)(a->ws + WS_ROPE); float* lse = (float*)(a->ws + WS_LSE);
    LAS bf16_t* Qs = (LAS bf16_t*)X.lds; LAS bf16_t* Ks = (LAS bf16_t*)(X.lds + 128 * QP * 2); LAS bf16_t* Vt = (LAS bf16_t*)(X.lds + 384 * QP * 2);
    const int fr = X.lane & 15, fq = X.lane >> 4, w = X.wave, i0 = 16 * w;
    const int per = (1536 + (int)gridDim.x - 1) / (int)gridDim.x, u0 = (int)blockIdx.x * per, u1 = (u0 + per < 1536) ? u0 + per : 1536;
    int cur_half = 1;
    for (int unit = u0; unit < u1; ++unit) {
        const int b = unit / 384, rem = unit % 384, h = rem >> 5, pn = rem & 31, g = h >> 2, hg = h & 3;
        const int r = (g == 0) ? 1 : (g == 1 ? 4 : 16), nblk = 32 / r, p = pn / nblk, n = pn % nblk;
        const int tb = b * SEQ + p;
        const bool reuse = (unit > u0) && (n >= 1);
        if (reuse) cur_half ^= 1;
        const int prev_half = cur_half ^ 1;
        __syncthreads();
        { const int i = X.tid >> 2, c = X.tid & 3; const int t = tb + (128 * n + i) * r; const bf16_t* src = proj + (size_t)t * NMAIN + C_AQ + h * 64 + 16 * c;
          *(LAS u32x4*)(Qs + i * QP + 16 * c) = *(const u32x4*)src; *(LAS u32x4*)(Qs + i * QP + 16 * c + 8) = *(const u32x4*)(src + 8); }
        for (int blk = reuse ? 1 : 0; blk < 2; ++blk) {
            const int half = blk ? cur_half : prev_half;
            { const int j = X.tid >> 2, c = X.tid & 3; int m = 128 * (n - 1 + blk) + j; m = m < 0 ? 0 : m; const int t = tb + m * r;
              const bf16_t* src = proj + (size_t)t * NMAIN + C_AK + h * 64 + 16 * c;
              *(LAS u32x4*)(Ks + (half * 128 + j) * QP + 16 * c) = *(const u32x4*)src; *(LAS u32x4*)(Ks + (half * 128 + j) * QP + 16 * c + 8) = *(const u32x4*)(src + 8); }
#pragma unroll
            for (int q = 0; q < 2; ++q) { const int idx = X.tid + 512 * q, j = idx & 127, c = idx >> 7; int m = 128 * (n - 1 + blk) + j; m = m < 0 ? 0 : m; const int t = tb + m * r;
                const u32x4 wv = *(const u32x4*)(proj + (size_t)t * NMAIN + C_AV + h * 64 + 8 * c);
                LAS bf16_t* vp = Vt + (8 * c) * VP + half * 128 + j;
                vp[0 * VP] = (bf16_t)(wv.x & 0xffff); vp[1 * VP] = (bf16_t)(wv.x >> 16); vp[2 * VP] = (bf16_t)(wv.y & 0xffff); vp[3 * VP] = (bf16_t)(wv.y >> 16);
                vp[4 * VP] = (bf16_t)(wv.z & 0xffff); vp[5 * VP] = (bf16_t)(wv.z >> 16); vp[6 * VP] = (bf16_t)(wv.w & 0xffff); vp[7 * VP] = (bf16_t)(wv.w >> 16); }
        }
        __syncthreads();
#define KOFF(t_) ((((t_) >> 3) ? cur_half : prev_half) * 128 + 16 * ((t_) & 7))
        bf16x8 bq[2];
#pragma unroll
        for (int ks = 0; ks < 2; ++ks) bq[ks] = *(const LAS bf16x8*)(Qs + (i0 + fr) * QP + 32 * ks + 8 * fq);
        f32x4 sc[9];
#pragma unroll
        for (int q = 0; q < 9; ++q) { sc[q] = (f32x4){0.f, 0.f, 0.f, 0.f};
#pragma unroll
            for (int ks = 0; ks < 2; ++ks) { const bf16x8 ak = *(const LAS bf16x8*)(Ks + (KOFF(w + q) + fr) * QP + 32 * ks + 8 * fq); sc[q] = __builtin_amdgcn_mfma_f32_16x16x32_bf16(ak, bq[ks], sc[q], 0, 0, 0); } }
        const int iq = i0 + fr;
        float mx = -INFINITY;
#pragma unroll
        for (int q = 0; q < 9; ++q) { const bool tile_ok = (n > 0) || (w + q >= 8);
#pragma unroll
            for (int e = 0; e < 4; ++e) { bool valid = tile_ok;
                if (q == 0) valid = valid && (4 * fq + e >= fr);
                if (q == 8) valid = valid && (4 * fq + e <= fr);
                sc[q][e] = valid ? sc[q][e] : -INFINITY; mx = fmaxf(mx, sc[q][e]); } }
        mx = fmaxf(mx, __shfl_xor(mx, 16)); mx = fmaxf(mx, __shfl_xor(mx, 32));
        float l = 0.f;
#pragma unroll
        for (int q = 0; q < 9; ++q)
#pragma unroll
            for (int e = 0; e < 4; ++e) { sc[q][e] = __builtin_amdgcn_exp2f(sc[q][e] - mx); l += sc[q][e]; }
        l += __shfl_xor(l, 16); l += __shfl_xor(l, 32);
        f32x4 o[4];
#pragma unroll
        for (int dt = 0; dt < 4; ++dt) o[dt] = (f32x4){0.f, 0.f, 0.f, 0.f};
#pragma unroll
        for (int c = 0; c < 5; ++c) { const int jtA = w + 2 * c; int jtB = w + 2 * c + 1; jtB = jtB > 15 ? 15 : jtB;
            const f32x4 pa = sc[2 * c]; const f32x4 pb = (2 * c + 1 <= 8) ? sc[(2 * c + 1 <= 8) ? 2 * c + 1 : 8] : (f32x4){0.f, 0.f, 0.f, 0.f};
            u32x4 pw; pw.x = pk2(pa[0], pa[1]); pw.y = pk2(pa[2], pa[3]); pw.z = pk2(pb[0], pb[1]); pw.w = pk2(pb[2], pb[3]);
            const bf16x8 bfrag = __builtin_bit_cast(bf16x8, pw);
#pragma unroll
            for (int dt = 0; dt < 4; ++dt) { const LAS bf16_t* vr = Vt + (16 * dt + fr) * VP + 4 * fq;
                const u32x2 lo = *(const LAS u32x2*)(vr + KOFF(jtA)), hi = *(const LAS u32x2*)(vr + KOFF(jtB)); const u32x4 av = {lo.x, lo.y, hi.x, hi.y};
                o[dt] = __builtin_amdgcn_mfma_f32_16x16x32_bf16(__builtin_bit_cast(bf16x8, av), bfrag, o[dt], 0, 0, 0); } }
        const float il = 1.0f / l; const int tq = tb + (128 * n + iq) * r;
        bf16_t* op = (dry ? proj + (size_t)NT * NMAIN + (size_t)(tq & 63) * NMAIN : proj + (size_t)tq * NMAIN) + C_AQ + h * 64 + 4 * fq;
#pragma unroll
        for (int dt = 0; dt < 4; ++dt) { u32x2 wv; wv.x = pk2(o[dt][0] * il, o[dt][1] * il); wv.y = pk2(o[dt][2] * il, o[dt][3] * il); *(u32x2*)(op + 16 * dt) = wv; }
        if (fq == 0) lse[((size_t)g * NT + tq) * 4 + hg] = mx * 0.6931471805599453f + __logf(l);
    }
}
#undef KOFF

__device__ __forceinline__ void attn_combine(const Ctx& X, KArgs a) {
    bf16_t* proj = (bf16_t*)(a->ws + WS_BIG); const float* lse = (const float*)(a->ws + WS_LSE);
    for (int base = X.gtid; base < NT * 32; base += 4 * X.nthr) {
        u32x4 o0[4], o1[4], o2[4]; float l0[4], l1[4], l2[4];
#pragma unroll
        for (int q = 0; q < 4; ++q) { const int idx = base + q * X.nthr; if (idx < NT * 32) { const int t = idx >> 5, c8 = (idx & 31) * 8, hg = c8 >> 6;
            l0[q] = lse[((size_t)0 * NT + t) * 4 + hg]; l1[q] = lse[((size_t)1 * NT + t) * 4 + hg]; l2[q] = lse[((size_t)2 * NT + t) * 4 + hg];
            const bf16_t* p = proj + (size_t)t * NMAIN + C_AQ + c8; o0[q] = *(const u32x4*)p; o1[q] = *(const u32x4*)(p + 256); o2[q] = *(const u32x4*)(p + 512); } }
#pragma unroll
        for (int q = 0; q < 4; ++q) { const int idx = base + q * X.nthr; if (idx < NT * 32) { const int t = idx >> 5, c8 = (idx & 31) * 8;
            const float mx = fmaxf(l0[q], fmaxf(l1[q], l2[q])); float w0 = __expf(l0[q] - mx), w1 = __expf(l1[q] - mx), w2 = __expf(l2[q] - mx); const float inv = 1.0f / (w0 + w1 + w2); w0 *= inv; w1 *= inv; w2 *= inv;
            float f0[8], f1[8], f2[8], o[8]; unpack8(o0[q], f0); unpack8(o1[q], f1); unpack8(o2[q], f2);
#pragma unroll
            for (int e = 0; e < 8; ++e) o[e] = w0 * f0[e] + w1 * f1[e] + w2 * f2[e];
            *(u32x4*)(proj + (size_t)t * NMAIN + C_AQ + c8) = pack8(o); } }
    }
}

constexpr int GP = 136;
__device__ __forceinline__ void gla_bcum(KArgs a, int tid, int t0, int h, LAS float* segtot, LAS float* glrs, float (&bc)[32], float& tot) {
    const int d = tid & 127, seg = __builtin_amdgcn_readfirstlane(tid >> 7), col = h * 128 + d;
    const float* glr = (const float*)(a->ws + WS_GLR);
    float w2r[16];
#pragma unroll
    for (int j = 0; j < 16; ++j) w2r[j] = a->gate_w2[j * 512 + col];
    const float bias = a->gate_b[col];
    *(LAS f32x4*)(glrs + tid * 4) = *(const f32x4*)(glr + (size_t)t0 * 16 + tid * 4);
    __syncthreads();
    float run = 0.f;
#pragma unroll
    for (int r = 0; r < 32; ++r) { const LAS f32x4* gp = (const LAS f32x4*)(glrs + (seg * 32 + r) * 16);
        float z = bias;
#pragma unroll
        for (int q = 0; q < 4; ++q) { const f32x4 g = gp[q]; z += g[0] * w2r[4 * q] + g[1] * w2r[4 * q + 1] + g[2] * w2r[4 * q + 2] + g[3] * w2r[4 * q + 3]; }
        const float la = (fminf(z, 0.f) - __logf(1.0f + __expf(-fabsf(z)))) * (1.0f / 16.0f);
        run += la; bc[r] = run; }
    segtot[seg * 128 + d] = run;
    __syncthreads();
    float off = 0.f; tot = 0.f;
#pragma unroll
    for (int s2 = 0; s2 < 4; ++s2) { const float v = segtot[s2 * 128 + d]; tot += v; if (s2 < seg) off += v; }
#pragma unroll
    for (int r = 0; r < 32; ++r) bc[r] += off;
}
__device__ __forceinline__ void gla_stage_vT(const bf16_t* proj, int tid, int t0, int h, LAS bf16_t* vT) {
#pragma unroll
    for (int q = 0; q < 8; ++q) { const int i = tid >> 2, c = (tid & 3) + 4 * q;
        const u32x4 wv = *(const u32x4*)(proj + (size_t)(t0 + i) * NMAIN + C_GV + h * 256 + 8 * c);
        LAS bf16_t* vp = vT + (8 * c) * GP + i;
        vp[0 * GP] = (bf16_t)(wv.x & 0xffff); vp[1 * GP] = (bf16_t)(wv.x >> 16); vp[2 * GP] = (bf16_t)(wv.y & 0xffff); vp[3 * GP] = (bf16_t)(wv.y >> 16);
        vp[4 * GP] = (bf16_t)(wv.z & 0xffff); vp[5 * GP] = (bf16_t)(wv.z >> 16); vp[6 * GP] = (bf16_t)(wv.w & 0xffff); vp[7 * GP] = (bf16_t)(wv.w >> 16); }
}
__device__ __forceinline__ void gla_a1(const Ctx& X, KArgs a, float* kvt, float* decb) {
    const bf16_t* proj = (const bf16_t*)(a->ws + WS_BIG);
    LAS bf16_t* kdT = (LAS bf16_t*)X.lds; LAS bf16_t* vT = (LAS bf16_t*)(X.lds + 128 * GP * 2); LAS float* segtot = (LAS float*)(X.lds + 384 * GP * 2);
    const int fr = X.lane & 15, fq = X.lane >> 4, w = X.wave;
    for (int unit = blockIdx.x; unit < 512; unit += gridDim.x) {
        const int bh = unit >> 5, n = unit & 31, b = bh >> 2, h = bh & 3, t0 = b * SEQ + n * 128;
        __syncthreads();
        float bc[32], tot; gla_bcum(a, X.tid, t0, h, segtot, (LAS float*)vT, bc, tot);
        { const int d = X.tid & 127, seg = X.tid >> 7;
#pragma unroll
          for (int r8 = 0; r8 < 4; ++r8) { float kd[8];
#pragma unroll
              for (int e = 0; e < 8; ++e) { const int r = r8 * 8 + e; kd[e] = bf2f(proj[(size_t)(t0 + seg * 32 + r) * NMAIN + C_GK + h * 128 + d]) * __expf(tot - bc[r]); }
              *(LAS u32x4*)(kdT + d * GP + seg * 32 + r8 * 8) = pack8(kd); }
          if (seg == 0) decb[unit * 128 + d] = __expf(tot); }
        gla_stage_vT(proj, X.tid, t0, h, vT);
        __syncthreads();
        f32x4 acc[8][2];
#pragma unroll
        for (int mt = 0; mt < 8; ++mt) { acc[mt][0] = (f32x4){0.f, 0.f, 0.f, 0.f}; acc[mt][1] = (f32x4){0.f, 0.f, 0.f, 0.f}; }
#pragma unroll
        for (int ks = 0; ks < 4; ++ks) {
            bf16x8 bfr[2];
#pragma unroll
            for (int nt = 0; nt < 2; ++nt) bfr[nt] = *(const LAS bf16x8*)(vT + (32 * w + 16 * nt + fr) * GP + 32 * ks + 8 * fq);
#pragma unroll
            for (int mt = 0; mt < 8; ++mt) { const bf16x8 af = *(const LAS bf16x8*)(kdT + (16 * mt + fr) * GP + 32 * ks + 8 * fq);
#pragma unroll
                for (int nt = 0; nt < 2; ++nt) acc[mt][nt] = __builtin_amdgcn_mfma_f32_16x16x32_bf16(af, bfr[nt], acc[mt][nt], 0, 0, 0); }
        }
        bf16_t* ko = (bf16_t*)kvt + (size_t)unit * 32768;
#pragma unroll
        for (int mt = 0; mt < 8; ++mt)
#pragma unroll
            for (int nt = 0; nt < 2; ++nt) { u32x2 wv; wv.x = pk2(acc[mt][nt][0], acc[mt][nt][1]); wv.y = pk2(acc[mt][nt][2], acc[mt][nt][3]);
                *(u32x2*)(ko + (32 * w + 16 * nt + fr) * 128 + 16 * mt + 4 * fq) = wv; }
    }
}
__device__ __forceinline__ void gla_a2(const Ctx& X, KArgs a, float* kvt, const float* decb, int dry = 0) {
    u32x2* kb = (u32x2*)kvt;
    for (int gid = X.gtid; gid < 131072; gid += X.nthr) {
        const int bh = gid >> 13, e4 = gid & 8191, d4 = (e4 & 31) * 4;
        f32x4 S = {0.f, 0.f, 0.f, 0.f};
        u32x2 kv[32];
#pragma unroll
        for (int j = 0; j < 32; ++j) kv[j] = kb[(size_t)(bh * 32 + j) * 8192 + e4];
#pragma unroll
        for (int hb = 0; hb < 2; ++hb) {
            f32x4 dc[16];
#pragma unroll
            for (int j = 0; j < 16; ++j) dc[j] = *(const f32x4*)(decb + (bh * 32 + hb * 16 + j) * 128 + d4);
#pragma unroll
            for (int j = 0; j < 16; ++j) { const int jj = hb * 16 + j, unit = bh * 32 + jj; u32x2 wv; wv.x = pk2(S[0], S[1]); wv.y = pk2(S[2], S[3]);
                if (dry) *((u32x2*)(a->ws + WS_BIG + (size_t)NT * NMAIN * 2) + gid) = wv; else kb[(size_t)unit * 8192 + e4] = wv;
                const f32x4 kf = {lo16(kv[jj].x), hi16(kv[jj].x), lo16(kv[jj].y), hi16(kv[jj].y)}; S = dc[j] * S + kf; }
        }
    }
}
__device__ __forceinline__ void gla_a3(const Ctx& X, KArgs a, const float* kvt, int dry = 0) {
    bf16_t* proj = (bf16_t*)(a->ws + WS_BIG);
    LAS bf16_t* qgs = (LAS bf16_t*)X.lds; LAS bf16_t* kgs = (LAS bf16_t*)(X.lds + 128 * GP * 2); LAS bf16_t* vT = (LAS bf16_t*)(X.lds + 256 * GP * 2); LAS float* segtot = (LAS float*)(X.lds + 512 * GP * 2);
    const int fr = X.lane & 15, fq = X.lane >> 4, w = X.wave, i0 = 16 * w;
    for (int unit = blockIdx.x; unit < 512; unit += gridDim.x) {
        const int bh = unit >> 5, n = unit & 31, b = bh >> 2, h = bh & 3, t0 = b * SEQ + n * 128;
        __syncthreads();
        { float bc[32], tot; gla_bcum(a, X.tid, t0, h, segtot, (LAS float*)vT, bc, tot);
          const int d = X.tid & 127, seg = X.tid >> 7;
#pragma unroll
          for (int r = 0; r < 32; ++r) { const int i = seg * 32 + r; const bf16_t* row = proj + (size_t)(t0 + i) * NMAIN + h * 128 + d;
              const float qv = bf2f(row[C_GQ]), kv = bf2f(row[C_GK]);
              qgs[i * GP + d] = (bf16_t)f2bf(qv * 0.08838834764831845f * __expf(bc[r])); kgs[i * GP + d] = (bf16_t)f2bf(kv * __expf(-bc[r])); } }
        gla_stage_vT(proj, X.tid, t0, h, vT);
        __syncthreads();
        bf16x8 afr[4];
#pragma unroll
        for (int ks = 0; ks < 4; ++ks) afr[ks] = *(const LAS bf16x8*)(qgs + (i0 + fr) * GP + 32 * ks + 8 * fq);
        f32x4 acc[16];
#pragma unroll
        for (int nt = 0; nt < 16; ++nt) acc[nt] = (f32x4){0.f, 0.f, 0.f, 0.f};
        for (int jt = 0; jt <= (w | 1); ++jt) {
            f32x4 att = {0.f, 0.f, 0.f, 0.f};
            if (jt <= w) {
#pragma unroll
                for (int ks = 0; ks < 4; ++ks) { const bf16x8 bf = *(const LAS bf16x8*)(kgs + (16 * jt + fr) * GP + 32 * ks + 8 * fq); att = __builtin_amdgcn_mfma_f32_16x16x32_bf16(afr[ks], bf, att, 0, 0, 0); }
            }
#pragma unroll
            for (int e = 0; e < 4; ++e) { const int i = i0 + 4 * fq + e, j = 16 * jt + fr; qgs[i * GP + j] = (bf16_t)f2bf(j <= i ? att[e] : 0.f); }
        }
        asm volatile("s_waitcnt lgkmcnt(0)" ::: "memory");
        for (int ks = 0; ks <= (w >> 1); ++ks) { const bf16x8 af = *(const LAS bf16x8*)(qgs + (i0 + fr) * GP + 32 * ks + 8 * fq);
#pragma unroll
            for (int nt = 0; nt < 16; ++nt) { const bf16x8 bf = *(const LAS bf16x8*)(vT + (16 * nt + fr) * GP + 32 * ks + 8 * fq); acc[nt] = __builtin_amdgcn_mfma_f32_16x16x32_bf16(af, bf, acc[nt], 0, 0, 0); } }
        if (n > 0) {
            __syncthreads();
            const bf16_t* sb = (const bf16_t*)kvt + (size_t)unit * 32768;
#pragma unroll
            for (int q = 0; q < 8; ++q) { const int sidx = X.tid + 512 * q; const u32x4 wv = *(const u32x4*)(sb + (size_t)sidx * 8);
                *(LAS u32x4*)(vT + (sidx >> 4) * GP + (sidx & 15) * 8) = wv; }
            __syncthreads();
#pragma unroll
            for (int ks = 0; ks < 4; ++ks)
#pragma unroll
                for (int nt = 0; nt < 16; ++nt) { const bf16x8 bf = *(const LAS bf16x8*)(vT + (16 * nt + fr) * GP + 32 * ks + 8 * fq); acc[nt] = __builtin_amdgcn_mfma_f32_16x16x32_bf16(afr[ks], bf, acc[nt], 0, 0, 0); }
        }
        float rs[4];
#pragma unroll
        for (int e = 0; e < 4; ++e) { float s2 = 0.f;
#pragma unroll
            for (int nt = 0; nt < 16; ++nt) s2 += acc[nt][e] * acc[nt][e];
            s2 += __shfl_xor(s2, 1); s2 += __shfl_xor(s2, 2); s2 += __shfl_xor(s2, 4); s2 += __shfl_xor(s2, 8);
            rs[e] = 1.0f / sqrtf(s2 * (1.0f / 256.0f) + EPS); }
        __syncthreads();
        { LAS bf16_t* ost = (LAS bf16_t*)(X.lds + w * 8704);
#pragma unroll
          for (int nt = 0; nt < 16; ++nt) { const float nw = a->gla_norm_w[16 * nt + fr];
#pragma unroll
              for (int e = 0; e < 4; ++e) ost[(4 * fq + e) * 272 + 16 * nt + fr] = (bf16_t)f2bf(acc[nt][e] * rs[e] * nw); }
          asm volatile("s_waitcnt lgkmcnt(0)" ::: "memory");
          const int r = X.lane >> 2, cgp = X.lane & 3;
          bf16_t* orow = proj + (size_t)(t0 + i0 + r) * NMAIN + C_GR + h * 256;
          bf16_t* drow = dry ? proj + (size_t)NT * NMAIN + (size_t)((t0 + i0 + r) & 63) * NMAIN + C_GR + h * 256 : orow;
          u32x4 gv[8];
#pragma unroll
          for (int q = 0; q < 8; ++q) gv[q] = *(const u32x4*)(orow + 8 * (cgp + 4 * q));
#pragma unroll
          for (int q = 0; q < 8; ++q) { const int c = cgp + 4 * q; float v[8], gr[8]; unpack8(*(const LAS u32x4*)(ost + r * 272 + 8 * c), v); unpack8(gv[q], gr);
#pragma unroll
              for (int e = 0; e < 8; ++e) v[e] *= gr[e] * sigmoidf_(gr[e]);
              *(u32x4*)(drow + 8 * c) = pack8(v); } }
    }
}

__global__ void __launch_bounds__(512, 2) fwd_megakernel(Args a_kernarg) {
    extern __shared__ __attribute__((aligned(16))) unsigned char lds_raw[];
    cg::grid_group grid = cg::this_grid();
#define X make_ctx(lds_raw)
    { volatile LAS unsigned* st0 = (volatile LAS unsigned*)((LAS unsigned char*)lds_raw + LDS_BYTES - 64); if (threadIdx.x < 2) st0[threadIdx.x] = 0u; }
    __syncthreads();
    const XcdBarrier xbar = xcd_barrier_post((unsigned*)(kargs()->ws), (volatile LAS unsigned*)((LAS unsigned char*)lds_raw + LDS_BYTES - 64));
#define WSP(T, off) ((T*)(a->ws + (off)))

    phase0(X, kargs());
    if (gridDim.x == 0x7fffffffu) grid.sync();
    xcd_barrier(xbar);
    { KArgs a = kargs(); norm_pass<0>(X, a, a->x, WSP(bf16_t, WS_HBUF), nullptr); }
    __syncthreads();
    phase0_transposes(X, kargs(), 0, 16 * 96 + 16 * 72 + 16 * 64, X.gw, X.ngw);
    xcd_barrier(xbar);
    { KArgs a = kargs(); pg8::Gemm g{WSP(bf16_t, WS_HBUF), WSP(bf16_t, WS_WMAIN), NT, NMAIN, DM, DM, DM}; run_gemm<0>(X, g, FStoreProj{WSP(bf16_t, WS_BIG), WSP(f32x2, WS_ROPE)}); }
    { const int nfull = (gridDim.x > 64) ? 64 : 0;
      if ((int)blockIdx.x >= nfull) phase0_transposes(X, kargs(), 16 * 96 + 16 * 72 + 16 * 64, -1, ((int)blockIdx.x - nfull) * 8 + X.wave, ((int)gridDim.x - nfull) * 8); }
    xcd_barrier(xbar);
#pragma unroll 1
    for (int step = 0; step < 2; ++step) {
        if (((step ^ (int)blockIdx.x) & 1) == 0) { KArgs a = kargs(); gla_a1(X, a, a->out, WSP(float, WS_SSQ)); }
        else attn_mfma(X, kargs());
        __syncthreads();
    }
    xcd_barrier(xbar);
    { KArgs a = kargs(); gla_a2(X, a, a->out, WSP(float, WS_SSQ)); }
    xcd_barrier(xbar);
    if ((blockIdx.x & 1) == 0) { KArgs a = kargs(); pg8::Gemm g{WSP(bf16_t, WS_HBUF), WSP(bf16_t, WS_WMAB), NT, NGATE, DM, DM, DM};
        run_gemm<1>(X, g, FSigmoidSplit{(bf16_t*)a->out + (size_t)NT * DM, WSP(bf16_t, WS_BIG) + C_AK}); }
    __syncthreads();
    { KArgs a = kargs(); gla_a3(X, a, a->out); }
    attn_combine(X, kargs());
    __syncthreads();
    if ((blockIdx.x & 1) != 0) { KArgs a = kargs(); pg8::Gemm g{WSP(bf16_t, WS_HBUF), WSP(bf16_t, WS_WMAB), NT, NGATE, DM, DM, DM};
        run_gemm<1>(X, g, FSigmoidSplit{(bf16_t*)a->out + (size_t)NT * DM, WSP(bf16_t, WS_BIG) + C_AK}); }
    xcd_barrier(xbar);
    { KArgs a = kargs(); pg8::Gemm g{WSP(bf16_t, WS_BIG) + C_GR, WSP(bf16_t, WS_WG), NT, DM, 1280, NMAIN, 1280};
      pg8::StaticOrder S; S.init(NT, DM, (int)gridDim.x, (int)blockIdx.x);
      EpiMixed2 E{(const bf16_t*)a->out + (size_t)NT * DM, WSP(bf16_t, WS_BIG) + C_AK, WSP(bf16_t, WS_HBUF)};
      pg8::gemm_phase<EpiMixed2, true, false, 1>(X.lds, g, S, E); }
    xcd_barrier(xbar);
    { KArgs a = kargs(); pg8::Gemm g{WSP(bf16_t, WS_HBUF), WSP(bf16_t, WS_WOUT), NT, DM, DM, DM, DM};
      pg8::StaticOrder S; S.init(NT, DM, (int)gridDim.x, (int)blockIdx.x);
      EpiResNorm E{a->x, WSP(bf16_t, WS_BIG) + (size_t)48 * 1024 * 1024, WSP(bf16_t, WS_HBUF), WSP(float, WS_MOD), a->norm2_w, RmsPanel{WSP(float, WS_GLR), (unsigned*)(a->ws + 16384)}};
      pg8::gemm_phase<EpiResNorm, false>(X.lds, g, S, E); }
    xcd_barrier(xbar);
    { KArgs a = kargs(); pg8::Gemm g{WSP(bf16_t, WS_HBUF) - 2 * DM, WSP(bf16_t, WS_WUP), NT, NUP, DM, DM, DM};
      pg8::StaticOrder S; S.init_tiles(66, NUP / 256, (int)gridDim.x, (int)blockIdx.x);
      EpiConvGeglu E{WSP(bf16_t, WS_BIG), a->conv_w, a->conv_b};
      pg8::gemm_phase<EpiConvGeglu, true, true>(X.lds, g, S, E); }
    xcd_barrier(xbar);
    { KArgs a = kargs(); pg8::Gemm g{WSP(bf16_t, WS_BIG), WSP(bf16_t, WS_WDOWN), NT, DM, DFF, DFF, DFF};
      pg8::StaticOrder S; S.init(NT, DM, (int)gridDim.x, (int)blockIdx.x);
      EpiResFinal E{WSP(bf16_t, WS_BIG) + (size_t)48 * 1024 * 1024, a->out, WSP(float, WS_MOD), a->final_w, RmsPanel{WSP(float, WS_GLR) + 65536, (unsigned*)(a->ws + 32768)}};
      pg8::gemm_phase<EpiResFinal, false>(X.lds, g, S, E); }
#undef WSP
#undef X
}

extern "C" void kernel_launch(void* const* d_in, const int* in_sizes, int n_in, void* d_out, int out_size, void* d_ws, size_t ws_size, hipStream_t stream) {
    static int grid_blocks = 0;
    if (grid_blocks == 0) {
        if (n_in != 19 || out_size != NT * DM || ws_size < WS_END) { fprintf(stderr, "kernel_launch: unexpected sizes (n_in %d out %d ws %zu)\n", n_in, out_size, ws_size); grid_blocks = -1; return; }
        int dev = 0, cus = 0, per_cu = 0;
        hipGetDevice(&dev); hipDeviceGetAttribute(&cus, hipDeviceAttributeMultiprocessorCount, dev);
        hipFuncSetAttribute((const void*)fwd_megakernel, hipFuncAttributeMaxDynamicSharedMemorySize, LDS_BYTES);
        hipOccupancyMaxActiveBlocksPerMultiprocessor(&per_cu, (const void*)fwd_megakernel, 512, LDS_BYTES);
        if (per_cu < 1) { fprintf(stderr, "kernel_launch: occupancy query says %d blocks per CU\n", per_cu); per_cu = 1; }
        if (per_cu > 1) per_cu = 1;
        grid_blocks = cus * per_cu;
        (void)hipGetLastError();
    }
    if (grid_blocks < 0) return;
    Args a{};
    a.x = (const float*)d_in[0]; a.c = (const float*)d_in[1]; a.positions = (const int*)d_in[2]; a.ada_w = (const float*)d_in[3]; a.ada_b = (const float*)d_in[4];
    a.norm1_w = (const float*)d_in[5]; a.w_in = (const float*)d_in[6]; a.gate_w2 = (const float*)d_in[7]; a.gate_b = (const float*)d_in[8]; a.gla_norm_w = (const float*)d_in[9];
    a.w_gla = (const float*)d_in[10]; a.w_attn = (const float*)d_in[11]; a.w_out = (const float*)d_in[12]; a.norm2_w = (const float*)d_in[13]; a.w_up = (const float*)d_in[14];
    a.conv_w = (const float*)d_in[15]; a.conv_b = (const float*)d_in[16]; a.w_down = (const float*)d_in[17]; a.final_w = (const float*)d_in[18];
    a.out = (float*)d_out; a.ws = (unsigned char*)d_ws;
    (void)hipMemsetAsync(d_ws, 0, 65536, stream);
    void* args[] = {&a};
    hipError_t e = hipLaunchCooperativeKernel((const void*)fwd_megakernel, dim3(grid_blocks), dim3(512), args, LDS_BYTES, stream);
    if (e != hipSuccess) fprintf(stderr, "cooperative launch failed: %s (grid %d)\n", hipGetErrorString(e), grid_blocks);
}
```

```cpp
#include <hip/hip_runtime.h>
#include <hip/hip_cooperative_groups.h>
#include <cstdio>
#include <cstdint>
namespace cg = cooperative_groups;


#define LAS __attribute__((address_space(3)))
typedef unsigned short bf16_t;
typedef short bf16x8 __attribute__((ext_vector_type(8)));
typedef float f32x4 __attribute__((ext_vector_type(4)));
typedef float f32x2 __attribute__((ext_vector_type(2)));
typedef unsigned u32x4 __attribute__((ext_vector_type(4)));
typedef unsigned u32x2 __attribute__((ext_vector_type(2)));

constexpr int NB = 4, SEQ = 4096, DM = 1024, NT = NB * SEQ;
constexpr int DIN = 7440, NMAIN = 5376, NGATE = 2048;
constexpr int C_GQ = 0, C_GK = 512, C_GV = 1024, C_GR = 2048, C_AQ = 3072, C_AK = 3840, C_AV = 4608;
constexpr int DFF = 2816, NUP = 5632;
constexpr float EPS = 1e-6f;

constexpr size_t KiB = 1024, MiB = 1024 * 1024;
constexpr size_t WS_MOD = 256 * KiB;
constexpr size_t WS_WLR = 512 * KiB;
constexpr size_t WS_SSQ = 768 * KiB;
constexpr size_t WS_GLR = 1 * MiB;
constexpr size_t WS_LSE = 2 * MiB;
constexpr size_t WS_MODP = 3 * MiB;
constexpr size_t WS_ROPE = 6 * MiB;
constexpr size_t WS_WMAIN = 10 * MiB;
constexpr size_t WS_WMAB = WS_WMAIN + (size_t)NMAIN * DM * 2;
constexpr size_t WS_WG = WS_WMAB + (size_t)NGATE * DM * 2;
constexpr size_t WS_WA = WS_WG + (size_t)DM * DM * 2;
constexpr size_t WS_WOUT = WS_WA + (size_t)DM * 256 * 2;
constexpr size_t WS_WUP = WS_WOUT + (size_t)DM * DM * 2;
constexpr size_t WS_WDOWN = WS_WUP + (size_t)NUP * DM * 2;
constexpr size_t WS_WEND = WS_WDOWN + (size_t)DM * DFF * 2;
constexpr size_t WS_HBUF = 47 * MiB;
constexpr size_t WS_BIG = 79 * MiB;
constexpr size_t WS_END = 255 * MiB;
static_assert(WS_WEND <= WS_HBUF, "weights overflow");

constexpr int LDS_BYTES = 147456;

__device__ const double INVF_REV[32] = {
1.59154943091895346e-01, 1.19349370211248862e-01, 8.94994016088910133e-02, 6.71150830052272551e-02, 5.03292121044870353e-02, 3.77415847174197711e-02, 2.83021958306233987e-02, 2.12236527647776604e-02,
1.59154943091895339e-02, 1.19349370211248862e-02, 8.94994016088910237e-03, 6.71150830052272534e-03, 5.03292121044870370e-03, 3.77415847174197719e-03, 2.83021958306233987e-03, 2.12236527647776622e-03,
1.59154943091895356e-03, 1.19349370211248849e-03, 8.94994016088910237e-04, 6.71150830052272599e-04, 5.03292121044870326e-04, 3.77415847174197741e-04, 2.83021958306233954e-04, 2.12236527647776605e-04,
1.59154943091895351e-04, 1.19349370211248862e-04, 8.94994016088910182e-05, 6.71150830052272545e-05, 5.03292121044870354e-05, 3.77415847174197768e-05, 2.83021958306233961e-05, 2.12236527647776592e-05};

__device__ __forceinline__ float bf2f(bf16_t v) { return __uint_as_float((unsigned)v << 16); }

typedef __bf16 bf16x2_hw __attribute__((ext_vector_type(2)));
__device__ __forceinline__ unsigned f2bf(float f) { return (unsigned)__builtin_bit_cast(unsigned short, (__bf16)f); }
__device__ __forceinline__ unsigned pk2(float lo, float hi) { const f32x2 v = {lo, hi}; return __builtin_bit_cast(unsigned, __builtin_convertvector(v, bf16x2_hw)); }
__device__ __forceinline__ float lo16(unsigned w) { return __uint_as_float(w << 16); }
__device__ __forceinline__ float hi16(unsigned w) { return __uint_as_float(w & 0xffff0000u); }
__device__ __forceinline__ void unpack8(u32x4 w, float* f) { f[0] = lo16(w.x); f[1] = hi16(w.x); f[2] = lo16(w.y); f[3] = hi16(w.y); f[4] = lo16(w.z); f[5] = hi16(w.z); f[6] = lo16(w.w); f[7] = hi16(w.w); }
__device__ __forceinline__ u32x4 pack8(const float* f) { u32x4 w; w.x = pk2(f[0], f[1]); w.y = pk2(f[2], f[3]); w.z = pk2(f[4], f[5]); w.w = pk2(f[6], f[7]); return w; }
__device__ __forceinline__ float wave_sum(float v) {
#pragma unroll
    for (int o = 1; o < 64; o <<= 1) v += __shfl_xor(v, o);
    return v;
}
__device__ __forceinline__ float sigmoidf_(float x) { return __builtin_amdgcn_rcpf(1.0f + __expf(-x)); }

namespace pg8 {
constexpr int BM = 256, BK = 64, HALF = 128, HTB = HALF * BK * 2, STAGE_BYTES = 8 * HTB, NXCD = 8, WGM = 8;
__host__ __device__ __forceinline__ int lds_byte(int r, int c) { const int st = (r >> 4) * 2 + (c >> 5), rr = r & 15, cc = c & 31, ob = rr * 64 + cc * 2; return st * 1024 + (ob ^ (((ob >> 9) & 1) << 5)); }
__host__ __device__ __forceinline__ void stage_rc(int b, int& R, int& C) { const int st = b / 1024, sb = b % 1024, swz = sb ^ (((sb >> 9) & 1) << 5); R = (st >> 1) * 16 + swz / 64; C = (st & 1) * 32 + (swz % 64) / 2; }
__host__ __device__ __forceinline__ int perm32(int rho) { const int n = rho >> 4, i = rho & 15; return 8 * (i >> 2) + 4 * n + (i & 3); }

struct Unit { int pm, pn; };
struct Gemm { const bf16_t* A; const bf16_t* Bt; int M, N, K, lda, ldb; };

struct StaticOrder {
    int nM, nN, nwg, G, c;
    __host__ __device__ void init(int M, int N, int G_, int c_) { nM = M / BM; nN = N / BM; nwg = nM * nN; G = G_; c = c_; }
    __host__ __device__ void init_tiles(int nM_, int nN_, int G_, int c_) { nM = nM_; nN = nN_; nwg = nM * nN; G = G_; c = c_; }
    __host__ __device__ bool next(int i, Unit& u) const {
        const long L = (long)i * G + c; if (L >= nwg) return false;
        int wgid = (int)L; { const int q = nwg / NXCD, r = nwg % NXCD, xcd = wgid % NXCD, off = wgid / NXCD; wgid = (xcd < r ? xcd * (q + 1) : r * (q + 1) + (xcd - r) * q) + off; }
        const int nig = WGM * nN, gid = wgid / nig, fm = gid * WGM, gsz = (nM - fm) < WGM ? (nM - fm) : WGM;
        u.pm = fm + ((wgid % nig) % gsz); u.pn = (wgid % nig) / gsz; return true;
    }
};

template <class F> struct EpiRow8 {
    static constexpr bool PERM = true, AFTER_DRAIN = false, MIDHOOK = false;
    F f;
    __device__ __forceinline__ void operator()(const f32x4 (&acc)[2][2][4][2], const Unit& u, int wr, int wc, int fr, int fq) const {
        const int row0 = u.pm * BM + wr * 64 + fr, col0 = u.pn * BM + wc * 32 + 8 * fq;
#pragma unroll
        for (int ai = 0; ai < 2; ++ai)
#pragma unroll
            for (int m = 0; m < 4; ++m) {
#pragma unroll
                for (int bj = 0; bj < 2; ++bj) f(row0 + ai * HALF + m * 16, col0 + bj * HALF, acc[ai][bj][m][0], acc[ai][bj][m][1]);
                if (m == 3) asm volatile("" ::: "memory");
            }
    }
};

template <class Epi, bool ALIGN_EPI = true, bool CONVMAP = false, int AKSPLIT = 0>
__device__ __forceinline__ void gemm_phase(LAS unsigned char* lds, const Gemm g, const StaticOrder& S, const Epi& E) {
    int tid_ = threadIdx.x; asm volatile("" : "+v"(tid_));
    const int tid = tid_, wid = __builtin_amdgcn_readfirstlane(tid >> 6), lane = tid & 63, wr = wid >> 2, wc = wid & 3, fr = lane & 15, fq = lane >> 4;
    const int K = g.K, nt = K / BK;
    unsigned voffA[2], voffB[2];
#pragma unroll
    for (int i = 0; i < 2; ++i) { int R, C; stage_rc(tid * 16 + i * 8192, R, C); const int Rb = Epi::PERM ? ((R & ~31) + perm32(R & 31)) : R;
        const int Ra = CONVMAP ? (126 * (R >> 6) + 8 * (R & 15) + ((R >> 4) & 3)) : R;
        voffA[i] = (unsigned)(Ra * g.lda + C) * 2u; voffB[i] = (unsigned)(Rb * g.ldb + C) * 2u; }
    const unsigned kstep = (unsigned)(BK * 2);
    const unsigned hstepA = (unsigned)(CONVMAP ? 4 : HALF) * g.lda * 2, hstepB = (unsigned)HALF * g.ldb * 2;
    const unsigned tstepA = CONVMAP ? 252u * g.lda * 2 : 2 * hstepA, tstepB = 2 * hstepB;
    const char* const baseA = (const char*)g.A; const char* const baseB = (const char*)g.Bt;
    const unsigned ldsw = (unsigned)wid * 1024u;
    const int aoff = lds_byte(wr * 64 + fr, fq * 8), boff = lds_byte(wc * 32 + fr, fq * 8);
#define PG8_SA(b, h) (((b) * 2 + (h)) * HTB)
#define PG8_SB(b, h) ((4 + (b) * 2 + (h)) * HTB)
#define PG8_STAGE(bufoff, goff, voff) do { _Pragma("unroll") for (int _i = 0; _i < 2; ++_i) { unsigned _vo = (voff)[_i] + (goff); asm volatile("" : "+v"(_vo)); \
        __builtin_amdgcn_global_load_lds((const unsigned*)(base_##voff + _vo), (LAS unsigned*)(lds + (bufoff) + ldsw + _i * 8192), 16, 0, 0); } } while (0)
#define base_voffA baseA
#define base_voffB baseB
#define PG8_LDA(dst, b, h) do { _Pragma("unroll") for (int m = 0; m < 4; ++m) _Pragma("unroll") for (int k = 0; k < 2; ++k) dst[m][k] = *(const LAS bf16x8*)(lds + PG8_SA(b, h) + aoff + m * 2048 + k * 1024); } while (0)
#define PG8_LDB(dst, b, h) do { _Pragma("unroll") for (int n = 0; n < 2; ++n) _Pragma("unroll") for (int k = 0; k < 2; ++k) dst[n][k] = *(const LAS bf16x8*)(lds + PG8_SB(b, h) + boff + n * 2048 + k * 1024); } while (0)
#define PG8_MMA(ai, bj, At, Bt) do { __builtin_amdgcn_s_setprio(1); _Pragma("unroll") for (int m = 0; m < 4; ++m) _Pragma("unroll") for (int n = 0; n < 2; ++n) _Pragma("unroll") for (int k = 0; k < 2; ++k) \
        acc[ai][bj][m][n] = __builtin_amdgcn_mfma_f32_16x16x32_bf16(Bt[n][k], At[m][k], acc[ai][bj][m][n], 0, 0, 0); __builtin_amdgcn_s_setprio(0); } while (0)
#define PG8_KOFFA(x) ((unsigned)(x) * kstep + (AKSPLIT ? ((x) < 4 ? 2048u : 0xFFFFFE00u) : 0u))
#define PG8_WAIT_V(n) asm volatile("s_waitcnt vmcnt(" #n ")" ::: "memory")
#define PG8_WAIT_L(n) asm volatile("s_waitcnt lgkmcnt(" #n ")" ::: "memory")
#define PG8_BAR __builtin_amdgcn_s_barrier()
#define PG8_SCHED __builtin_amdgcn_sched_barrier(0)
    Unit cur, nxt; int ui = 0;
    if (!S.next(0, cur)) return;
    f32x4 acc[2][2][4][2];
#pragma unroll
    for (int a = 0; a < 2; ++a)
#pragma unroll
        for (int b = 0; b < 2; ++b)
#pragma unroll
            for (int m = 0; m < 4; ++m)
#pragma unroll
                for (int n = 0; n < 2; ++n) acc[a][b][m][n] = (f32x4){0.f, 0.f, 0.f, 0.f};
    bf16x8 At[4][2], B0[2][2], B1[2][2];
    unsigned cA = (unsigned)cur.pm * tstepA, cB = (unsigned)cur.pn * tstepB;
    PG8_STAGE(PG8_SB(0, 0), cB, voffB); PG8_STAGE(PG8_SB(0, 1), cB + hstepB, voffB); PG8_STAGE(PG8_SA(0, 0), cA + PG8_KOFFA(0), voffA); PG8_STAGE(PG8_SA(0, 1), cA + hstepA + PG8_KOFFA(0), voffA);
    if (wr == 1) PG8_BAR;
    PG8_WAIT_V(2); PG8_BAR;
    PG8_STAGE(PG8_SB(1, 0), cB + kstep, voffB); PG8_STAGE(PG8_SA(1, 0), cA + PG8_KOFFA(1), voffA); PG8_STAGE(PG8_SB(1, 1), cB + hstepB + kstep, voffB);
    PG8_WAIT_V(6); PG8_BAR;
    for (;;) {
        const bool has_next = S.next(ui + 1, nxt);
        const unsigned nA = has_next ? (unsigned)nxt.pm * tstepA : cA, nB = has_next ? (unsigned)nxt.pn * tstepB : cB;
#define PG8_ITER(t) do { \
            const bool last = (t == nt - 2); \
            const unsigned a1 = cA + PG8_KOFFA(t + 1); \
            const unsigned a2 = last ? nA + PG8_KOFFA(0) : cA + PG8_KOFFA(t + 2), b2 = last ? nB : cB + (unsigned)(t + 2) * kstep; \
            const unsigned a3 = a2 + kstep, b3 = b2 + kstep; \
            PG8_LDB(B0, 0, 0); PG8_LDB(B1, 0, 1); PG8_SCHED; PG8_LDA(At, 0, 0); PG8_STAGE(PG8_SA(1, 1), a1 + hstepA, voffA); \
            PG8_WAIT_V(8); PG8_WAIT_L(0); PG8_BAR; PG8_MMA(0, 0, At, B0); PG8_MMA(0, 1, At, B1); PG8_BAR; PG8_SCHED; \
            PG8_LDA(At, 0, 1); PG8_STAGE(PG8_SB(0, 0), b2, voffB); PG8_STAGE(PG8_SB(0, 1), b2 + hstepB, voffB); PG8_STAGE(PG8_SA(0, 0), a2, voffA); \
            PG8_WAIT_V(8); PG8_WAIT_L(0); PG8_BAR; PG8_MMA(1, 0, At, B0); PG8_MMA(1, 1, At, B1); PG8_BAR; PG8_SCHED; \
            PG8_LDB(B0, 1, 0); PG8_LDB(B1, 1, 1); PG8_SCHED; PG8_LDA(At, 1, 0); PG8_STAGE(PG8_SA(0, 1), a2 + hstepA, voffA); \
            PG8_WAIT_V(8); PG8_WAIT_L(0); PG8_BAR; PG8_MMA(0, 0, At, B0); PG8_MMA(0, 1, At, B1); PG8_BAR; PG8_SCHED; \
            PG8_LDA(At, 1, 1); PG8_STAGE(PG8_SB(1, 0), b3, voffB); PG8_STAGE(PG8_SB(1, 1), b3 + hstepB, voffB); PG8_STAGE(PG8_SA(1, 0), a3, voffA); \
            PG8_WAIT_V(8); PG8_WAIT_L(0); PG8_BAR; PG8_MMA(1, 0, At, B0); PG8_MMA(1, 1, At, B1); PG8_BAR; PG8_SCHED; \
        } while (0)
        if constexpr (Epi::MIDHOOK) {
            for (int t = 0; t < 4; t += 2) PG8_ITER(t);
            E.mid(acc, cur, wr, wc, fr, fq);
            for (int t = 4; t < nt; t += 2) PG8_ITER(t);
        } else {
            for (int t = 0; t < nt; t += 2) PG8_ITER(t);
        }
#undef PG8_ITER
        if constexpr (ALIGN_EPI) { if (wr == 0) PG8_BAR; }
        if constexpr (!Epi::AFTER_DRAIN) { E(acc, cur, wr, wc, fr, fq); }
        if (!has_next) break;
#pragma unroll
        for (int a = 0; a < 2; ++a)
#pragma unroll
            for (int b = 0; b < 2; ++b)
#pragma unroll
                for (int m = 0; m < 4; ++m)
#pragma unroll
                    for (int n = 0; n < 2; ++n) acc[a][b][m][n] = (f32x4){0.f, 0.f, 0.f, 0.f};
        cur = nxt; cA = nA; cB = nB; ++ui;
        if constexpr (ALIGN_EPI) { if (wr == 1) PG8_BAR; }
    }
    PG8_WAIT_V(0);
    if constexpr (!ALIGN_EPI) { if (wr == 0) PG8_BAR; }
    PG8_BAR;
    if constexpr (Epi::AFTER_DRAIN) { E.fused(acc, cur, wr, wc, fr, fq, lds, wid, lane); }
#undef PG8_SA
#undef PG8_SB
#undef PG8_STAGE
#undef base_voffA
#undef base_voffB
#undef PG8_LDA
#undef PG8_LDB
#undef PG8_MMA
#undef PG8_WAIT_V
#undef PG8_KOFFA
#undef PG8_WAIT_L
#undef PG8_BAR
#undef PG8_SCHED
}
}


#define XB_TMO      128
#define XB_XCNT(j)  (256  + 64 * (j))
#define XB_XSUB(j)  (1280 + 64 * (j))
#define XB_XGEN(j)  (2304 + 64 * (j))
#define XB_TOP      3328
#define XB_TOPGEN   3392
#define XCD_BAR_WORDS 3456
#define XB_SPIN_CAP (1u << 18)
__device__ __forceinline__ unsigned xb_ld(unsigned* p)              { return __hip_atomic_load(p, __ATOMIC_RELAXED, __HIP_MEMORY_SCOPE_AGENT); }
__device__ __forceinline__ unsigned xb_add(unsigned* p, unsigned v) { return __hip_atomic_fetch_add(p, v, __ATOMIC_RELAXED, __HIP_MEMORY_SCOPE_AGENT); }
__device__ __forceinline__ unsigned xb_xcc_id() { return (unsigned)__builtin_amdgcn_s_getreg((3 << 11) | 20) & 0xFu; }
#define XB_SPIN(cond, bar) do { unsigned _sp = 0; while (cond) { __builtin_amdgcn_s_sleep(1); \
    if ((++_sp & 255u) == 0u) { if (xb_ld(&(bar)[XB_TMO])) break; if (_sp > XB_SPIN_CAP) { atomicAdd(&(bar)[XB_TMO], 1u); break; } } } } while (0)
struct XcdBarrier { unsigned* bar; unsigned x; volatile LAS unsigned* st; };
__device__ __forceinline__ XcdBarrier xcd_barrier_post(unsigned* bar, volatile LAS unsigned* st) {
    XcdBarrier b; b.bar = bar; b.x = xb_xcc_id(); b.st = st;
    if (threadIdx.x == 0) (void)xb_add(&bar[XB_XCNT(b.x)], 1u);
    return b;
}
__device__ __forceinline__ void xcd_barrier_complete(unsigned* bar, unsigned x, unsigned& nloc, unsigned& nx) {
    const unsigned G = gridDim.x * gridDim.y * gridDim.z;
    unsigned sum, cnt, mine, sp = 0u;
    for (;;) {
        sum = 0u; cnt = 0u; mine = 0u;
#pragma unroll
        for (unsigned j = 0; j < 16; ++j) { const unsigned c = xb_ld(&bar[XB_XCNT(j)]); sum += c; cnt += (c > 0u) ? 1u : 0u; mine = (j == x) ? c : mine; }
        if (sum == G) break;
        __builtin_amdgcn_s_sleep(1);
        if ((++sp & 255u) == 0u) { if (xb_ld(&bar[XB_TMO])) break; if (sp > XB_SPIN_CAP) { atomicAdd(&bar[XB_TMO], 1u); break; } }
    }
    nloc = mine > 0u ? mine : 1u; nx = cnt > 0u ? cnt : 1u;
}
__device__ __forceinline__ void xcd_barrier(const XcdBarrier& b) {
    asm volatile("s_waitcnt vmcnt(0)" ::: "memory");
    __syncthreads();
    if (threadIdx.x == 0) {
        unsigned* bar = b.bar;
        __builtin_amdgcn_s_waitcnt(0);
        unsigned nloc = b.st[0], nx = b.st[1];
        if (nloc == 0u) { xcd_barrier_complete(bar, b.x, nloc, nx); b.st[0] = nloc; b.st[1] = nx; }
        const unsigned old = xb_add(&bar[XB_XSUB(b.x)], 1u);
        const unsigned gen = old / nloc;
        if (old + 1u == (gen + 1u) * nloc) {
            __builtin_amdgcn_fence(__ATOMIC_RELEASE, "agent");
            asm volatile("s_waitcnt vmcnt(0)" ::: "memory");
            const unsigned og = xb_add(&bar[XB_TOP], 1u);
            const unsigned tg = og / nx;
            if (og + 1u == (tg + 1u) * nx) xb_add(&bar[XB_TOPGEN], 1u);
            else XB_SPIN(xb_ld(&bar[XB_TOPGEN]) == tg, bar);
            __builtin_amdgcn_fence(__ATOMIC_ACQUIRE, "agent");
            xb_add(&bar[XB_XGEN(b.x)], 1u);
            asm volatile("s_waitcnt vmcnt(0)" ::: "memory");
        } else {
            XB_SPIN(xb_ld(&bar[XB_XGEN(b.x)]) == gen, bar);
            __builtin_amdgcn_fence(__ATOMIC_ACQUIRE, "agent");
            asm volatile("s_waitcnt vmcnt(0)" ::: "memory");
        }
    }
    __syncthreads();
}

struct Args {
    const float* x; const float* c; const int* positions; const float* ada_w; const float* ada_b; const float* norm1_w; const float* w_in;
    const float* gate_w2; const float* gate_b; const float* gla_norm_w; const float* w_gla; const float* w_attn; const float* w_out; const float* norm2_w;
    const float* w_up; const float* conv_w; const float* conv_b; const float* w_down; const float* final_w;
    float* out; unsigned char* ws;
};

typedef const __attribute__((address_space(4))) Args* KArgs;
__device__ __forceinline__ KArgs kargs() { KArgs p = (KArgs)__builtin_amdgcn_kernarg_segment_ptr(); asm volatile("" : "+s"(p)); return p; }

struct Ctx { int tid, lane, wave, gtid, nthr, gw, ngw; LAS unsigned char* lds; };

__device__ __forceinline__ Ctx make_ctx(unsigned char* lds_raw) {
    Ctx X; int t = threadIdx.x; asm volatile("" : "+v"(t)); X.tid = t; X.lane = X.tid & 63; X.wave = __builtin_amdgcn_readfirstlane(X.tid >> 6);
    X.gtid = blockIdx.x * 512 + X.tid; X.nthr = gridDim.x * 512; X.gw = blockIdx.x * 8 + X.wave; X.ngw = gridDim.x * 8; X.lds = (LAS unsigned char*)lds_raw; return X; }

template <int ID, class F> __device__ __forceinline__ void run_gemm(const Ctx& X, const pg8::Gemm g, const F& f) {
    pg8::StaticOrder S; S.init(g.M, g.N, (int)gridDim.x, (int)blockIdx.x);
    pg8::EpiRow8<F> E{f};
    pg8::gemm_phase<pg8::EpiRow8<F>, true>(X.lds, g, S, E);
}

struct FStoreProj { bf16_t* O; const f32x2* rope;
    __device__ __forceinline__ void operator()(int row, int col, f32x4 v0, f32x4 v1) const {
        if (col >= C_AQ && col < C_AV) { const int g8 = ((col - C_AQ) & 63) >> 3; const f32x4* rp = (const f32x4*)(rope + (size_t)row * 32 + 4 * g8); const f32x4 r0 = rp[0], r1 = rp[1];
            const f32x4 cs = {r0[0], r0[2], r1[0], r1[2]}, sn = {r0[1], r0[3], r1[1], r1[3]}; const float sc = col < C_AK ? 0.125f * 1.44269504088896f : 1.0f;
            const f32x4 a0 = (v0 * cs - v1 * sn) * sc, a1 = (v1 * cs + v0 * sn) * sc; v0 = a0; v1 = a1; }
        u32x4 w; w.x = pk2(v0[0], v0[1]); w.y = pk2(v0[2], v0[3]); w.z = pk2(v1[0], v1[1]); w.w = pk2(v1[2], v1[3]);
        *(u32x4*)((char*)O + (unsigned)(row * NMAIN + col) * 2u) = w; } };
struct FSigmoidSplit { bf16_t* GA; bf16_t* GB;
    __device__ __forceinline__ void operator()(int row, int col, f32x4 v0, f32x4 v1) const {
        u32x4 w; w.x = pk2(sigmoidf_(v0[0]), sigmoidf_(v0[1])); w.y = pk2(sigmoidf_(v0[2]), sigmoidf_(v0[3])); w.z = pk2(sigmoidf_(v1[0]), sigmoidf_(v1[1])); w.w = pk2(sigmoidf_(v1[2]), sigmoidf_(v1[3]));
        if (col < 1024) *(u32x4*)((char*)GA + (unsigned)(row * DM + col) * 2u) = w; else *(u32x4*)((char*)GB + (unsigned)(row * NMAIN + (col - 1024)) * 2u) = w; } };
__device__ __forceinline__ f32x2 gelu_pk(f32x2 v) {
    const f32x2 av = __builtin_elementwise_abs(v), d = av * 0.2316418882f + 1.0f;
    f32x2 t; t.x = __builtin_amdgcn_rcpf(d.x); t.y = __builtin_amdgcn_rcpf(d.y);
    f32x2 q = t * 0.5307027145f + (-0.7265760135f); q = q * t + 0.7107068705f; q = q * t + (-0.142248368f); q = q * t + 0.127414796f; q = q * t;
    const f32x2 s = (v * v) * (-0.72134752044f);
    f32x2 e; e.x = __builtin_amdgcn_exp2f(s.x); e.y = __builtin_amdgcn_exp2f(s.y);
    const f32x2 m = av * (q * e);
    f32x2 o; o.x = fmaxf(v.x, 0.f) - m.x; o.y = fmaxf(v.y, 0.f) - m.y; return o;
}
__device__ __forceinline__ f32x4 dpp_shr1(f32x4 x) {
    f32x4 r;
#pragma unroll
    for (int j = 0; j < 4; ++j) r[j] = __int_as_float(__builtin_amdgcn_update_dpp(0, __float_as_int(x[j]), 0x111, 0xf, 0xf, false));
    return r;
}
struct EpiConvGeglu {
    static constexpr bool PERM = true, AFTER_DRAIN = false, MIDHOOK = false;
    bf16_t* hidden; const float* conv_w; const float* conv_b;
    template <bool EDGE> __device__ __forceinline__ void body(const f32x4 (&acc)[2][2][4][2], const pg8::Unit& u, int wr, int wc, int fr, int fq) const {
        const int tw0 = 252 * u.pm - 2 + 126 * wr;
        const int chb = 128 * u.pn + 32 * wc + 8 * fq;
#pragma unroll
        for (int n = 0; n < 2; ++n) {
            const int ch = chb + 4 * n;
            const f32x4 wv0 = *(const f32x4*)(conv_w + ch), wv1 = *(const f32x4*)(conv_w + NUP + ch), wv2 = *(const f32x4*)(conv_w + 2 * NUP + ch), bv = *(const f32x4*)(conv_b + ch);
            const f32x4 wg0 = *(const f32x4*)(conv_w + DFF + ch), wg1 = *(const f32x4*)(conv_w + NUP + DFF + ch), wg2 = *(const f32x4*)(conv_w + 2 * NUP + DFF + ch), bg = *(const f32x4*)(conv_b + DFF + ch);
            const f32x4 v7 = dpp_shr1(acc[1][0][3][n]), v6 = dpp_shr1(acc[1][0][2][n]), g7 = dpp_shr1(acc[1][1][3][n]), g6 = dpp_shr1(acc[1][1][2][n]);
#pragma unroll
            for (int k = 0; k < 8; ++k) {
                const int ai = k >> 2, m = k & 3, lr = 8 * fr + k, tau = tw0 + lr, sp = tau & 4095;
                const f32x4 cv = acc[ai][0][m][n], cg = acc[ai][1][m][n];
                const f32x4 p1v = k >= 1 ? acc[(k >= 1 ? k - 1 : 0) >> 2][0][(k >= 1 ? k - 1 : 0) & 3][n] : v7;
                const f32x4 p1g = k >= 1 ? acc[(k >= 1 ? k - 1 : 0) >> 2][1][(k >= 1 ? k - 1 : 0) & 3][n] : g7;
                const f32x4 p2v = k >= 2 ? acc[(k >= 2 ? k - 2 : 0) >> 2][0][(k >= 2 ? k - 2 : 0) & 3][n] : (k == 1 ? v7 : v6);
                const f32x4 p2g = k >= 2 ? acc[(k >= 2 ? k - 2 : 0) >> 2][1][(k >= 2 ? k - 2 : 0) & 3][n] : (k == 1 ? g7 : g6);
                f32x4 val, gat;
                if (EDGE) { const float m1 = sp >= 1 ? 1.f : 0.f, m2 = sp >= 2 ? 1.f : 0.f;
                    val = bv + wv2 * cv + (wv1 * m1) * p1v + (wv0 * m2) * p2v; gat = bg + wg2 * cg + (wg1 * m1) * p1g + (wg0 * m2) * p2g; }
                else { val = bv + wv2 * cv + wv1 * p1v + wv0 * p2v; gat = bg + wg2 * cg + wg1 * p1g + wg0 * p2g; }
                const f32x2 g01 = gelu_pk((f32x2){gat[0], gat[1]}), g23 = gelu_pk((f32x2){gat[2], gat[3]});
                u32x2 w; w.x = pk2(g01.x * val[0], g01.y * val[1]); w.y = pk2(g23.x * val[2], g23.y * val[3]);
                if (lr >= 2 && (!EDGE || tau < NT)) *(u32x2*)((char*)hidden + (unsigned)(tau * DFF + ch) * 2u) = w;
            }
            asm volatile("" ::: "memory");
        }
    }
    __device__ __forceinline__ void operator()(const f32x4 (&acc)[2][2][4][2], const pg8::Unit& u, int wr, int wc, int fr, int fq) const {
        const int tw0 = 252 * u.pm - 2 + 126 * wr;
        const bool edge = (tw0 <= 1) || ((tw0 & 4095) < 2) || (((tw0 + 127) >> 12) != (tw0 >> 12)) || (tw0 + 127 >= NT);
        if (edge) body<true>(acc, u, wr, wc, fr, fq); else body<false>(acc, u, wr, wc, fr, fq);
    }
};

struct EpiMixed2 {
    static constexpr bool PERM = true, AFTER_DRAIN = false, MIDHOOK = true;
    const bf16_t* gA; const bf16_t* gB; bf16_t* O;
    __device__ __forceinline__ void mid(f32x4 (&acc)[2][2][4][2], const pg8::Unit& u, int wr, int wc, int fr, int fq) const {
        const int row0 = u.pm * 256 + wr * 64 + fr, col0 = u.pn * 256 + wc * 32 + 8 * fq;
#pragma unroll
        for (int ai = 0; ai < 2; ++ai)
#pragma unroll
            for (int m = 0; m < 4; ++m) { const int row = row0 + ai * 128 + m * 16;
#pragma unroll
                for (int bj = 0; bj < 2; ++bj) { const int col = col0 + bj * 128;
                    const u32x4 aw = *(const u32x4*)((const char*)gA + (unsigned)(row * DM + col) * 2u), bw = *(const u32x4*)((const char*)gB + (unsigned)(row * NMAIN + col) * 2u);
                    f32x4 r0, r1;
                    r0[0] = lo16(bw.x) * __builtin_amdgcn_rcpf(fmaxf(lo16(aw.x), 1e-20f)); r0[1] = hi16(bw.x) * __builtin_amdgcn_rcpf(fmaxf(hi16(aw.x), 1e-20f));
                    r0[2] = lo16(bw.y) * __builtin_amdgcn_rcpf(fmaxf(lo16(aw.y), 1e-20f)); r0[3] = hi16(bw.y) * __builtin_amdgcn_rcpf(fmaxf(hi16(aw.y), 1e-20f));
                    r1[0] = lo16(bw.z) * __builtin_amdgcn_rcpf(fmaxf(lo16(aw.z), 1e-20f)); r1[1] = hi16(bw.z) * __builtin_amdgcn_rcpf(fmaxf(hi16(aw.z), 1e-20f));
                    r1[2] = lo16(bw.w) * __builtin_amdgcn_rcpf(fmaxf(lo16(aw.w), 1e-20f)); r1[3] = hi16(bw.w) * __builtin_amdgcn_rcpf(fmaxf(hi16(aw.w), 1e-20f));
                    acc[ai][bj][m][0] *= r0; acc[ai][bj][m][1] *= r1;
                    asm volatile("" ::: "memory"); } }
    }
    __device__ __forceinline__ void operator()(const f32x4 (&acc)[2][2][4][2], const pg8::Unit& u, int wr, int wc, int fr, int fq) const {
        const int row0 = u.pm * 256 + wr * 64 + fr, col0 = u.pn * 256 + wc * 32 + 8 * fq;
#pragma unroll
        for (int ai = 0; ai < 2; ++ai) {
#pragma unroll
            for (int m = 0; m < 4; ++m) { const int row = row0 + ai * 128 + m * 16;
#pragma unroll
                for (int bj = 0; bj < 2; ++bj) { const int col = col0 + bj * 128; float a8[8]; unpack8(*(const u32x4*)((const char*)gA + (unsigned)(row * DM + col) * 2u), a8);
                    const f32x4 v0 = acc[ai][bj][m][0], v1 = acc[ai][bj][m][1];
                    float o[8] = {v0[0] * a8[0], v0[1] * a8[1], v0[2] * a8[2], v0[3] * a8[3], v1[0] * a8[4], v1[1] * a8[5], v1[2] * a8[6], v1[3] * a8[7]};
                    *(u32x4*)((char*)O + (unsigned)(row * DM + col) * 2u) = pack8(o); } }
            asm volatile("" ::: "memory");
        }
    }
};

struct RmsPanel {
    float* xbuf;
    unsigned* cnt;
    __device__ __forceinline__ void run(const pg8::Unit& u, LAS unsigned char* lds, int wid, int lane) const {
        LAS float* P = (LAS float*)lds; LAS float* S = (LAS float*)(lds + 4096);
        asm volatile("s_waitcnt lgkmcnt(0)" ::: "memory"); __builtin_amdgcn_s_barrier(); asm volatile("" ::: "memory");
        const int row = wid * 32 + (lane & 31);
        if (lane < 32) { const float tot = (P[row * 4 + 0] + P[row * 4 + 1]) + (P[row * 4 + 2] + P[row * 4 + 3]);
            __hip_atomic_store(xbuf + (size_t)(u.pm * 256 + row) * 4 + u.pn, tot, __ATOMIC_RELAXED, __HIP_MEMORY_SCOPE_AGENT); }
        asm volatile("s_waitcnt vmcnt(0)" ::: "memory");
        if (lane == 0) __hip_atomic_fetch_add(cnt + 64 * u.pm, 1u, __ATOMIC_RELAXED, __HIP_MEMORY_SCOPE_AGENT);
        if (wid == 0) { unsigned sp = 0;
            for (;;) { if ((unsigned)__builtin_amdgcn_readfirstlane(__hip_atomic_load(cnt + 64 * u.pm, __ATOMIC_RELAXED, __HIP_MEMORY_SCOPE_AGENT)) >= 32u) break;
                if (++sp > (1u << 22)) break; __builtin_amdgcn_s_sleep(2); }
            __builtin_amdgcn_fence(__ATOMIC_ACQUIRE, "agent"); }
        asm volatile("s_waitcnt vmcnt(0) lgkmcnt(0)" ::: "memory"); __builtin_amdgcn_s_barrier(); asm volatile("" ::: "memory");
        if (lane < 32) { const float* slot = xbuf + (size_t)(u.pm * 256 + row) * 4; float q = 0.f;
#pragma unroll
            for (int t = 0; t < 4; ++t) q += __hip_atomic_load(slot + t, __ATOMIC_RELAXED, __HIP_MEMORY_SCOPE_AGENT);
            S[row] = 1.0f / sqrtf(q * (1.0f / 1024.0f) + EPS); }
        asm volatile("s_waitcnt lgkmcnt(0)" ::: "memory"); __builtin_amdgcn_s_barrier(); asm volatile("" ::: "memory");
    }
};
struct EpiResNorm {
    static constexpr bool PERM = true, AFTER_DRAIN = true, MIDHOOK = false;
    const float* base; bf16_t* x1b; bf16_t* hn; const float* mod; const float* nw; RmsPanel st;
    __device__ __forceinline__ void fused(f32x4 (&acc)[2][2][4][2], const pg8::Unit& u, int wr, int wc, int fr, int fq, LAS unsigned char* lds, int wid, int lane) const {
        const int col0 = u.pn * 256 + wc * 32 + 8 * fq, b = (u.pm * 256) >> 12; const float* mb = mod + (size_t)b * 6144;
        { LAS float* P = (LAS float*)lds;
          f32x4 gg[2][2];
#pragma unroll
          for (int bj = 0; bj < 2; ++bj) { gg[bj][0] = *(const f32x4*)(mb + 2048 + col0 + bj * 128); gg[bj][1] = *(const f32x4*)(mb + 2048 + col0 + bj * 128 + 4); }
          f32x4 nb[2][2];
          { const float* bp = base + (size_t)(u.pm * 256 + wr * 64 + fr) * DM + col0;
#pragma unroll
            for (int bj = 0; bj < 2; ++bj) { nb[bj][0] = __builtin_nontemporal_load((const f32x4*)(bp + bj * 128)); nb[bj][1] = __builtin_nontemporal_load((const f32x4*)(bp + bj * 128 + 4)); } }
#pragma unroll
          for (int k = 0; k < 8; ++k) { const int ai = k >> 2, m = k & 3, r = ai * 128 + wr * 64 + m * 16 + fr; float s = 0.f;
              f32x4 cb[2][2];
#pragma unroll
              for (int bj = 0; bj < 2; ++bj) { cb[bj][0] = nb[bj][0]; cb[bj][1] = nb[bj][1]; }
              if (k < 7) { const int k2 = k + 1; const float* bp = base + (size_t)(u.pm * 256 + (k2 >> 2) * 128 + wr * 64 + (k2 & 3) * 16 + fr) * DM + col0;
#pragma unroll
                  for (int bj = 0; bj < 2; ++bj) { nb[bj][0] = __builtin_nontemporal_load((const f32x4*)(bp + bj * 128)); nb[bj][1] = __builtin_nontemporal_load((const f32x4*)(bp + bj * 128 + 4)); } }
#pragma unroll
              for (int bj = 0; bj < 2; ++bj) { const f32x4 x0 = cb[bj][0] + gg[bj][0] * acc[ai][bj][m][0], x1 = cb[bj][1] + gg[bj][1] * acc[ai][bj][m][1];
                  acc[ai][bj][m][0] = x0; acc[ai][bj][m][1] = x1;
                  s += ((x0[0] * x0[0] + x0[1] * x0[1]) + (x0[2] * x0[2] + x0[3] * x0[3])) + ((x1[0] * x1[0] + x1[1] * x1[1]) + (x1[2] * x1[2] + x1[3] * x1[3])); }
              s += __shfl_xor(s, 16); s += __shfl_xor(s, 32);
              if (fq == 0) P[r * 4 + wc] = s;
              asm volatile("" ::: "memory"); } }
        st.run(u, lds, wid, lane);
        const LAS float* S = (const LAS float*)(lds + 4096);
#pragma unroll
        for (int bj = 0; bj < 2; ++bj) { const int col = col0 + bj * 128;
            f32x4 g2[2], s2[2];
#pragma unroll
            for (int n = 0; n < 2; ++n) { g2[n] = *(const f32x4*)(nw + col + 4 * n) * (*(const f32x4*)(mb + 4096 + col + 4 * n) + 1.0f); s2[n] = *(const f32x4*)(mb + 3072 + col + 4 * n); }
#pragma unroll
            for (int ai = 0; ai < 2; ++ai)
#pragma unroll
                for (int m = 0; m < 4; ++m) { const int r = ai * 128 + wr * 64 + m * 16 + fr; const float rstd = S[r]; const size_t off = (size_t)(u.pm * 256 + r) * DM + col;
                    { u32x4 xw; xw.x = pk2(acc[ai][bj][m][0][0], acc[ai][bj][m][0][1]); xw.y = pk2(acc[ai][bj][m][0][2], acc[ai][bj][m][0][3]); xw.z = pk2(acc[ai][bj][m][1][0], acc[ai][bj][m][1][1]); xw.w = pk2(acc[ai][bj][m][1][2], acc[ai][bj][m][1][3]);
                      *(u32x4*)(x1b + off) = xw; }
                    const f32x4 y0 = acc[ai][bj][m][0] * rstd * g2[0] + s2[0], y1 = acc[ai][bj][m][1] * rstd * g2[1] + s2[1];
                    u32x4 w; w.x = pk2(y0[0], y0[1]); w.y = pk2(y0[2], y0[3]); w.z = pk2(y1[0], y1[1]); w.w = pk2(y1[2], y1[3]);
                    *(u32x4*)(hn + off) = w; } }
    }
};
struct EpiResFinal {
    static constexpr bool PERM = true, AFTER_DRAIN = true, MIDHOOK = false;
    const bf16_t* x1b; float* out; const float* mod; const float* fw; RmsPanel st;
    __device__ __forceinline__ void fused(f32x4 (&acc)[2][2][4][2], const pg8::Unit& u, int wr, int wc, int fr, int fq, LAS unsigned char* lds, int wid, int lane) const {
        const int col0 = u.pn * 256 + wc * 32 + 8 * fq, b = (u.pm * 256) >> 12; const float* mb = mod + (size_t)b * 6144;
        { LAS float* P = (LAS float*)lds;
          f32x4 gg[2][2];
#pragma unroll
          for (int bj = 0; bj < 2; ++bj) { gg[bj][0] = *(const f32x4*)(mb + 5120 + col0 + bj * 128); gg[bj][1] = *(const f32x4*)(mb + 5120 + col0 + bj * 128 + 4); }
          u32x4 nb[2];
          { const bf16_t* bp = x1b + (size_t)(u.pm * 256 + wr * 64 + fr) * DM + col0;
#pragma unroll
            for (int bj = 0; bj < 2; ++bj) nb[bj] = __builtin_nontemporal_load((const u32x4*)(bp + bj * 128)); }
#pragma unroll
          for (int k = 0; k < 8; ++k) { const int ai = k >> 2, m = k & 3, r = ai * 128 + wr * 64 + m * 16 + fr; float s = 0.f;
              f32x4 cb[2][2];
#pragma unroll
              for (int bj = 0; bj < 2; ++bj) { cb[bj][0] = (f32x4){lo16(nb[bj].x), hi16(nb[bj].x), lo16(nb[bj].y), hi16(nb[bj].y)}; cb[bj][1] = (f32x4){lo16(nb[bj].z), hi16(nb[bj].z), lo16(nb[bj].w), hi16(nb[bj].w)}; }
              if (k < 7) { const int k2 = k + 1; const bf16_t* bp = x1b + (size_t)(u.pm * 256 + (k2 >> 2) * 128 + wr * 64 + (k2 & 3) * 16 + fr) * DM + col0;
#pragma unroll
                  for (int bj = 0; bj < 2; ++bj) nb[bj] = __builtin_nontemporal_load((const u32x4*)(bp + bj * 128)); }
#pragma unroll
              for (int bj = 0; bj < 2; ++bj) { const f32x4 x0 = cb[bj][0] + gg[bj][0] * acc[ai][bj][m][0], x1 = cb[bj][1] + gg[bj][1] * acc[ai][bj][m][1];
                  acc[ai][bj][m][0] = x0; acc[ai][bj][m][1] = x1;
                  s += ((x0[0] * x0[0] + x0[1] * x0[1]) + (x0[2] * x0[2] + x0[3] * x0[3])) + ((x1[0] * x1[0] + x1[1] * x1[1]) + (x1[2] * x1[2] + x1[3] * x1[3])); }
              s += __shfl_xor(s, 16); s += __shfl_xor(s, 32);
              if (fq == 0) P[r * 4 + wc] = s;
              asm volatile("" ::: "memory"); } }
        st.run(u, lds, wid, lane);
        const LAS float* S = (const LAS float*)(lds + 4096);
#pragma unroll
        for (int bj = 0; bj < 2; ++bj) { const int col = col0 + bj * 128; const f32x4 w0 = *(const f32x4*)(fw + col), w1 = *(const f32x4*)(fw + col + 4);
#pragma unroll
            for (int ai = 0; ai < 2; ++ai)
#pragma unroll
                for (int m = 0; m < 4; ++m) { const int r = ai * 128 + wr * 64 + m * 16 + fr; const float rstd = S[r]; const size_t off = (size_t)(u.pm * 256 + r) * DM + col;
                    __builtin_nontemporal_store(acc[ai][bj][m][0] * rstd * w0, (f32x4*)(out + off)); __builtin_nontemporal_store(acc[ai][bj][m][1] * rstd * w1, (f32x4*)(out + off + 4)); } }
    }
};

__device__ __forceinline__ void transpose_item(const float* W, int ldw, int col0, int K, bf16_t* WT, int drow0, int k0, int n0, LAS float* scr, int lane, int perm = 0, int d0 = 0) {
#pragma unroll 8
    for (int i = 0; i < 32; ++i) { const int kk = 2 * i + (lane >> 5); scr[kk * 33 + (lane & 31)] = __builtin_nontemporal_load(&W[(size_t)(k0 + kk) * ldw + col0 + n0 + (lane & 31)]); }
    asm volatile("s_waitcnt lgkmcnt(0)" ::: "memory");
    const int c = lane & 7;
#pragma unroll
    for (int j = 0; j < 4; ++j) { const int n = (lane >> 3) + 8 * j; const LAS float* s = scr + (8 * c) * 33 + n;
        u32x4 o; o.x = pk2(s[0 * 33], s[1 * 33]); o.y = pk2(s[2 * 33], s[3 * 33]); o.z = pk2(s[4 * 33], s[5 * 33]); o.w = pk2(s[6 * 33], s[7 * 33]);
        const int drow = perm ? (drow0 + 8 * (n >> 2) + (n & 3) + (d0 ? 4 : 0)) : (drow0 + n);
        *(u32x4*)(WT + (size_t)drow * K + k0 + 8 * c) = o; }
    asm volatile("s_waitcnt lgkmcnt(0)" ::: "memory");
}

__device__ __forceinline__ void phase0_transposes(const Ctx& X, KArgs a, int it0, int it1, int gw, int ngw) {
    unsigned char* ws = a->ws;
    LAS float* scr = (LAS float*)(X.lds + X.wave * 16384);
    constexpr int I1 = 16 * 96, I2 = 16 * 72, I3 = 16 * 64, I4 = 16 * 32, I5 = 4 * 32, I6 = 16 * 32, I7 = 16 * 176, I8 = 44 * 32;
    constexpr int NITEMS = I1 + I2 + I3 + I4 + I5 + I6 + I7 + I8;
    for (int it = it0 + gw; it < (it1 < 0 ? NITEMS : it1); it += ngw) {
        int r = it;
        if (r < I1) { const int nb = r % 96, kb = r / 96; transpose_item(a->w_in, DIN, 0, DM, (bf16_t*)(ws + WS_WMAIN), nb * 32, kb * 64, nb * 32, scr, X.lane); continue; } r -= I1;
        if (r < I2) { const int nb = r % 72, kb = r / 72; const bool rot = nb < 48;
            transpose_item(a->w_in, DIN, 3088, DM, (bf16_t*)(ws + WS_WMAIN), rot ? 3072 + (nb >> 1) * 64 : 3072 + nb * 32, kb * 64, nb * 32, scr, X.lane, rot ? 1 : 0, (nb & 1) * 32); continue; } r -= I2;
        if (r < I3) { const int nb = r % 64, kb = r / 64; transpose_item(a->w_in, DIN, 5392, DM, (bf16_t*)(ws + WS_WMAB), nb * 32, kb * 64, nb * 32, scr, X.lane); continue; } r -= I3;
        if (r < I4) { const int nb = r % 32, kb = r / 32; transpose_item(a->w_gla, DM, 0, 1280, (bf16_t*)(ws + WS_WG) + 256, nb * 32, kb * 64, nb * 32, scr, X.lane); continue; } r -= I4;
        if (r < I5) { const int nb = r % 32, kb = r / 32; transpose_item(a->w_attn, DM, 0, 1280, (bf16_t*)(ws + WS_WG), nb * 32, kb * 64, nb * 32, scr, X.lane); continue; } r -= I5;
        if (r < I6) { const int nb = r % 32, kb = r / 32; transpose_item(a->w_out, DM, 0, DM, (bf16_t*)(ws + WS_WOUT), nb * 32, kb * 64, nb * 32, scr, X.lane); continue; } r -= I6;
        if (r < I7) { const int nb = r % 176, kb = r / 176; const int n0 = nb * 32; const int ch = n0 % DFF; const int drow = (ch / 128) * 256 + (n0 >= DFF ? 128 : 0) + (ch % 128);
            transpose_item(a->w_up, NUP, 0, DM, (bf16_t*)(ws + WS_WUP), drow, kb * 64, n0, scr, X.lane); continue; } r -= I7;
        { const int nb = r % 32, kb = r / 32; transpose_item(a->w_down, DM, 0, DFF, (bf16_t*)(ws + WS_WDOWN), nb * 32, kb * 64, nb * 32, scr, X.lane); }
    }
}

__device__ __forceinline__ void phase0(const Ctx& X, KArgs a) {
    unsigned char* ws = a->ws;
    { bf16_t* wlr = (bf16_t*)(ws + WS_WLR);
      for (int idx = X.gtid; idx < 16 * DM; idx += X.nthr) { const int j = idx >> 10, k = idx & 1023; wlr[idx] = (bf16_t)f2bf(a->w_in[(size_t)k * DIN + 3072 + j]); } }
    { float* modp = (float*)(ws + WS_MODP);
      for (int u = X.gw; u < 96 * 32; u += X.ngw) { const int cgp = u % 96, kc = u / 96, j = cgp * 64 + X.lane;
          float w[32];
#pragma unroll
          for (int kk = 0; kk < 32; ++kk) w[kk] = __builtin_nontemporal_load(&a->ada_w[(size_t)(kc * 32 + kk) * 6144 + j]);
          const float cA = a->c[(X.lane >> 5) * DM + kc * 32 + (X.lane & 31)], cB = a->c[((X.lane >> 5) + 2) * DM + kc * 32 + (X.lane & 31)];
          const int sA = __float_as_int(cA / (1.0f + __expf(-cA))), sB = __float_as_int(cB / (1.0f + __expf(-cB)));
          float acc[4] = {0.f, 0.f, 0.f, 0.f};
#pragma unroll
          for (int kk = 0; kk < 32; ++kk) {
              acc[0] += __int_as_float(__builtin_amdgcn_readlane(sA, kk)) * w[kk]; acc[1] += __int_as_float(__builtin_amdgcn_readlane(sA, 32 + kk)) * w[kk];
              acc[2] += __int_as_float(__builtin_amdgcn_readlane(sB, kk)) * w[kk]; acc[3] += __int_as_float(__builtin_amdgcn_readlane(sB, 32 + kk)) * w[kk]; }
#pragma unroll
          for (int b = 0; b < 4; ++b) modp[(size_t)(kc * 4 + b) * 6144 + j] = acc[b]; } }
    { f32x2* rope = (f32x2*)(ws + WS_ROPE);
      for (int idx = X.gtid; idx < NT * 32; idx += X.nthr) { const int t = idx >> 5, i = idx & 31;
          const double rev = (double)a->positions[t] * INVF_REV[i]; const float fr = (float)(rev - floor(rev));
          rope[idx] = (f32x2){__builtin_amdgcn_cosf(fr), __builtin_amdgcn_sinf(fr)}; } }
}

template <int MODE> __device__ __forceinline__ void norm_pass(const Ctx& X, KArgs a, const float* xin, bf16_t* hout, float* fout) {
    unsigned char* ws = a->ws;
    const float* modp = (const float*)(ws + WS_MODP); float* mod = (float*)(ws + WS_MOD);
    if (MODE == 0) { for (int idx = X.gtid; idx < 4 * 6144; idx += X.nthr) { const int b = idx / 6144, j = idx % 6144; float s = a->ada_b[j];
            float pv[32];
#pragma unroll
            for (int kc = 0; kc < 32; ++kc) pv[kc] = modp[(size_t)(kc * 4 + b) * 6144 + j];
#pragma unroll
            for (int kc = 0; kc < 32; ++kc) s += pv[kc];
            mod[idx] = s; } }
    LAS float* gs = (LAS float*)X.lds;
    LAS bf16_t* hs = (LAS bf16_t*)(X.lds + 8192);
    for (int rt = blockIdx.x; rt < NT / 64; rt += gridDim.x) {
        const int row0 = rt * 64, b = row0 >> 12;
        __syncthreads();
        for (int idx = X.tid; idx < DM; idx += 512) {
            float g, s;
            if (MODE == 0) { float sc = a->ada_b[1024 + idx], sh = a->ada_b[idx];
                float pa[32], pb[32];
#pragma unroll
                for (int kc = 0; kc < 32; ++kc) { pa[kc] = modp[(size_t)(kc * 4 + b) * 6144 + 1024 + idx]; pb[kc] = modp[(size_t)(kc * 4 + b) * 6144 + idx]; }
#pragma unroll
                for (int kc = 0; kc < 32; ++kc) { sc += pa[kc]; sh += pb[kc]; }
                g = a->norm1_w[idx] * (1.0f + sc); s = sh; }
            else if (MODE == 1) { g = a->norm2_w[idx] * (1.0f + mod[b * 6144 + 4096 + idx]); s = mod[b * 6144 + 3072 + idx]; }
            else { g = a->final_w[idx]; s = 0.f; }
            gs[idx] = g; gs[1024 + idx] = s;
        }
        __syncthreads();
#pragma unroll 1
        for (int rb = 0; rb < 8; rb += 4) {
            f32x4 v[4][4];
#pragma unroll
            for (int r = 0; r < 4; ++r) { const f32x4* xr = (const f32x4*)(xin + (size_t)(row0 + X.wave * 8 + rb + r) * DM) + X.lane;
#pragma unroll
                for (int j = 0; j < 4; ++j) v[r][j] = __builtin_nontemporal_load(xr + 64 * j); }
#pragma unroll
            for (int r = 0; r < 4; ++r) {
                const int lr = X.wave * 8 + rb + r, row = row0 + lr;
                float ss = 0.f;
#pragma unroll
                for (int j = 0; j < 4; ++j) ss += (v[r][j][0] * v[r][j][0] + v[r][j][1] * v[r][j][1]) + (v[r][j][2] * v[r][j][2] + v[r][j][3] * v[r][j][3]);
                const float rstd = 1.0f / sqrtf(wave_sum(ss) * (1.0f / DM) + EPS);
#pragma unroll
                for (int j = 0; j < 4; ++j) { const int k = 4 * X.lane + 256 * j;
                    const f32x4 g = *(const LAS f32x4*)(gs + k), sft = *(const LAS f32x4*)(gs + 1024 + k);
                    const f32x4 y = v[r][j] * rstd * g + sft;
                    if (MODE == 2) { *((f32x4*)(fout + (size_t)row * DM) + X.lane + 64 * j) = y; }
                    else { u32x2 w; w.x = pk2(y[0], y[1]); w.y = pk2(y[2], y[3]);
                        *(u32x2*)(hout + (size_t)row * DM + k) = w;
                        if (MODE == 0) *(LAS u32x2*)(hs + lr * 1032 + k) = w; } }
            }
        }
        if (MODE == 0) {
            __syncthreads();
            const bf16_t* wlr = (const bf16_t*)(ws + WS_WLR);
            const int mt = X.wave & 3, kh = X.wave >> 2, fr = X.lane & 15, fq = X.lane >> 4;
            f32x4 acc = {0.f, 0.f, 0.f, 0.f};
#pragma unroll 4
            for (int ks = 0; ks < 16; ++ks) { const int k0 = kh * 512 + ks * 32 + 8 * fq;
                const bf16x8 av = *(const LAS bf16x8*)(hs + (16 * mt + fr) * 1032 + k0);
                const bf16x8 bv = *(const bf16x8*)(wlr + fr * 1024 + k0);
                acc = __builtin_amdgcn_mfma_f32_16x16x32_bf16(av, bv, acc, 0, 0, 0); }
            LAS f32x4* red = (LAS f32x4*)X.lds;
            if (kh == 1) red[mt * 64 + X.lane] = acc;
            __syncthreads();
            if (kh == 0) { const f32x4 o = acc + red[mt * 64 + X.lane]; float* glr = (float*)(ws + WS_GLR);
#pragma unroll
                for (int e = 0; e < 4; ++e) glr[(size_t)(row0 + 16 * mt + 4 * fq + e) * 16 + fr] = o[e]; }
        }
    }
}

constexpr int QP = 72, VP = 264;
__device__ __forceinline__ void attn_mfma(const Ctx& X, KArgs a, int dry = 0) {
    bf16_t* proj = (bf16_t*)(a->ws + WS_BIG); const f32x2* rope = (const f32x2*)(a->ws + WS_ROPE); float* lse = (float*)(a->ws + WS_LSE);
    LAS bf16_t* Qs = (LAS bf16_t*)X.lds; LAS bf16_t* Ks = (LAS bf16_t*)(X.lds + 128 * QP * 2); LAS bf16_t* Vt = (LAS bf16_t*)(X.lds + 384 * QP * 2);
    const int fr = X.lane & 15, fq = X.lane >> 4, w = X.wave, i0 = 16 * w;
    const int vcu = ((gridDim.x & 7) == 0) ? (int)((blockIdx.x & 7) * (gridDim.x >> 3) + (blockIdx.x >> 3)) : (int)blockIdx.x;
    const int per = (1536 + (int)gridDim.x - 1) / (int)gridDim.x, u0 = vcu * per, u1 = (u0 + per < 1536) ? u0 + per : 1536;
    int cur_half = 1;
    for (int unit = u0; unit < u1; ++unit) {
        const int b = unit / 384, rem = unit % 384, h = rem >> 5, pn = rem & 31, g = h >> 2, hg = h & 3;
        const int r = (g == 0) ? 1 : (g == 1 ? 4 : 16), nblk = 32 / r, p = pn / nblk, n = pn % nblk;
        const int tb = b * SEQ + p;
        const bool reuse = (unit > u0) && (n >= 1);
        if (reuse) cur_half ^= 1;
        const int prev_half = cur_half ^ 1;
        __syncthreads();
        { const int i = X.tid >> 2, c = X.tid & 3; const int t = tb + (128 * n + i) * r; const bf16_t* src = proj + (size_t)t * NMAIN + C_AQ + h * 64 + 16 * c;
          *(LAS u32x4*)(Qs + i * QP + 16 * c) = *(const u32x4*)src; *(LAS u32x4*)(Qs + i * QP + 16 * c + 8) = *(const u32x4*)(src + 8); }
        for (int blk = reuse ? 1 : 0; blk < 2; ++blk) {
            const int half = blk ? cur_half : prev_half;
            { const int j = X.tid >> 2, c = X.tid & 3; int m = 128 * (n - 1 + blk) + j; m = m < 0 ? 0 : m; const int t = tb + m * r;
              const bf16_t* src = proj + (size_t)t * NMAIN + C_AK + h * 64 + 16 * c;
              *(LAS u32x4*)(Ks + (half * 128 + j) * QP + 16 * c) = *(const u32x4*)src; *(LAS u32x4*)(Ks + (half * 128 + j) * QP + 16 * c + 8) = *(const u32x4*)(src + 8); }
#pragma unroll
            for (int q = 0; q < 2; ++q) { const int idx = X.tid + 512 * q, j = idx & 127, c = idx >> 7; int m = 128 * (n - 1 + blk) + j; m = m < 0 ? 0 : m; const int t = tb + m * r;
                const u32x4 wv = *(const u32x4*)(proj + (size_t)t * NMAIN + C_AV + h * 64 + 8 * c);
                LAS bf16_t* vp = Vt + (8 * c) * VP + half * 128 + j;
                vp[0 * VP] = (bf16_t)(wv.x & 0xffff); vp[1 * VP] = (bf16_t)(wv.x >> 16); vp[2 * VP] = (bf16_t)(wv.y & 0xffff); vp[3 * VP] = (bf16_t)(wv.y >> 16);
                vp[4 * VP] = (bf16_t)(wv.z & 0xffff); vp[5 * VP] = (bf16_t)(wv.z >> 16); vp[6 * VP] = (bf16_t)(wv.w & 0xffff); vp[7 * VP] = (bf16_t)(wv.w >> 16); }
        }
        __syncthreads();
#define KOFF(t_) ((((t_) >> 3) ? cur_half : prev_half) * 128 + 16 * ((t_) & 7))
        bf16x8 bq[2];
#pragma unroll
        for (int ks = 0; ks < 2; ++ks) bq[ks] = *(const LAS bf16x8*)(Qs + (i0 + fr) * QP + 32 * ks + 8 * fq);
        f32x4 sc[9];
#pragma unroll
        for (int q = 0; q < 9; ++q) { sc[q] = (f32x4){0.f, 0.f, 0.f, 0.f};
#pragma unroll
            for (int ks = 0; ks < 2; ++ks) { const bf16x8 ak = *(const LAS bf16x8*)(Ks + (KOFF(w + q) + fr) * QP + 32 * ks + 8 * fq); sc[q] = __builtin_amdgcn_mfma_f32_16x16x32_bf16(ak, bq[ks], sc[q], 0, 0, 0); } }
        const int iq = i0 + fr;
        float mx = -INFINITY;
#pragma unroll
        for (int q = 0; q < 9; ++q) { const bool tile_ok = (n > 0) || (w + q >= 8);
#pragma unroll
            for (int e = 0; e < 4; ++e) { bool valid = tile_ok;
                if (q == 0) valid = valid && (4 * fq + e >= fr);
                if (q == 8) valid = valid && (4 * fq + e <= fr);
                sc[q][e] = valid ? sc[q][e] : -INFINITY; mx = fmaxf(mx, sc[q][e]); } }
        mx = fmaxf(mx, __shfl_xor(mx, 16)); mx = fmaxf(mx, __shfl_xor(mx, 32));
        float l = 0.f;
#pragma unroll
        for (int q = 0; q < 9; ++q)
#pragma unroll
            for (int e = 0; e < 4; ++e) { sc[q][e] = __builtin_amdgcn_exp2f(sc[q][e] - mx); l += sc[q][e]; }
        l += __shfl_xor(l, 16); l += __shfl_xor(l, 32);
        f32x4 o[4];
#pragma unroll
        for (int dt = 0; dt < 4; ++dt) o[dt] = (f32x4){0.f, 0.f, 0.f, 0.f};
#pragma unroll
        for (int c = 0; c < 5; ++c) { const int jtA = w + 2 * c; int jtB = w + 2 * c + 1; jtB = jtB > 15 ? 15 : jtB;
            const f32x4 pa = sc[2 * c]; const f32x4 pb = (2 * c + 1 <= 8) ? sc[(2 * c + 1 <= 8) ? 2 * c + 1 : 8] : (f32x4){0.f, 0.f, 0.f, 0.f};
            u32x4 pw; pw.x = pk2(pa[0], pa[1]); pw.y = pk2(pa[2], pa[3]); pw.z = pk2(pb[0], pb[1]); pw.w = pk2(pb[2], pb[3]);
            const bf16x8 bfrag = __builtin_bit_cast(bf16x8, pw);
#pragma unroll
            for (int dt = 0; dt < 4; ++dt) { const LAS bf16_t* vr = Vt + (16 * dt + fr) * VP + 4 * fq;
                const u32x2 lo = *(const LAS u32x2*)(vr + KOFF(jtA)), hi = *(const LAS u32x2*)(vr + KOFF(jtB)); const u32x4 av = {lo.x, lo.y, hi.x, hi.y};
                o[dt] = __builtin_amdgcn_mfma_f32_16x16x32_bf16(__builtin_bit_cast(bf16x8, av), bfrag, o[dt], 0, 0, 0); } }
        const float il = 1.0f / l; const int tq = tb + (128 * n + iq) * r;
        bf16_t* op = (dry ? proj + (size_t)NT * NMAIN + (size_t)(tq & 63) * NMAIN : proj + (size_t)tq * NMAIN) + C_AQ + h * 64 + 4 * fq;
#pragma unroll
        for (int dt = 0; dt < 4; ++dt) { u32x2 wv; wv.x = pk2(o[dt][0] * il, o[dt][1] * il); wv.y = pk2(o[dt][2] * il, o[dt][3] * il); *(u32x2*)(op + 16 * dt) = wv; }
        if (fq == 0) lse[((size_t)g * NT + tq) * 4 + hg] = mx * 0.6931471805599453f + __logf(l);
    }
}
#undef KOFF

__device__ __forceinline__ void attn_combine(const Ctx& X, KArgs a) {
    bf16_t* proj = (bf16_t*)(a->ws + WS_BIG); const float* lse = (const float*)(a->ws + WS_LSE);
    for (int base = X.gtid; base < NT * 32; base += 4 * X.nthr) {
        u32x4 o0[4], o1[4], o2[4]; float l0[4], l1[4], l2[4];
#pragma unroll
        for (int q = 0; q < 4; ++q) { const int idx = base + q * X.nthr; if (idx < NT * 32) { const int t = idx >> 5, c8 = (idx & 31) * 8, hg = c8 >> 6;
            l0[q] = lse[((size_t)0 * NT + t) * 4 + hg]; l1[q] = lse[((size_t)1 * NT + t) * 4 + hg]; l2[q] = lse[((size_t)2 * NT + t) * 4 + hg];
            const bf16_t* p = proj + (size_t)t * NMAIN + C_AQ + c8; o0[q] = *(const u32x4*)p; o1[q] = *(const u32x4*)(p + 256); o2[q] = *(const u32x4*)(p + 512); } }
#pragma unroll
        for (int q = 0; q < 4; ++q) { const int idx = base + q * X.nthr; if (idx < NT * 32) { const int t = idx >> 5, c8 = (idx & 31) * 8;
            const float mx = fmaxf(l0[q], fmaxf(l1[q], l2[q])); float w0 = __expf(l0[q] - mx), w1 = __expf(l1[q] - mx), w2 = __expf(l2[q] - mx); const float inv = 1.0f / (w0 + w1 + w2); w0 *= inv; w1 *= inv; w2 *= inv;
            float f0[8], f1[8], f2[8], o[8]; unpack8(o0[q], f0); unpack8(o1[q], f1); unpack8(o2[q], f2);
#pragma unroll
            for (int e = 0; e < 8; ++e) o[e] = w0 * f0[e] + w1 * f1[e] + w2 * f2[e];
            *(u32x4*)(proj + (size_t)t * NMAIN + C_AQ + c8) = pack8(o); } }
    }
}

constexpr int GP = 136;
__device__ __forceinline__ void gla_bcum(KArgs a, int tid, int t0, int h, LAS float* segtot, LAS float* glrs, float (&bc)[32], float& tot) {
    const int d = tid & 127, seg = __builtin_amdgcn_readfirstlane(tid >> 7), col = h * 128 + d;
    const float* glr = (const float*)(a->ws + WS_GLR);
    float w2r[16];
#pragma unroll
    for (int j = 0; j < 16; ++j) w2r[j] = a->gate_w2[j * 512 + col];
    const float bias = a->gate_b[col];
    *(LAS f32x4*)(glrs + tid * 4) = *(const f32x4*)(glr + (size_t)t0 * 16 + tid * 4);
    __syncthreads();
    float run = 0.f;
#pragma unroll
    for (int r = 0; r < 32; ++r) { const LAS f32x4* gp = (const LAS f32x4*)(glrs + (seg * 32 + r) * 16);
        float z = bias;
#pragma unroll
        for (int q = 0; q < 4; ++q) { const f32x4 g = gp[q]; z += g[0] * w2r[4 * q] + g[1] * w2r[4 * q + 1] + g[2] * w2r[4 * q + 2] + g[3] * w2r[4 * q + 3]; }
        const float la = (fminf(z, 0.f) - __logf(1.0f + __expf(-fabsf(z)))) * (1.0f / 16.0f);
        run += la; bc[r] = run; }
    segtot[seg * 128 + d] = run;
    __syncthreads();
    float off = 0.f; tot = 0.f;
#pragma unroll
    for (int s2 = 0; s2 < 4; ++s2) { const float v = segtot[s2 * 128 + d]; tot += v; if (s2 < seg) off += v; }
#pragma unroll
    for (int r = 0; r < 32; ++r) bc[r] += off;
}
__device__ __forceinline__ void gla_stage_vT(const bf16_t* proj, int tid, int t0, int h, LAS bf16_t* vT) {
#pragma unroll
    for (int q = 0; q < 8; ++q) { const int i = tid >> 2, c = (tid & 3) + 4 * q;
        const u32x4 wv = *(const u32x4*)(proj + (size_t)(t0 + i) * NMAIN + C_GV + h * 256 + 8 * c);
        LAS bf16_t* vp = vT + (8 * c) * GP + i;
        vp[0 * GP] = (bf16_t)(wv.x & 0xffff); vp[1 * GP] = (bf16_t)(wv.x >> 16); vp[2 * GP] = (bf16_t)(wv.y & 0xffff); vp[3 * GP] = (bf16_t)(wv.y >> 16);
        vp[4 * GP] = (bf16_t)(wv.z & 0xffff); vp[5 * GP] = (bf16_t)(wv.z >> 16); vp[6 * GP] = (bf16_t)(wv.w & 0xffff); vp[7 * GP] = (bf16_t)(wv.w >> 16); }
}
__device__ __forceinline__ void gla_a1(const Ctx& X, KArgs a, float* kvt, float* decb) {
    const bf16_t* proj = (const bf16_t*)(a->ws + WS_BIG);
    LAS bf16_t* kdT = (LAS bf16_t*)X.lds; LAS bf16_t* vT = (LAS bf16_t*)(X.lds + 128 * GP * 2); LAS float* segtot = (LAS float*)(X.lds + 384 * GP * 2);
    const int fr = X.lane & 15, fq = X.lane >> 4, w = X.wave;
    for (int unit = blockIdx.x; unit < 512; unit += gridDim.x) {
        const int bh = unit >> 5, n = unit & 31, b = bh >> 2, h = bh & 3, t0 = b * SEQ + n * 128;
        __syncthreads();
        float bc[32], tot; gla_bcum(a, X.tid, t0, h, segtot, (LAS float*)vT, bc, tot);
        { const int d = X.tid & 127, seg = X.tid >> 7;
#pragma unroll
          for (int r8 = 0; r8 < 4; ++r8) { float kd[8];
#pragma unroll
              for (int e = 0; e < 8; ++e) { const int r = r8 * 8 + e; kd[e] = bf2f(proj[(size_t)(t0 + seg * 32 + r) * NMAIN + C_GK + h * 128 + d]) * __expf(tot - bc[r]); }
              *(LAS u32x4*)(kdT + d * GP + seg * 32 + r8 * 8) = pack8(kd); }
          if (seg == 0) decb[unit * 128 + d] = __expf(tot); }
        gla_stage_vT(proj, X.tid, t0, h, vT);
        __syncthreads();
        f32x4 acc[8][2];
#pragma unroll
        for (int mt = 0; mt < 8; ++mt) { acc[mt][0] = (f32x4){0.f, 0.f, 0.f, 0.f}; acc[mt][1] = (f32x4){0.f, 0.f, 0.f, 0.f}; }
#pragma unroll
        for (int ks = 0; ks < 4; ++ks) {
            bf16x8 bfr[2];
#pragma unroll
            for (int nt = 0; nt < 2; ++nt) bfr[nt] = *(const LAS bf16x8*)(vT + (32 * w + 16 * nt + fr) * GP + 32 * ks + 8 * fq);
#pragma unroll
            for (int mt = 0; mt < 8; ++mt) { const bf16x8 af = *(const LAS bf16x8*)(kdT + (16 * mt + fr) * GP + 32 * ks + 8 * fq);
#pragma unroll
                for (int nt = 0; nt < 2; ++nt) acc[mt][nt] = __builtin_amdgcn_mfma_f32_16x16x32_bf16(af, bfr[nt], acc[mt][nt], 0, 0, 0); }
        }
        bf16_t* ko = (bf16_t*)kvt + (size_t)unit * 32768;
#pragma unroll
        for (int mt = 0; mt < 8; ++mt)
#pragma unroll
            for (int nt = 0; nt < 2; ++nt) { u32x2 wv; wv.x = pk2(acc[mt][nt][0], acc[mt][nt][1]); wv.y = pk2(acc[mt][nt][2], acc[mt][nt][3]);
                *(u32x2*)(ko + (32 * w + 16 * nt + fr) * 128 + 16 * mt + 4 * fq) = wv; }
    }
}
__device__ __forceinline__ void gla_a2(const Ctx& X, KArgs a, float* kvt, const float* decb, int dry = 0) {
    u32x2* kb = (u32x2*)kvt;
    for (int gid = X.gtid; gid < 131072; gid += X.nthr) {
        const int bh = gid >> 13, e4 = gid & 8191, d4 = (e4 & 31) * 4;
        f32x4 S = {0.f, 0.f, 0.f, 0.f};
        u32x2 kv[32];
#pragma unroll
        for (int j = 0; j < 32; ++j) kv[j] = kb[(size_t)(bh * 32 + j) * 8192 + e4];
#pragma unroll
        for (int hb = 0; hb < 2; ++hb) {
            f32x4 dc[16];
#pragma unroll
            for (int j = 0; j < 16; ++j) dc[j] = *(const f32x4*)(decb + (bh * 32 + hb * 16 + j) * 128 + d4);
#pragma unroll
            for (int j = 0; j < 16; ++j) { const int jj = hb * 16 + j, unit = bh * 32 + jj; u32x2 wv; wv.x = pk2(S[0], S[1]); wv.y = pk2(S[2], S[3]);
                if (dry) *((u32x2*)(a->ws + WS_BIG + (size_t)NT * NMAIN * 2) + gid) = wv; else kb[(size_t)unit * 8192 + e4] = wv;
                const f32x4 kf = {lo16(kv[jj].x), hi16(kv[jj].x), lo16(kv[jj].y), hi16(kv[jj].y)}; S = dc[j] * S + kf; }
        }
    }
}
__device__ __forceinline__ void gla_a3(const Ctx& X, KArgs a, const float* kvt, int dry = 0) {
    bf16_t* proj = (bf16_t*)(a->ws + WS_BIG);
    LAS bf16_t* qgs = (LAS bf16_t*)X.lds; LAS bf16_t* kgs = (LAS bf16_t*)(X.lds + 128 * GP * 2); LAS bf16_t* vT = (LAS bf16_t*)(X.lds + 256 * GP * 2); LAS float* segtot = (LAS float*)(X.lds + 512 * GP * 2);
    const int fr = X.lane & 15, fq = X.lane >> 4, w = X.wave, i0 = 16 * w;
    for (int unit = blockIdx.x; unit < 512; unit += gridDim.x) {
        const int bh = unit >> 5, n = unit & 31, b = bh >> 2, h = bh & 3, t0 = b * SEQ + n * 128;
        __syncthreads();
        { float bc[32], tot; gla_bcum(a, X.tid, t0, h, segtot, (LAS float*)vT, bc, tot);
          const int d = X.tid & 127, seg = X.tid >> 7;
#pragma unroll
          for (int r = 0; r < 32; ++r) { const int i = seg * 32 + r; const bf16_t* row = proj + (size_t)(t0 + i) * NMAIN + h * 128 + d;
              const float qv = bf2f(row[C_GQ]), kv = bf2f(row[C_GK]);
              qgs[i * GP + d] = (bf16_t)f2bf(qv * 0.08838834764831845f * __expf(bc[r])); kgs[i * GP + d] = (bf16_t)f2bf(kv * __expf(-bc[r])); } }
        gla_stage_vT(proj, X.tid, t0, h, vT);
        __syncthreads();
        bf16x8 afr[4];
#pragma unroll
        for (int ks = 0; ks < 4; ++ks) afr[ks] = *(const LAS bf16x8*)(qgs + (i0 + fr) * GP + 32 * ks + 8 * fq);
        f32x4 acc[16];
#pragma unroll
        for (int nt = 0; nt < 16; ++nt) acc[nt] = (f32x4){0.f, 0.f, 0.f, 0.f};
        for (int jt = 0; jt <= (w | 1); ++jt) {
            f32x4 att = {0.f, 0.f, 0.f, 0.f};
            if (jt <= w) {
#pragma unroll
                for (int ks = 0; ks < 4; ++ks) { const bf16x8 bf = *(const LAS bf16x8*)(kgs + (16 * jt + fr) * GP + 32 * ks + 8 * fq); att = __builtin_amdgcn_mfma_f32_16x16x32_bf16(afr[ks], bf, att, 0, 0, 0); }
            }
#pragma unroll
            for (int e = 0; e < 4; ++e) { const int i = i0 + 4 * fq + e, j = 16 * jt + fr; qgs[i * GP + j] = (bf16_t)f2bf(j <= i ? att[e] : 0.f); }
        }
        asm volatile("s_waitcnt lgkmcnt(0)" ::: "memory");
        for (int ks = 0; ks <= (w >> 1); ++ks) { const bf16x8 af = *(const LAS bf16x8*)(qgs + (i0 + fr) * GP + 32 * ks + 8 * fq);
#pragma unroll
            for (int nt = 0; nt < 16; ++nt) { const bf16x8 bf = *(const LAS bf16x8*)(vT + (16 * nt + fr) * GP + 32 * ks + 8 * fq); acc[nt] = __builtin_amdgcn_mfma_f32_16x16x32_bf16(af, bf, acc[nt], 0, 0, 0); } }
        if (n > 0) {
            __syncthreads();
            const bf16_t* sb = (const bf16_t*)kvt + (size_t)unit * 32768;
#pragma unroll
            for (int q = 0; q < 8; ++q) { const int sidx = X.tid + 512 * q; const u32x4 wv = *(const u32x4*)(sb + (size_t)sidx * 8);
                *(LAS u32x4*)(vT + (sidx >> 4) * GP + (sidx & 15) * 8) = wv; }
            __syncthreads();
#pragma unroll
            for (int ks = 0; ks < 4; ++ks)
#pragma unroll
                for (int nt = 0; nt < 16; ++nt) { const bf16x8 bf = *(const LAS bf16x8*)(vT + (16 * nt + fr) * GP + 32 * ks + 8 * fq); acc[nt] = __builtin_amdgcn_mfma_f32_16x16x32_bf16(afr[ks], bf, acc[nt], 0, 0, 0); }
        }
        float rs[4];
#pragma unroll
        for (int e = 0; e < 4; ++e) { float s2 = 0.f;
#pragma unroll
            for (int nt = 0; nt < 16; ++nt) s2 += acc[nt][e] * acc[nt][e];
            s2 += __shfl_xor(s2, 1); s2 += __shfl_xor(s2, 2); s2 += __shfl_xor(s2, 4); s2 += __shfl_xor(s2, 8);
            rs[e] = 1.0f / sqrtf(s2 * (1.0f / 256.0f) + EPS); }
        __syncthreads();
        { LAS bf16_t* ost = (LAS bf16_t*)(X.lds + w * 8704);
#pragma unroll
          for (int nt = 0; nt < 16; ++nt) { const float nw = a->gla_norm_w[16 * nt + fr];
#pragma unroll
              for (int e = 0; e < 4; ++e) ost[(4 * fq + e) * 272 + 16 * nt + fr] = (bf16_t)f2bf(acc[nt][e] * rs[e] * nw); }
          asm volatile("s_waitcnt lgkmcnt(0)" ::: "memory");
          const int r = X.lane >> 2, cgp = X.lane & 3;
          bf16_t* orow = proj + (size_t)(t0 + i0 + r) * NMAIN + C_GR + h * 256;
          bf16_t* drow = dry ? proj + (size_t)NT * NMAIN + (size_t)((t0 + i0 + r) & 63) * NMAIN + C_GR + h * 256 : orow;
          u32x4 gv[8];
#pragma unroll
          for (int q = 0; q < 8; ++q) gv[q] = *(const u32x4*)(orow + 8 * (cgp + 4 * q));
#pragma unroll
          for (int q = 0; q < 8; ++q) { const int c = cgp + 4 * q; float v[8], gr[8]; unpack8(*(const LAS u32x4*)(ost + r * 272 + 8 * c), v); unpack8(gv[q], gr);
#pragma unroll
              for (int e = 0; e < 8; ++e) v[e] *= gr[e] * sigmoidf_(gr[e]);
              *(u32x4*)(drow + 8 * c) = pack8(v); } }
    }
}

__global__ void __launch_bounds__(512, 2) fwd_megakernel(Args a_kernarg) {
    extern __shared__ __attribute__((aligned(16))) unsigned char lds_raw[];
    cg::grid_group grid = cg::this_grid();
#define X make_ctx(lds_raw)
    { volatile LAS unsigned* st0 = (volatile LAS unsigned*)((LAS unsigned char*)lds_raw + LDS_BYTES - 64); if (threadIdx.x < 2) st0[threadIdx.x] = 0u; }
    __syncthreads();
    const XcdBarrier xbar = xcd_barrier_post((unsigned*)(kargs()->ws), (volatile LAS unsigned*)((LAS unsigned char*)lds_raw + LDS_BYTES - 64));
#define WSP(T, off) ((T*)(a->ws + (off)))

    phase0(X, kargs());
    if (gridDim.x == 0x7fffffffu) grid.sync();
    xcd_barrier(xbar);
    { KArgs a = kargs(); norm_pass<0>(X, a, a->x, WSP(bf16_t, WS_HBUF), nullptr); }
    __syncthreads();
    phase0_transposes(X, kargs(), 0, 16 * 96 + 16 * 72 + 16 * 64, X.gw, X.ngw);
    xcd_barrier(xbar);
    { KArgs a = kargs(); pg8::Gemm g{WSP(bf16_t, WS_HBUF), WSP(bf16_t, WS_WMAIN), NT, NMAIN, DM, DM, DM}; run_gemm<0>(X, g, FStoreProj{WSP(bf16_t, WS_BIG), WSP(f32x2, WS_ROPE)}); }
    { const int nfull = (gridDim.x > 64) ? 64 : 0;
      if ((int)blockIdx.x >= nfull) phase0_transposes(X, kargs(), 16 * 96 + 16 * 72 + 16 * 64, -1, ((int)blockIdx.x - nfull) * 8 + X.wave, ((int)gridDim.x - nfull) * 8); }
    xcd_barrier(xbar);
#pragma unroll 1
    for (int step = 0; step < 2; ++step) {
        if (((step ^ (int)blockIdx.x) & 1) == 0) { KArgs a = kargs(); gla_a1(X, a, a->out, WSP(float, WS_SSQ)); }
        else attn_mfma(X, kargs());
        __syncthreads();
    }
    xcd_barrier(xbar);
    { KArgs a = kargs(); gla_a2(X, a, a->out, WSP(float, WS_SSQ)); }
    xcd_barrier(xbar);
    if ((blockIdx.x & 1) == 0) { KArgs a = kargs(); pg8::Gemm g{WSP(bf16_t, WS_HBUF), WSP(bf16_t, WS_WMAB), NT, NGATE, DM, DM, DM};
        run_gemm<1>(X, g, FSigmoidSplit{(bf16_t*)a->out + (size_t)NT * DM, WSP(bf16_t, WS_BIG) + C_AK}); }
    __syncthreads();
    { KArgs a = kargs(); gla_a3(X, a, a->out); }
    attn_combine(X, kargs());
    __syncthreads();
    if ((blockIdx.x & 1) != 0) { KArgs a = kargs(); pg8::Gemm g{WSP(bf16_t, WS_HBUF), WSP(bf16_t, WS_WMAB), NT, NGATE, DM, DM, DM};
        run_gemm<1>(X, g, FSigmoidSplit{(bf16_t*)a->out + (size_t)NT * DM, WSP(bf16_t, WS_BIG) + C_AK}); }
    xcd_barrier(xbar);
    { KArgs a = kargs(); pg8::Gemm g{WSP(bf16_t, WS_BIG) + C_GR, WSP(bf16_t, WS_WG), NT, DM, 1280, NMAIN, 1280};
      pg8::StaticOrder S; S.init(NT, DM, (int)gridDim.x, (int)blockIdx.x);
      EpiMixed2 E{(const bf16_t*)a->out + (size_t)NT * DM, WSP(bf16_t, WS_BIG) + C_AK, WSP(bf16_t, WS_HBUF)};
      pg8::gemm_phase<EpiMixed2, true, false, 1>(X.lds, g, S, E); }
    xcd_barrier(xbar);
    { KArgs a = kargs(); pg8::Gemm g{WSP(bf16_t, WS_HBUF), WSP(bf16_t, WS_WOUT), NT, DM, DM, DM, DM};
      pg8::StaticOrder S; S.init(NT, DM, (int)gridDim.x, (int)blockIdx.x);
      EpiResNorm E{a->x, WSP(bf16_t, WS_BIG) + (size_t)48 * 1024 * 1024, WSP(bf16_t, WS_HBUF), WSP(float, WS_MOD), a->norm2_w, RmsPanel{WSP(float, WS_GLR), (unsigned*)(a->ws + 16384)}};
      pg8::gemm_phase<EpiResNorm, false>(X.lds, g, S, E); }
    xcd_barrier(xbar);
    { KArgs a = kargs(); pg8::Gemm g{WSP(bf16_t, WS_HBUF) - 2 * DM, WSP(bf16_t, WS_WUP), NT, NUP, DM, DM, DM};
      pg8::StaticOrder S; S.init_tiles(66, NUP / 256, (int)gridDim.x, (int)blockIdx.x);
      EpiConvGeglu E{WSP(bf16_t, WS_BIG), a->conv_w, a->conv_b};
      pg8::gemm_phase<EpiConvGeglu, true, true>(X.lds, g, S, E); }
    xcd_barrier(xbar);
    { KArgs a = kargs(); pg8::Gemm g{WSP(bf16_t, WS_BIG), WSP(bf16_t, WS_WDOWN), NT, DM, DFF, DFF, DFF};
      pg8::StaticOrder S; S.init(NT, DM, (int)gridDim.x, (int)blockIdx.x);
      EpiResFinal E{WSP(bf16_t, WS_BIG) + (size_t)48 * 1024 * 1024, a->out, WSP(float, WS_MOD), a->final_w, RmsPanel{WSP(float, WS_GLR) + 65536, (unsigned*)(a->ws + 32768)}};
      pg8::gemm_phase<EpiResFinal, false>(X.lds, g, S, E); }
#undef WSP
#undef X
}

extern "C" void kernel_launch(void* const* d_in, const int* in_sizes, int n_in, void* d_out, int out_size, void* d_ws, size_t ws_size, hipStream_t stream) {
    static int grid_blocks = 0;
    if (grid_blocks == 0) {
        if (n_in != 19 || out_size != NT * DM || ws_size < WS_END) { fprintf(stderr, "kernel_launch: unexpected sizes (n_in %d out %d ws %zu)\n", n_in, out_size, ws_size); grid_blocks = -1; return; }
        int dev = 0, cus = 0, per_cu = 0;
        hipGetDevice(&dev); hipDeviceGetAttribute(&cus, hipDeviceAttributeMultiprocessorCount, dev);
        hipFuncSetAttribute((const void*)fwd_megakernel, hipFuncAttributeMaxDynamicSharedMemorySize, LDS_BYTES);
        hipOccupancyMaxActiveBlocksPerMultiprocessor(&per_cu, (const void*)fwd_megakernel, 512, LDS_BYTES);
        if (per_cu < 1) { fprintf(stderr, "kernel_launch: occupancy query says %d blocks per CU\n", per_cu); per_cu = 1; }
        if (per_cu > 1) per_cu = 1;
        grid_blocks = cus * per_cu;
        (void)hipGetLastError();
    }
    if (grid_blocks < 0) return;
    Args a{};
    a.x = (const float*)d_in[0]; a.c = (const float*)d_in[1]; a.positions = (const int*)d_in[2]; a.ada_w = (const float*)d_in[3]; a.ada_b = (const float*)d_in[4];
    a.norm1_w = (const float*)d_in[5]; a.w_in = (const float*)d_in[6]; a.gate_w2 = (const float*)d_in[7]; a.gate_b = (const float*)d_in[8]; a.gla_norm_w = (const float*)d_in[9];
    a.w_gla = (const float*)d_in[10]; a.w_attn = (const float*)d_in[11]; a.w_out = (const float*)d_in[12]; a.norm2_w = (const float*)d_in[13]; a.w_up = (const float*)d_in[14];
    a.conv_w = (const float*)d_in[15]; a.conv_b = (const float*)d_in[16]; a.w_down = (const float*)d_in[17]; a.final_w = (const float*)d_in[18];
    a.out = (float*)d_out; a.ws = (unsigned char*)d_ws;
    (void)hipMemsetAsync(d_ws, 0, 65536, stream);
    void* args[] = {&a};
    hipError_t e = hipLaunchCooperativeKernel((const void*)fwd_megakernel, dim3(grid_blocks), dim3(512), args, LDS_BYTES, stream);
    if (e != hipSuccess) fprintf(stderr, "cooperative launch failed: %s (grid %d)\n", hipGetErrorString(e), grid_blocks);
}
```
